# Optimizing an MI355X kernel written in HIP

```python
import math
import jax, jax.numpy as jnp
from jax import lax
import numpy as np

D_MODEL = 4096
BATCH = 2
SEQ = 8192
DEPTH = 2

CHUNK = 64
LEFT_CHUNKS = 8
REL_CLIP = 256
Q_BLOCK = 128
HEAD_DIM = 128
MIX_WIDTH = D_MODEL
A_HEADS = MIX_WIDTH // 4 // HEAD_DIM
B_HEADS = MIX_WIDTH // 4 // HEAD_DIM
A_WIDTH = A_HEADS * HEAD_DIM
B_WIDTH = B_HEADS * HEAD_DIM
SSM_WIDTH = MIX_WIDTH - A_WIDTH - B_WIDTH
SSM_GROUP = 16
SSM_GROUPS = SSM_WIDTH // SSM_GROUP
SSM_STATE = 64
IN_COLS = 3 * A_WIDTH + 3 * B_WIDTH + B_HEADS + SSM_WIDTH
D_FF = -(-8 * D_MODEL // (3 * 256)) * 256
RMS_EPS = 1e-6

kernel_name = "hybrid_chunk_causal_encoder"


def rms_norm(x, g):
    xf = x.astype(jnp.float32)
    y = xf * lax.rsqrt(jnp.mean(xf * xf, axis=-1, keepdims=True) + RMS_EPS)
    return (y * g.astype(jnp.float32)).astype(x.dtype)


def split_heads(t, n_heads):
    b, s, _ = t.shape
    return t.reshape(b, s, n_heads, HEAD_DIM).transpose(0, 2, 1, 3)


def merge_heads(t):
    b, h, s, d = t.shape
    return t.transpose(0, 2, 1, 3).reshape(b, s, h * d)


def chunk_band(t):
    b, h, s, d = t.shape
    n_c = s // CHUNK
    tc = t.reshape(b, h, n_c, CHUNK, d)
    tp = jnp.pad(tc, ((0, 0), (0, 0), (LEFT_CHUNKS, 0), (0, 0), (0, 0)))
    return jnp.concatenate([tp[:, :, j:j + n_c] for j in range(LEFT_CHUNKS + 1)], axis=3)


def chunked_relpos_attention(q, k, v, rel_bias):
    b, h, s, d = q.shape
    n_c = s // CHUNK
    band = (LEFT_CHUNKS + 1) * CHUNK
    qc = q.reshape(b, h, n_c, CHUNK, d)
    kb = chunk_band(k)
    vb = chunk_band(v)
    scores = jnp.einsum('bhcqd,bhckd->bhcqk', qc, kb).astype(jnp.float32) * (d ** -0.5)
    dist = LEFT_CHUNKS * CHUNK + jnp.arange(CHUNK)[:, None] - jnp.arange(band)[None, :]
    idx = jnp.clip(dist, -REL_CLIP, REL_CLIP) + REL_CLIP
    bias = rel_bias.astype(jnp.float32)[:, idx]
    valid = (jnp.arange(n_c)[:, None] - LEFT_CHUNKS + jnp.arange(band)[None, :] // CHUNK) >= 0
    scores = jnp.where(valid[None, None, :, None, :], scores + bias[None, :, None], -jnp.inf)
    p = jax.nn.softmax(scores, axis=-1)
    o = jnp.einsum('bhcqk,bhckd->bhcqd', p.astype(v.dtype), vb)
    return o.reshape(b, h, s, d)


def forgetting_attention(q, k, v, f_logit):
    b, h, s, d = q.shape
    n_q = s // Q_BLOCK
    cum = jnp.cumsum(jax.nn.log_sigmoid(f_logit.astype(jnp.float32)), axis=-1)
    q_blocks = jnp.moveaxis(q.reshape(b, h, n_q, Q_BLOCK, d), 2, 0)
    c_blocks = jnp.moveaxis(cum.reshape(b, h, n_q, Q_BLOCK), 2, 0)
    starts = jnp.arange(n_q, dtype=jnp.int32) * Q_BLOCK
    k_pos = jnp.arange(s, dtype=jnp.int32)
    scale = d ** -0.5

    def block(args):
        q_i, c_i, s0 = args
        logits = jnp.einsum('bhqd,bhkd->bhqk', q_i, k).astype(jnp.float32) * scale
        logits = logits + (c_i[..., None] - cum[:, :, None, :])
        q_pos = s0 + jnp.arange(Q_BLOCK, dtype=jnp.int32)
        logits = jnp.where(k_pos[None, :] <= q_pos[:, None], logits, -jnp.inf)
        p = jax.nn.softmax(logits, axis=-1)
        return jnp.einsum('bhqk,bhkd->bhqd', p.astype(v.dtype), v)

    o = lax.map(block, (q_blocks, c_blocks, starts))
    return jnp.moveaxis(o, 0, 2).reshape(b, h, s, d)


def s5_mixer(u, a_re, a_im, log_dt, b_re, b_im, c_re, c_im, d_skip, w_glu, b_glu):
    bsz, s, w = u.shape
    uf = u.astype(jnp.float32).reshape(bsz, s, SSM_GROUPS, SSM_GROUP)
    lam = lax.complex(jnp.minimum(a_re.astype(jnp.float32), -1e-4), a_im.astype(jnp.float32))
    dt = jnp.exp(log_dt.astype(jnp.float32))[:, None]
    lam_bar = jnp.exp(lam * dt)
    b_mat = lax.complex(b_re.astype(jnp.float32), b_im.astype(jnp.float32))
    b_bar = ((lam_bar - 1.0) / lam)[..., None] * b_mat
    bu = jnp.einsum('blgi,gni->blgn', uf.astype(jnp.complex64), b_bar)
    lam_seq = jnp.broadcast_to(lam_bar, bu.shape)

    def combine(e1, e2):
        a1, x1 = e1
        a2, x2 = e2
        return a1 * a2, a2 * x1 + x2

    _, states = lax.associative_scan(combine, (lam_seq, bu), axis=1)
    c_mat = lax.complex(c_re.astype(jnp.float32), c_im.astype(jnp.float32))
    y = jnp.einsum('blgn,gin->blgi', states, c_mat).real
    y = y + d_skip.astype(jnp.float32).reshape(SSM_GROUPS, SSM_GROUP) * uf
    y = jax.nn.gelu(y.reshape(bsz, s, w))
    y = y * jax.nn.sigmoid(y @ w_glu.astype(jnp.float32) + b_glu.astype(jnp.float32))
    return y.astype(u.dtype)


def setup_inputs(seed: int = 0) -> dict:
    key = jax.random.key(seed)
    ks = jax.random.split(key, 24)
    L = DEPTH
    f32 = jnp.float32
    nrm = lambda k, shape: jax.random.normal(k, shape, f32)
    return {
        "x": nrm(ks[0], (BATCH, SEQ, D_MODEL)),
        "w_in": nrm(ks[1], (L, D_MODEL, IN_COLS)) * D_MODEL ** -0.5,
        "w_out": nrm(ks[2], (L, MIX_WIDTH, D_MODEL)) * MIX_WIDTH ** -0.5,
        "g_pre_mix": 1.0 + 0.05 * nrm(ks[3], (L, D_MODEL)),
        "g_post_mix": 1.0 + 0.05 * nrm(ks[4], (L, D_MODEL)),
        "g_group": 1.0 + 0.05 * nrm(ks[5], (L, MIX_WIDTH)),
        "rel_bias": 0.1 * nrm(ks[6], (L, A_HEADS, 2 * REL_CLIP + 1)),
        "b_forget": 2.0 + 0.1 * nrm(ks[7], (L, B_HEADS)),
        "ssm_a_re": -0.5 + 0.01 * nrm(ks[8], (L, SSM_GROUPS, SSM_STATE)),
        "ssm_a_im": jnp.pi * jnp.arange(SSM_STATE, dtype=f32) + 0.01 * nrm(ks[9], (L, SSM_GROUPS, SSM_STATE)),
        "ssm_log_dt": jax.random.uniform(ks[10], (L, SSM_GROUPS), f32, minval=math.log(1e-3), maxval=math.log(1e-1)),
        "ssm_b_re": nrm(ks[11], (L, SSM_GROUPS, SSM_STATE, SSM_GROUP)) * (2 * SSM_GROUP) ** -0.5,
        "ssm_b_im": nrm(ks[12], (L, SSM_GROUPS, SSM_STATE, SSM_GROUP)) * (2 * SSM_GROUP) ** -0.5,
        "ssm_c_re": nrm(ks[13], (L, SSM_GROUPS, SSM_GROUP, SSM_STATE)) * SSM_STATE ** -0.5,
        "ssm_c_im": nrm(ks[14], (L, SSM_GROUPS, SSM_GROUP, SSM_STATE)) * SSM_STATE ** -0.5,
        "ssm_d": 0.5 * nrm(ks[15], (L, SSM_WIDTH)),
        "w_glu": nrm(ks[16], (L, SSM_WIDTH, SSM_WIDTH)) * SSM_WIDTH ** -0.5,
        "b_glu": 0.02 * nrm(ks[17], (L, SSM_WIDTH)),
        "g_pre_ffn": 1.0 + 0.05 * nrm(ks[18], (L, D_MODEL)),
        "g_post_ffn": 1.0 + 0.05 * nrm(ks[19], (L, D_MODEL)),
        "w_ffn_gate": nrm(ks[20], (L, D_MODEL, D_FF)) * D_MODEL ** -0.5,
        "w_ffn_up": nrm(ks[21], (L, D_MODEL, D_FF)) * D_MODEL ** -0.5,
        "w_ffn_down": nrm(ks[22], (L, D_FF, D_MODEL)) * D_FF ** -0.5,
    }


def reference(x, w_in, w_out, g_pre_mix, g_post_mix, g_group, rel_bias, b_forget,
              ssm_a_re, ssm_a_im, ssm_log_dt, ssm_b_re, ssm_b_im, ssm_c_re, ssm_c_im,
              ssm_d, w_glu, b_glu, g_pre_ffn, g_post_ffn, w_ffn_gate, w_ffn_up, w_ffn_down):
    splits = list(np.cumsum([A_WIDTH, A_WIDTH, A_WIDTH, B_WIDTH, B_WIDTH, B_WIDTH, B_HEADS]))
    for l in range(DEPTH):
        h = rms_norm(x, g_pre_mix[l])
        proj = h @ w_in[l]
        qa, ka, va, qb, kb, vb, fb, uc = jnp.split(proj, splits, axis=-1)
        o_a = merge_heads(chunked_relpos_attention(
            split_heads(qa, A_HEADS), split_heads(ka, A_HEADS), split_heads(va, A_HEADS), rel_bias[l]))
        f_logit = (fb + b_forget[l]).transpose(0, 2, 1)
        o_b = merge_heads(forgetting_attention(
            split_heads(qb, B_HEADS), split_heads(kb, B_HEADS), split_heads(vb, B_HEADS), f_logit))
        o_c = s5_mixer(uc, ssm_a_re[l], ssm_a_im[l], ssm_log_dt[l], ssm_b_re[l], ssm_b_im[l],
                       ssm_c_re[l], ssm_c_im[l], ssm_d[l], w_glu[l], b_glu[l])
        gg = g_group[l]
        mix = jnp.concatenate([
            rms_norm(o_a, gg[:A_WIDTH]),
            rms_norm(o_b, gg[A_WIDTH:A_WIDTH + B_WIDTH]),
            rms_norm(o_c, gg[A_WIDTH + B_WIDTH:]),
        ], axis=-1)
        x = x + rms_norm(mix @ w_out[l], g_post_mix[l])
        h = rms_norm(x, g_pre_ffn[l])
        f = (jax.nn.silu(h @ w_ffn_gate[l]) * (h @ w_ffn_up[l])) @ w_ffn_down[l]
        x = x + rms_norm(f, g_post_ffn[l])
    return x
```

```cpp
#include <hip/hip_runtime.h>
#include <cstdio>
#include <cstdint>
namespace pg8 {
#define PG8_LAS __attribute__((address_space(3)))
typedef unsigned short bf16_t;
typedef short bf16x8 __attribute__((ext_vector_type(8)));
typedef float f32x4 __attribute__((ext_vector_type(4)));
typedef unsigned u32x4 __attribute__((ext_vector_type(4)));
constexpr int BM = 256, BK = 64, HALF = 128, HTB = HALF * BK * 2  , STAGE_BYTES = 8 * HTB, NXCD = 8, WGM = 8;

__host__ __device__ __forceinline__ int lds_byte(int r, int c) { const int st = (r >> 4) * 2 + (c >> 5), rr = r & 15, cc = c & 31, ob = rr * 64 + cc * 2; return st * 1024 + (ob ^ (((ob >> 9) & 1) << 5)); }
__host__ __device__ __forceinline__ void stage_rc(int b, int& R, int& C) { const int st = b / 1024, sb = b % 1024, swz = sb ^ (((sb >> 9) & 1) << 5); R = (st >> 1) * 16 + swz / 64; C = (st & 1) * 32 + (swz % 64) / 2; }
__host__ __device__ __forceinline__ int perm32(int rho) { const int n = rho >> 4, i = rho & 15; return 8 * (i >> 2) + 4 * n + (i & 3); }

struct Unit { int pm, pn; };
struct Gemm { const bf16_t* A; const bf16_t* Bt; int M, N, K; };

struct StaticOrder {
    int nM, nN, nwg, G, c;
    __host__ __device__ void init(int M, int N, int G_, int c_) { nM = M / BM; nN = N / BM; nwg = nM * nN; G = G_; c = c_; }
    __host__ __device__ bool next(int i, Unit& u) const {
        const long L = (long)i * G + c; if (L >= nwg) return false;
        int wgid = (int)L; { const int q = nwg / NXCD, r = nwg % NXCD, xcd = wgid % NXCD, off = wgid / NXCD; wgid = (xcd < r ? xcd * (q + 1) : r * (q + 1) + (xcd - r) * q) + off; }
        const int nig = WGM * nN, gid = wgid / nig, fm = gid * WGM, gsz = (nM - fm) < WGM ? (nM - fm) : WGM;
        u.pm = fm + ((wgid % nig) % gsz); u.pn = (wgid % nig) / gsz; return true;
    }
    __device__ __forceinline__ void a_ready(const Unit&) const {}
    __device__ __forceinline__ void done(const Unit&) const {}
};

__device__ __forceinline__ unsigned cvt_pk_bf16(float lo, float hi) { unsigned r; asm volatile("v_cvt_pk_bf16_f32 %0, %1, %2" : "=v"(r) : "v"(lo), "v"(hi)); return r; }
typedef unsigned u32x2 __attribute__((ext_vector_type(2)));
__device__ __forceinline__ float sigm(float z) { return __builtin_amdgcn_rcpf(1.0f + __builtin_amdgcn_exp2f(-1.4426950408889634f * z)); }
__device__ __forceinline__ float bflo(unsigned w) { return __builtin_bit_cast(float, w << 16); }
__device__ __forceinline__ float bfhi(unsigned w) { return __builtin_bit_cast(float, w & 0xffff0000u); }
struct EpiStoreBf16 {
    static constexpr bool PERM = true, AFTER_DRAIN = false;
    bf16_t* O; int ldc;
    __device__ __forceinline__ void operator()(const f32x4 (&acc)[2][2][4][2], const Unit& u, int wr, int wc, int fr, int fq) const {
        const int row0 = u.pm * BM + wr * 64 + fr, col0 = u.pn * BM + wc * 32 + 8 * fq;
#pragma unroll
        for (int ai = 0; ai < 2; ++ai)
#pragma unroll
            for (int m = 0; m < 4; ++m) { bf16_t* rowp = O + (size_t)(row0 + ai * HALF + m * 16) * ldc + col0;
#pragma unroll
                for (int bj = 0; bj < 2; ++bj) { const f32x4 v0 = acc[ai][bj][m][0], v1 = acc[ai][bj][m][1];
                    u32x4 w; w.x = cvt_pk_bf16(v0[0], v0[1]); w.y = cvt_pk_bf16(v0[2], v0[3]); w.z = cvt_pk_bf16(v1[0], v1[1]); w.w = cvt_pk_bf16(v1[2], v1[3]);
                    *(u32x4*)(rowp + bj * HALF) = w; } }
    }
};
struct EpiStoreF32 {
    static constexpr bool PERM = false, AFTER_DRAIN = false;
    float* C; int ldc;
    __device__ __forceinline__ void operator()(const f32x4 (&acc)[2][2][4][2], const Unit& u, int wr, int wc, int fr, int fq) const {
        const int row0 = u.pm * BM + wr * 64 + fr, col0 = u.pn * BM + wc * 32 + 4 * fq;
#pragma unroll
        for (int ai = 0; ai < 2; ++ai)
#pragma unroll
            for (int m = 0; m < 4; ++m) { float* rowp = C + (size_t)(row0 + ai * HALF + m * 16) * ldc + col0;
#pragma unroll
                for (int bj = 0; bj < 2; ++bj)
#pragma unroll
                    for (int n = 0; n < 2; ++n) *(f32x4*)(rowp + bj * HALF + n * 16) = acc[ai][bj][m][n]; }
    }
};
struct EpiGlu {
    static constexpr bool PERM = true, AFTER_DRAIN = false;
    const bf16_t* Y; int ldy; bf16_t* O; int ldo; const float* bias;
    __device__ __forceinline__ void operator()(const f32x4 (&acc)[2][2][4][2], const Unit& u, int wr, int wc, int fr, int fq) const {
        const int row0 = u.pm * BM + wr * 64 + fr, col0 = u.pn * BM + wc * 32 + 8 * fq;
        f32x4 bv[2][2];
#pragma unroll
        for (int bj = 0; bj < 2; ++bj)
#pragma unroll
            for (int n = 0; n < 2; ++n) bv[bj][n] = *(const f32x4*)(bias + col0 + bj * HALF + 4 * n);
#pragma unroll
        for (int ai = 0; ai < 2; ++ai)
#pragma unroll
            for (int m = 0; m < 4; ++m) { const size_t r = (size_t)(row0 + ai * HALF + m * 16);
#pragma unroll
                for (int bj = 0; bj < 2; ++bj) { const u32x4 yv = *(const u32x4*)(Y + r * ldy + col0 + bj * HALF);
                    const f32x4 z0 = acc[ai][bj][m][0] + bv[bj][0], z1 = acc[ai][bj][m][1] + bv[bj][1];
                    u32x4 w;
                    w.x = cvt_pk_bf16(bflo(yv.x) * sigm(z0[0]), bfhi(yv.x) * sigm(z0[1])); w.y = cvt_pk_bf16(bflo(yv.y) * sigm(z0[2]), bfhi(yv.y) * sigm(z0[3]));
                    w.z = cvt_pk_bf16(bflo(yv.z) * sigm(z1[0]), bfhi(yv.z) * sigm(z1[1])); w.w = cvt_pk_bf16(bflo(yv.w) * sigm(z1[2]), bfhi(yv.w) * sigm(z1[3]));
                    *(u32x4*)(O + r * ldo + col0 + bj * HALF) = w; } }
    }
};
struct EpiSwiGlu {
    static constexpr bool PERM = true, AFTER_DRAIN = false;
    bf16_t* O; int ldc;
    __device__ __forceinline__ void operator()(const f32x4 (&acc)[2][2][4][2], const Unit& u, int wr, int wc, int fr, int fq) const {
        const int row0 = u.pm * BM + wr * 64 + fr, col0 = u.pn * HALF + wc * 32 + 8 * fq;
#pragma unroll
        for (int ai = 0; ai < 2; ++ai)
#pragma unroll
            for (int m = 0; m < 4; ++m) { bf16_t* rowp = O + (size_t)(row0 + ai * HALF + m * 16) * ldc + col0;
                const f32x4 g0 = acc[ai][0][m][0], g1 = acc[ai][0][m][1], u0 = acc[ai][1][m][0], u1 = acc[ai][1][m][1];
                u32x4 w;
                w.x = cvt_pk_bf16(g0[0] * sigm(g0[0]) * u0[0], g0[1] * sigm(g0[1]) * u0[1]); w.y = cvt_pk_bf16(g0[2] * sigm(g0[2]) * u0[2], g0[3] * sigm(g0[3]) * u0[3]);
                w.z = cvt_pk_bf16(g1[0] * sigm(g1[0]) * u1[0], g1[1] * sigm(g1[1]) * u1[1]); w.w = cvt_pk_bf16(g1[2] * sigm(g1[2]) * u1[2], g1[3] * sigm(g1[3]) * u1[3]);
                *(u32x4*)rowp = w; }
    }
};
template <class Epi, class Sched, bool ALIGN_EPI = false, bool SP2 = false>
__device__ __forceinline__ void gemm_phase(PG8_LAS unsigned char* lds, const Gemm g, const Sched& S, const Epi& E, const int tid) {
    const int wid = __builtin_amdgcn_readfirstlane(tid >> 6), lane = tid & 63, wr = wid >> 2, wc = wid & 3, fr = lane & 15, fq = lane >> 4;
    const int K = g.K, nt = K / BK;
    unsigned voffA[2], voffB[2];
#pragma unroll
    for (int i = 0; i < 2; ++i) { int R, C; stage_rc(tid * 16 + i * 8192, R, C); const int Rb = Epi::PERM ? ((R & ~31) + perm32(R & 31)) : R;
        voffA[i] = (unsigned)(R * K + C) * 2u; voffB[i] = (unsigned)(Rb * K + C) * 2u; }
    const size_t kstep = (size_t)(BK * 2);
    const size_t hstep = (size_t)HALF * K * 2;
    const size_t tstep = 2 * hstep;
    const unsigned ldsw = (unsigned)wid * 1024u;
    const int aoff = lds_byte(wr * 64 + fr, fq * 8), boff = lds_byte(wc * 32 + fr, fq * 8);
#define PG8_SA(b, h) (((b) * 2 + (h)) * HTB)
#define PG8_SB(b, h) ((4 + (b) * 2 + (h)) * HTB)
#define PG8_STAGE(bufoff, gbase, voff) do { _Pragma("unroll") for (int _i = 0; _i < 2; ++_i) \
        __builtin_amdgcn_global_load_lds((const unsigned*)((const char*)(gbase) + (voff)[_i]), (PG8_LAS unsigned*)(lds + (bufoff) + ldsw + _i * 8192), 16, 0, 0); } while (0)
#define PG8_LDA(dst, b, h) do { _Pragma("unroll") for (int m = 0; m < 4; ++m) _Pragma("unroll") for (int k = 0; k < 2; ++k) dst[m][k] = *(const PG8_LAS bf16x8*)(lds + PG8_SA(b, h) + aoff + m * 2048 + k * 1024); } while (0)
#define PG8_LDB(dst, b, h) do { _Pragma("unroll") for (int n = 0; n < 2; ++n) _Pragma("unroll") for (int k = 0; k < 2; ++k) dst[n][k] = *(const PG8_LAS bf16x8*)(lds + PG8_SB(b, h) + boff + n * 2048 + k * 1024); } while (0)
#define PG8_MMA(ai, bj, At, Bt) do { __builtin_amdgcn_s_setprio(1); _Pragma("unroll") for (int m = 0; m < 4; ++m) _Pragma("unroll") for (int n = 0; n < 2; ++n) _Pragma("unroll") for (int k = 0; k < 2; ++k) \
        acc[ai][bj][m][n] = __builtin_amdgcn_mfma_f32_16x16x32_bf16(Bt[n][k], At[m][k], acc[ai][bj][m][n], 0, 0, 0); __builtin_amdgcn_s_setprio(0); } while (0)
#define PG8_WAIT_V(n) asm volatile("s_waitcnt vmcnt(" #n ")" ::: "memory")
#define PG8_WAIT_L(n) asm volatile("s_waitcnt lgkmcnt(" #n ")" ::: "memory")
#define PG8_BAR __builtin_amdgcn_s_barrier()
#define PG8_SCHED __builtin_amdgcn_sched_barrier(0)
    Unit cur, nxt; int ui = 0;
    if (!S.next(0, cur)) return;
    f32x4 acc[2][2][4][2];
#pragma unroll
    for (int a = 0; a < 2; ++a)
#pragma unroll
        for (int b = 0; b < 2; ++b)
#pragma unroll
            for (int m = 0; m < 4; ++m)
#pragma unroll
                for (int n = 0; n < 2; ++n) acc[a][b][m][n] = (f32x4){0.f, 0.f, 0.f, 0.f};
    bf16x8 At[4][2], B0[2][2], B1[2][2];
    const char* cA = (const char*)g.A + (size_t)cur.pm * tstep; const char* cB = (const char*)g.Bt + (size_t)cur.pn * tstep;
    S.a_ready(cur);
    if constexpr (SP2) {
        PG8_STAGE(PG8_SB(0, 0), cB, voffB); PG8_STAGE(PG8_SB(0, 1), cB + hstep, voffB); PG8_STAGE(PG8_SA(0, 0), cA, voffA); PG8_STAGE(PG8_SA(0, 1), cA + hstep, voffA);
        if (wr == 1) PG8_BAR;
        PG8_WAIT_V(2); PG8_BAR;
        PG8_STAGE(PG8_SB(1, 0), cB + kstep, voffB); PG8_STAGE(PG8_SA(1, 0), cA + kstep, voffA); PG8_STAGE(PG8_SB(1, 1), cB + hstep + kstep, voffB);
        PG8_WAIT_V(6); PG8_BAR;
    } else {
        PG8_STAGE(PG8_SB(0, 0), cB, voffB); PG8_STAGE(PG8_SA(0, 0), cA, voffA); PG8_STAGE(PG8_SB(0, 1), cB + hstep, voffB); PG8_STAGE(PG8_SA(0, 1), cA + hstep, voffA);
        if (wr == 1) PG8_BAR;
        PG8_WAIT_V(4); PG8_BAR;
        PG8_STAGE(PG8_SB(1, 0), cB + kstep, voffB); PG8_STAGE(PG8_SA(1, 0), cA + kstep, voffA); PG8_STAGE(PG8_SB(1, 1), cB + hstep + kstep, voffB);
        PG8_WAIT_V(6); PG8_BAR;
    }
    for (;;) {
        const bool has_next = S.next(ui + 1, nxt);
        const char* nA = has_next ? (const char*)g.A + (size_t)nxt.pm * tstep : cA; const char* nB = has_next ? (const char*)g.Bt + (size_t)nxt.pn * tstep : cB;
        for (int t = 0; t < nt; t += 2) {
            const bool last = (t == nt - 2);
            const char* a1 = cA + (size_t)(t + 1) * kstep;
            const char* a2 = last ? nA : cA + (size_t)(t + 2) * kstep; const char* b2 = last ? nB : cB + (size_t)(t + 2) * kstep;
            const char* a3 = a2 + kstep; const char* b3 = b2 + kstep;
            if (last && has_next) S.a_ready(nxt);
            if constexpr (SP2) {
            PG8_LDB(B0, 0, 0); PG8_LDB(B1, 0, 1); PG8_SCHED; PG8_LDA(At, 0, 0); PG8_STAGE(PG8_SA(1, 1), a1 + hstep, voffA);
            PG8_WAIT_V(8); PG8_WAIT_L(0); PG8_BAR; PG8_MMA(0, 0, At, B0); PG8_MMA(0, 1, At, B1); PG8_BAR; PG8_SCHED;
            PG8_LDA(At, 0, 1); PG8_STAGE(PG8_SB(0, 0), b2, voffB); PG8_STAGE(PG8_SB(0, 1), b2 + hstep, voffB); PG8_STAGE(PG8_SA(0, 0), a2, voffA);
            PG8_WAIT_V(8); PG8_WAIT_L(0); PG8_BAR; PG8_MMA(1, 0, At, B0); PG8_MMA(1, 1, At, B1); PG8_BAR; PG8_SCHED;
            PG8_LDB(B0, 1, 0); PG8_LDB(B1, 1, 1); PG8_SCHED; PG8_LDA(At, 1, 0); PG8_STAGE(PG8_SA(0, 1), a2 + hstep, voffA);
            PG8_WAIT_V(8); PG8_WAIT_L(0); PG8_BAR; PG8_MMA(0, 0, At, B0); PG8_MMA(0, 1, At, B1); PG8_BAR; PG8_SCHED;
            PG8_LDA(At, 1, 1); PG8_STAGE(PG8_SB(1, 0), b3, voffB); PG8_STAGE(PG8_SB(1, 1), b3 + hstep, voffB); PG8_STAGE(PG8_SA(1, 0), a3, voffA);
            PG8_WAIT_V(8); PG8_WAIT_L(0); PG8_BAR; PG8_MMA(1, 0, At, B0); PG8_MMA(1, 1, At, B1); PG8_BAR; PG8_SCHED;
            } else {
            PG8_LDB(B0, 0, 0); PG8_SCHED; PG8_LDA(At, 0, 0); PG8_STAGE(PG8_SA(1, 1), a1 + hstep, voffA);
            PG8_WAIT_L(8); PG8_BAR; PG8_WAIT_L(0); PG8_MMA(0, 0, At, B0); PG8_BAR; PG8_SCHED;
            PG8_LDB(B1, 0, 1); PG8_STAGE(PG8_SB(0, 0), b2, voffB);
            PG8_BAR; PG8_WAIT_L(0); PG8_MMA(0, 1, At, B1); PG8_BAR;
            PG8_LDA(At, 0, 1); PG8_STAGE(PG8_SA(0, 0), a2, voffA);
            PG8_BAR; PG8_WAIT_L(0); PG8_MMA(1, 0, At, B0); PG8_BAR; PG8_SCHED;
            PG8_STAGE(PG8_SB(0, 1), b2 + hstep, voffB);
            PG8_WAIT_V(6); PG8_BAR; PG8_MMA(1, 1, At, B1); PG8_BAR;
            PG8_LDB(B0, 1, 0); PG8_SCHED; PG8_LDA(At, 1, 0); PG8_STAGE(PG8_SA(0, 1), a2 + hstep, voffA);
            PG8_WAIT_L(8); PG8_BAR; PG8_WAIT_L(0); PG8_MMA(0, 0, At, B0); PG8_BAR; PG8_SCHED;
            PG8_LDB(B1, 1, 1); PG8_STAGE(PG8_SB(1, 0), b3, voffB);
            PG8_BAR; PG8_WAIT_L(0); PG8_MMA(0, 1, At, B1); PG8_BAR;
            PG8_LDA(At, 1, 1); PG8_STAGE(PG8_SA(1, 0), a3, voffA);
            PG8_BAR; PG8_WAIT_L(0); PG8_MMA(1, 0, At, B0); PG8_BAR; PG8_SCHED;
            PG8_STAGE(PG8_SB(1, 1), b3 + hstep, voffB);
            PG8_WAIT_V(6); PG8_BAR; PG8_MMA(1, 1, At, B1); PG8_BAR;
            }
        }
        if constexpr (ALIGN_EPI) { if (wr == 0) PG8_BAR; }
        if constexpr (!Epi::AFTER_DRAIN) { E(acc, cur, wr, wc, fr, fq); S.done(cur); }
        if (!has_next) break;
#pragma unroll
        for (int a = 0; a < 2; ++a)
#pragma unroll
            for (int b = 0; b < 2; ++b)
#pragma unroll
                for (int m = 0; m < 4; ++m)
#pragma unroll
                    for (int n = 0; n < 2; ++n) acc[a][b][m][n] = (f32x4){0.f, 0.f, 0.f, 0.f};
        cur = nxt; cA = nA; cB = nB; ++ui;
        if constexpr (ALIGN_EPI) { if (wr == 1) PG8_BAR; }
    }
    PG8_WAIT_V(0);
    if constexpr (!ALIGN_EPI) { if (wr == 0) PG8_BAR; }
    PG8_BAR;
    if constexpr (Epi::AFTER_DRAIN) { E.fused(acc, cur, wr, wc, fr, fq, lds, wid, lane); S.done(cur); }
#undef PG8_SA
#undef PG8_SB
#undef PG8_STAGE
#undef PG8_LDA
#undef PG8_LDB
#undef PG8_MMA
#undef PG8_WAIT_V
#undef PG8_WAIT_L
#undef PG8_BAR
#undef PG8_SCHED
}
}
#ifndef PG8_SP2
#define PG8_SP2 true
#endif
#ifndef PG8_ALIGN
#define PG8_ALIGN true
#endif

constexpr int NWAVES = 8;
constexpr int BATCH = 2, SEQ = 8192, M = BATCH * SEQ, D = 4096, INCOLS = 8200, NPROJ = 8192, DFF = 11008, NGU = 2 * DFF;
constexpr int HD = 128, NH = 8, SSMW = 2048, NG = 128, NS = 64, LAYERS = 2;
constexpr int COL_QA = 0, COL_KA = 1024, COL_VA = 2048, COL_QB = 3072, COL_KB = 4096, COL_VB = 5120, COL_U = 6144;
constexpr float RMS_EPS = 1e-6f;
constexpr float LOG2E = 1.4426950408889634f;
constexpr float QK_SCALE = 0.08838834764831845f;

constexpr size_t MiB = 1u << 20;
constexpr size_t WS_CTL = 0, CTL_ZERO_BYTES = 1 * MiB;
constexpr size_t WS_LS = 3 * MiB;
constexpr size_t WS_CUM = 4 * MiB;
constexpr size_t WS_KNT = 5 * MiB;
constexpr size_t WS_W = 16 * MiB;
constexpr size_t W_IN = 0, W_GLU = 64 * MiB, W_OUT = 72 * MiB, W_GU = 104 * MiB, W_D = 276 * MiB, W_LAYER = 362 * MiB;
constexpr size_t WS_H = WS_W + 2 * W_LAYER;
constexpr size_t WS_PROJ = WS_H + 128 * MiB;
constexpr size_t WS_YG = WS_PROJ + 256 * MiB;
constexpr size_t WS_O = WS_YG + 64 * MiB;
constexpr size_t WS_Y32 = WS_O + 128 * MiB;
constexpr size_t WS_ACT = WS_PROJ;
constexpr size_t WS_END = WS_Y32 + 256 * MiB;
static_assert(WS_ACT + (size_t)M * DFF * 2 <= WS_Y32, "ACT overlay");
constexpr int CW_TMO = 0, CW_BAR = 4096;

constexpr int RING_OFF = 0, RING_BYTES = 131072;
constexpr int LDSCTL_OFF = RING_BYTES, MISC_OFF = LDSCTL_OFF + 320;
constexpr int LDS_BYTES = 147456;

#define GAS __attribute__((address_space(1)))
#define LAS __attribute__((address_space(3)))
typedef unsigned short bf16;
typedef unsigned v4u __attribute__((ext_vector_type(4)));
typedef unsigned v2u __attribute__((ext_vector_type(2)));
typedef float f32x4 __attribute__((ext_vector_type(4)));
typedef float f32x8 __attribute__((ext_vector_type(8)));
typedef float f32x16 __attribute__((ext_vector_type(16)));
typedef short bf16x8 __attribute__((ext_vector_type(8)));
typedef __bf16 bfv8 __attribute__((ext_vector_type(8)));
typedef __bf16 bfv4 __attribute__((ext_vector_type(4)));
typedef __bf16 bfv2 __attribute__((ext_vector_type(2)));
typedef GAS unsigned gu32;
#define RLX_AGENT __ATOMIC_RELAXED, __HIP_MEMORY_SCOPE_AGENT
#define MFMA32(a, b, c) __builtin_amdgcn_mfma_f32_32x32x16_bf16((a), (b), (c), 0, 0, 0)

__device__ __forceinline__ bf16x8 cvt8(f32x8 v) { return __builtin_bit_cast(bf16x8, __builtin_convertvector(v, bfv8)); }
__device__ __forceinline__ v2u cvt4(f32x4 v) { return __builtin_bit_cast(v2u, __builtin_convertvector(v, bfv4)); }
__device__ __forceinline__ unsigned cvt2(float a, float b) { typedef float f2 __attribute__((ext_vector_type(2))); f2 v = {a, b}; return __builtin_bit_cast(unsigned, __builtin_convertvector(v, bfv2)); }
__device__ __forceinline__ float bf_lo(unsigned w) { return __builtin_bit_cast(float, w << 16); }
__device__ __forceinline__ float bf_hi(unsigned w) { return __builtin_bit_cast(float, w & 0xffff0000u); }
__device__ __forceinline__ float wave_sum(float v) {
#pragma unroll
    for (int o = 1; o < 64; o <<= 1) v += __shfl_xor(v, o);
    return v;
}
__device__ __forceinline__ int crow(int r, int hi) { return (r & 3) + 8 * (r >> 2) + 4 * hi; }

#define XB_TMO      128
#define XB_XCNT(j)  (256  + 64 * (j))
#define XB_XSUB(j)  (1280 + 64 * (j))
#define XB_XGEN(j)  (2304 + 64 * (j))
#define XB_TOP      3328
#define XB_TOPGEN   3392
#define XCD_BAR_WORDS 3456
#define XB_SPIN_CAP (1u << 18)

__device__ __forceinline__ unsigned xb_ld(unsigned* p)              { return __hip_atomic_load(p, __ATOMIC_RELAXED, __HIP_MEMORY_SCOPE_AGENT); }
__device__ __forceinline__ unsigned xb_add(unsigned* p, unsigned v) { return __hip_atomic_fetch_add(p, v, __ATOMIC_RELAXED, __HIP_MEMORY_SCOPE_AGENT); }
__device__ __forceinline__ unsigned xb_xcc_id() { return (unsigned)__builtin_amdgcn_s_getreg((3 << 11) | 20) & 0xFu; }
#define XB_SPIN(cond, bar) do { unsigned _sp = 0; while (cond) { __builtin_amdgcn_s_sleep(1); \
    if ((++_sp & 255u) == 0u) { if (xb_ld(&(bar)[XB_TMO])) break; if (_sp > XB_SPIN_CAP) { atomicAdd(&(bar)[XB_TMO], 1u); break; } } } } while (0)

struct XcdBarrier {
    unsigned* bar; unsigned x;
    volatile LAS unsigned* st;
};

__device__ __forceinline__ XcdBarrier xcd_barrier_post(unsigned* bar, volatile LAS unsigned* st) {
    XcdBarrier b; b.bar = bar; b.x = xb_xcc_id(); b.st = st;
    if (threadIdx.x == 0) (void)xb_add(&bar[XB_XCNT(b.x)], 1u);
    return b;
}
__device__ __forceinline__ void xcd_barrier_complete(unsigned* bar, unsigned x, unsigned& nloc, unsigned& nx) {
    const unsigned G = gridDim.x * gridDim.y * gridDim.z;
    unsigned sum, cnt, mine, sp = 0u;
    for (;;) {
        sum = 0u; cnt = 0u; mine = 0u;
#pragma unroll
        for (unsigned j = 0; j < 16; ++j) { const unsigned c = xb_ld(&bar[XB_XCNT(j)]); sum += c; cnt += (c > 0u) ? 1u : 0u; mine = (j == x) ? c : mine; }
        if (sum == G) break;
        __builtin_amdgcn_s_sleep(1);
        if ((++sp & 255u) == 0u) { if (xb_ld(&bar[XB_TMO])) break; if (sp > XB_SPIN_CAP) { atomicAdd(&bar[XB_TMO], 1u); break; } }
    }
    nloc = mine > 0u ? mine : 1u; nx = cnt > 0u ? cnt : 1u;
}

__device__ __forceinline__ void xcd_barrier(const XcdBarrier& b) {
    asm volatile("s_waitcnt vmcnt(0)" ::: "memory");
    __syncthreads();
    if (threadIdx.x == 0) {
        unsigned* bar = b.bar;
        __builtin_amdgcn_s_waitcnt(0);
        unsigned nloc = b.st[0], nx = b.st[1];
        if (nloc == 0u) { xcd_barrier_complete(bar, b.x, nloc, nx); b.st[0] = nloc; b.st[1] = nx; }
        const unsigned old = xb_add(&bar[XB_XSUB(b.x)], 1u);
        const unsigned gen = old / nloc;
        if (old + 1u == (gen + 1u) * nloc) {
            __builtin_amdgcn_fence(__ATOMIC_RELEASE, "agent");
            asm volatile("s_waitcnt vmcnt(0)" ::: "memory");
            const unsigned og = xb_add(&bar[XB_TOP], 1u);
            const unsigned tg = og / nx;
            if (og + 1u == (tg + 1u) * nx) xb_add(&bar[XB_TOPGEN], 1u);
            else XB_SPIN(xb_ld(&bar[XB_TOPGEN]) == tg, bar);
            __builtin_amdgcn_fence(__ATOMIC_ACQUIRE, "agent");
            xb_add(&bar[XB_XGEN(b.x)], 1u);
            asm volatile("s_waitcnt vmcnt(0)" ::: "memory");
        } else {
            XB_SPIN(xb_ld(&bar[XB_XGEN(b.x)]) == gen, bar);
            __builtin_amdgcn_fence(__ATOMIC_ACQUIRE, "agent");
            asm volatile("s_waitcnt vmcnt(0)" ::: "memory");
        }
    }
    __syncthreads();
}


__device__ __forceinline__ void p0_item(const float* W, int ld, int col0, int k0, const float* gain, bf16* dst, int dstK, LAS float* scr, int lane) {
#pragma unroll 8
    for (int i = 0; i < 32; ++i) { const int kk = 2 * i + (lane >> 5); float w = W[(size_t)(k0 + kk) * ld + col0 + (lane & 31)]; if (gain) w *= gain[k0 + kk]; scr[kk * 33 + (lane & 31)] = w; }
    asm volatile("s_waitcnt lgkmcnt(0)" ::: "memory");
    const int c = lane & 7;
#pragma unroll
    for (int j = 0; j < 4; ++j) { const int n = (lane >> 3) + 8 * j; const LAS float* s = scr + (8 * c) * 33 + n;
        f32x8 v = {s[0 * 33], s[1 * 33], s[2 * 33], s[3 * 33], s[4 * 33], s[5 * 33], s[6 * 33], s[7 * 33]};
        *(bf16x8*)(dst + (size_t)n * dstK + 8 * c) = cvt8(v); }
    asm volatile("s_waitcnt lgkmcnt(0)" ::: "memory");
}
constexpr int I_IN = (D / 64) * (NPROJ / 32), I_GLU = (SSMW / 64) * (SSMW / 32), I_OUT = (D / 64) * (D / 32), I_GU = (D / 64) * (NGU / 32), I_D = (DFF / 64) * (D / 32);
constexpr int I_LAYER = I_IN + I_GLU + I_OUT + I_GU + I_D;

struct Args { const float* in[23]; float* out; unsigned char* ws; };
typedef const __attribute__((address_space(4))) Args CArgs;

__device__ __forceinline__ void p0_weights(CArgs& a, LAS unsigned char* lds, int gw, int NGW, int wave, int lane) {
    LAS float* scr = (LAS float*)(lds + RING_OFF + wave * 16384);
    for (int it = gw; it < LAYERS * I_LAYER; it += NGW) {
        const int l = it / I_LAYER; int r = it - l * I_LAYER;
        unsigned char* wl = a.ws + WS_W + (size_t)l * W_LAYER;
        if (r < I_IN) { const int kb = r / (NPROJ / 32), nb = r % (NPROJ / 32); const int n0 = 32 * nb;
            p0_item(a.in[1] + (size_t)l * D * INCOLS, INCOLS, n0 + (n0 >= COL_U ? 8 : 0), 64 * kb, a.in[3] + l * D, (bf16*)(wl + W_IN) + (size_t)n0 * D + 64 * kb, D, scr, lane); continue; }
        r -= I_IN;
        if (r < I_GLU) { const int kb = r / (SSMW / 32), nb = r % (SSMW / 32);
            p0_item(a.in[16] + (size_t)l * SSMW * SSMW, SSMW, 32 * nb, 64 * kb, nullptr, (bf16*)(wl + W_GLU) + (size_t)(32 * nb) * SSMW + 64 * kb, SSMW, scr, lane); continue; }
        r -= I_GLU;
        if (r < I_OUT) { const int kb = r / (D / 32), nb = r % (D / 32);
            p0_item(a.in[2] + (size_t)l * D * D, D, 32 * nb, 64 * kb, a.in[5] + l * D, (bf16*)(wl + W_OUT) + (size_t)(32 * nb) * D + 64 * kb, D, scr, lane); continue; }
        r -= I_OUT;
        if (r < I_GU) { const int kb = r / (NGU / 32), nb = r % (NGU / 32); const int n0 = 32 * nb, tile = n0 >> 8, within = n0 & 255;
            const float* src = (within < 128 ? a.in[20] : a.in[21]) + (size_t)l * D * DFF;
            p0_item(src, DFF, 128 * tile + (within & 127), 64 * kb, a.in[18] + l * D, (bf16*)(wl + W_GU) + (size_t)n0 * D + 64 * kb, D, scr, lane); continue; }
        r -= I_GU;
        { const int kb = r / (D / 32), nb = r % (D / 32);
            p0_item(a.in[22] + (size_t)l * DFF * D, D, 32 * nb, 64 * kb, nullptr, (bf16*)(wl + W_D) + (size_t)(32 * nb) * DFF + 64 * kb, DFF, scr, lane); }
    }
}

__device__ __forceinline__ void load_row(const float* p, int lane, f32x4 (&v)[16]) {
    const f32x4* q = (const f32x4*)p + lane;
#pragma unroll
    for (int j = 0; j < 16; ++j) v[j] = q[64 * j];
}
__device__ __forceinline__ float row_sumsq(const f32x4 (&v)[16]) {
    float s = 0.f;
#pragma unroll
    for (int j = 0; j < 16; ++j) s += (v[j].x * v[j].x + v[j].y * v[j].y) + (v[j].z * v[j].z + v[j].w * v[j].w);
    return wave_sum(s);
}
__device__ __forceinline__ void store_h(bf16* hrow, int lane, const f32x4 (&v)[16], float rstd) {
    v2u* o = (v2u*)hrow + lane;
#pragma unroll
    for (int j = 0; j < 16; ++j) o[64 * j] = cvt4(v[j] * rstd);
}
__device__ __forceinline__ void build_wfb(LAS float* wfb, const float* w_in_l, const float* g, int tid) {
    for (int idx = tid; idx < 8 * D; idx += NWAVES * 64) { const int k = idx >> 3, hh = idx & 7; wfb[hh * D + k] = g[k] * w_in_l[(size_t)k * INCOLS + COL_U + hh]; }
}
__device__ __forceinline__ void fb_emit(const f32x4 (&v)[16], float rstd, const LAS float* wfb, const float* bfg, float* LS, int m, int lane) {
    float acc[8];
#pragma unroll
    for (int hh = 0; hh < 8; ++hh) acc[hh] = 0.f;
#pragma unroll
    for (int j = 0; j < 16; ++j) {
#pragma unroll
        for (int hh = 0; hh < 8; ++hh) { const f32x4 w = *(const LAS f32x4*)(wfb + hh * D + 256 * j + 4 * lane); acc[hh] += (v[j].x * w.x + v[j].y * w.y) + (v[j].z * w.z + v[j].w * w.w); }
        asm volatile("" ::: "memory");
    }
    float mine = 0.f;
#pragma unroll
    for (int hh = 0; hh < 8; ++hh) { const float s = wave_sum(acc[hh]); mine = (lane == hh) ? s : mine; }
    if (lane < 8) { const float z = mine * rstd + bfg[lane]; const float ls = fminf(z, 0.f) - log1pf(expf(-fabsf(z)));
        const int b = m / SEQ, s = m - b * SEQ; LS[(size_t)(b * NH + lane) * SEQ + s] = ls; }
}
__device__ __forceinline__ void phase_norm0(CArgs& a, LAS unsigned char* lds, int gw, int NGW, int tid, int lane) {
    LAS float* wfb = (LAS float*)(lds + RING_OFF);
    build_wfb(wfb, a.in[1], a.in[3], tid);
    __syncthreads();
    bf16* H = (bf16*)(a.ws + WS_H); float* LS = (float*)(a.ws + WS_LS);
    for (int m = gw; m < M; m += NGW) {
        f32x4 v[16]; load_row(a.in[0] + (size_t)m * D, lane, v);
        const float rstd = 1.0f / sqrtf(row_sumsq(v) * (1.0f / D) + RMS_EPS);
        store_h(H + (size_t)m * D, lane, v, rstd);
        fb_emit(v, rstd, wfb, a.in[7], LS, m, lane);
    }
    __syncthreads();
}
template <bool WRITE_H, bool DO_FB>
__device__ __forceinline__ void phase_post(CArgs& a, LAS unsigned char* lds, const float* xsrc, const float* gpost, int lnext, int gw, int NGW, int tid, int lane) {
    LAS float* wfb = (LAS float*)(lds + RING_OFF);
    if (DO_FB) { build_wfb(wfb, a.in[1] + (size_t)lnext * D * INCOLS, a.in[3] + lnext * D, tid); __syncthreads(); }
    const float* Y = (const float*)(a.ws + WS_Y32); bf16* H = (bf16*)(a.ws + WS_H); float* LS = (float*)(a.ws + WS_LS);
    for (int m = gw; m < M; m += NGW) {
        f32x4 v[16], y[16]; load_row(Y + (size_t)m * D, lane, y);
        const float ry = 1.0f / sqrtf(row_sumsq(y) * (1.0f / D) + RMS_EPS);
        const f32x4* gq = (const f32x4*)gpost + lane; const f32x4* xq = (const f32x4*)(xsrc + (size_t)m * D) + lane;
        f32x4* o = (f32x4*)(a.out + (size_t)m * D) + lane;
#pragma unroll
        for (int j = 0; j < 16; ++j) { v[j] = xq[64 * j] + (y[j] * ry) * gq[64 * j]; o[64 * j] = v[j];
            if ((j & 3) == 3) asm volatile("" ::: "memory"); }
        if (WRITE_H) {
            const float rstd = 1.0f / sqrtf(row_sumsq(v) * (1.0f / D) + RMS_EPS);
            store_h(H + (size_t)m * D, lane, v, rstd);
            if (DO_FB) fb_emit(v, rstd, wfb, a.in[7] + lnext * NH, LS, m, lane);
        }
    }
    if (DO_FB) __syncthreads();
}
__device__ __forceinline__ void phase_mixnorm(CArgs& a, int gw, int NGW, int lane) {
    bf16* O = (bf16*)(a.ws + WS_O);
    for (int m = gw; m < M; m += NGW) {
        v4u* p = (v4u*)(O + (size_t)m * D) + lane; v4u w[8]; float ss[8];
#pragma unroll
        for (int j = 0; j < 8; ++j) w[j] = p[64 * j];
#pragma unroll
        for (int j = 0; j < 8; ++j) { float s = 0.f;
#pragma unroll
            for (int e = 0; e < 4; ++e) { const float lo = bf_lo(w[j][e]), hi = bf_hi(w[j][e]); s += lo * lo + hi * hi; }
            ss[j] = s; }
        const float sa = wave_sum(ss[0] + ss[1]), sb = wave_sum(ss[2] + ss[3]), sc = wave_sum((ss[4] + ss[5]) + (ss[6] + ss[7]));
        const float ra = 1.0f / sqrtf(sa * (1.0f / 1024.f) + RMS_EPS), rb = 1.0f / sqrtf(sb * (1.0f / 1024.f) + RMS_EPS), rc = 1.0f / sqrtf(sc * (1.0f / 2048.f) + RMS_EPS);
#pragma unroll
        for (int j = 0; j < 8; ++j) { const float r = j < 2 ? ra : (j < 4 ? rb : rc); v4u o;
#pragma unroll
            for (int e = 0; e < 4; ++e) o[e] = cvt2(bf_lo(w[j][e]) * r, bf_hi(w[j][e]) * r);
            p[64 * j] = o; }
    }
}
__device__ __forceinline__ void phase_cum_knorm(CArgs& a, int l, int gw, int NGW, int lane) {
    if (gw < BATCH * NH) {
        const float* ls = (const float*)(a.ws + WS_LS) + (size_t)gw * SEQ; float* cum = (float*)(a.ws + WS_CUM) + (size_t)gw * SEQ; float carry = 0.f;
        for (int c = 0; c < SEQ / 1024; ++c) {
            f32x4 q[4];
#pragma unroll
            for (int i = 0; i < 4; ++i) q[i] = *(const f32x4*)(ls + c * 1024 + lane * 16 + 4 * i);
            float run = 0.f;
#pragma unroll
            for (int i = 0; i < 4; ++i) { q[i].x += run; q[i].y += q[i].x; q[i].z += q[i].y; q[i].w += q[i].z; run = q[i].w; }
            float inc = run;
#pragma unroll
            for (int o = 1; o < 64; o <<= 1) { const float t = __shfl_up(inc, o); if (lane >= o) inc += t; }
            const float excl = (inc - run) + carry;
#pragma unroll
            for (int i = 0; i < 4; ++i) *(f32x4*)(cum + c * 1024 + lane * 16 + 4 * i) = q[i] + excl;
            carry += __shfl(inc, 63);
        }
    }
    const bf16* P = (const bf16*)(a.ws + WS_PROJ); float* knt = (float*)(a.ws + WS_KNT);
    for (int t = gw; t < BATCH * NH * (SEQ / 64); t += NGW) {
        const int bh = t / (SEQ / 64), kt = t % (SEQ / 64), b = bh / NH, h = bh % NH; float mx = 0.f;
        const bf16* base = P + (size_t)(b * SEQ + kt * 64) * NPROJ + COL_KB + h * HD + 8 * (lane & 15);
#pragma unroll 4
        for (int it = 0; it < 16; ++it) { const v4u w = *(const v4u*)(base + (size_t)(it * 4 + (lane >> 4)) * NPROJ); float s = 0.f;
#pragma unroll
            for (int e = 0; e < 4; ++e) { const float lo = bf_lo(w[e]), hi = bf_hi(w[e]); s += lo * lo + hi * hi; }
            s += __shfl_xor(s, 1); s += __shfl_xor(s, 2); s += __shfl_xor(s, 4); s += __shfl_xor(s, 8); mx = fmaxf(mx, s); }
        mx = fmaxf(mx, __shfl_xor(mx, 16)); mx = fmaxf(mx, __shfl_xor(mx, 32));
        if (lane == 0) knt[t] = sqrtf(mx);
    }
}
namespace att {
constexpr int KROW = 272, VROW = 136, KBUF = 64 * KROW, VBUF = 128 * VROW;
constexpr int OFF_K = 0, OFF_V = 2 * KBUF, OFF_TAB = 2 * KBUF + 2 * VBUF, OFF_CK = OFF_TAB + 2304, OFF_RED = OFF_CK + 512, LDS_END = OFF_RED + 64;
static_assert(LDS_END <= RING_BYTES, "attention LDS");

template <int MODE>
__device__ __forceinline__ void attn_unit(CArgs& a, LAS unsigned char* lds, int l, int b, int h, int qb, int tid, int wave, int lane) {
    const bf16* P = (const bf16*)(a.ws + WS_PROJ);
    const int colq = MODE == 0 ? COL_QA : COL_QB, colk = MODE == 0 ? COL_KA : COL_KB, colv = MODE == 0 ? COL_VA : COL_VB;
    const int q = lane & 31, hi = lane >> 5;
    const int qpos = qb * 256 + wave * 32 + q;
    const size_t rowbase = (size_t)b * SEQ;
    const float* cum = (const float*)(a.ws + WS_CUM) + (size_t)(b * NH + h) * SEQ;
    LAS float* tab = (LAS float*)(lds + OFF_TAB);
    LAS float* ckl = (LAS float*)(lds + OFF_CK);

    int kt_first, ntiles, kt_step;
    if (MODE == 0) { kt_first = 4 * qb - 8 < 0 ? 0 : 4 * qb - 8; ntiles = 4 * qb + 3 - kt_first + 1; kt_step = 1; }
    else { kt_first = 4 * qb + 3; ntiles = 4 * qb + 4; kt_step = -1; }
    const int cq = 4 * qb + (wave >> 1);

    if (MODE == 0) { const float* rb = a.in[6] + (size_t)(l * NH + h) * 513; for (int i = tid; i < 513; i += NWAVES * 64) tab[i] = rb[i] * LOG2E; }

    bf16x8 qf[8];
    { const bf16* qp = P + (rowbase + qpos) * NPROJ + colq + h * HD + 8 * hi;
#pragma unroll
        for (int s = 0; s < 8; ++s) qf[s] = *(const bf16x8*)(qp + 16 * s); }
    float cqv = 0.f; if (MODE == 1) cqv = cum[qpos] * LOG2E;

    f32x16 O[4];
#pragma unroll
    for (int d = 0; d < 4; ++d)
#pragma unroll
        for (int r = 0; r < 16; ++r) O[d][r] = 0.f;
    float mrun = -1e30f, lsum = 0.f;

    v4u st[4]; float ckreg = 0.f;
    const bool vrole = tid < 256;
    const int kg = tid & 15, dg = (tid >> 4) & 15, t2 = tid & 255;
    const bf16* kbase = P + rowbase * NPROJ + colk + h * HD;
    const bf16* vbase = P + rowbase * NPROJ + colv + h * HD;
#define ATT_LOAD(kt) do { const size_t r0_ = (size_t)(kt) * 64; \
        if (vrole) { _Pragma("unroll") for (int i_ = 0; i_ < 4; ++i_) st[i_] = *(const v4u*)(vbase + (r0_ + 4 * kg + i_) * NPROJ + 8 * dg); } \
        else { _Pragma("unroll") for (int i_ = 0; i_ < 4; ++i_) { const int p_ = t2 + 256 * i_; st[i_] = *(const v4u*)(kbase + (r0_ + (p_ >> 4)) * NPROJ + 8 * (p_ & 15)); } } \
        if (MODE == 1 && tid < 64) ckreg = cum[r0_ + tid] * LOG2E; } while (0)
#define ATT_STORE(buf) do { \
        if (vrole) { LAS unsigned char* vb_ = lds + OFF_V + (buf) * VBUF + kg * 8; \
            _Pragma("unroll") for (int c_ = 0; c_ < 4; ++c_) { const unsigned a0 = st[0][c_], a1 = st[1][c_], a2 = st[2][c_], a3 = st[3][c_]; \
                v2u e_, o_; e_.x = (a0 & 0xffffu) | (a1 << 16); e_.y = (a2 & 0xffffu) | (a3 << 16); o_.x = (a0 >> 16) | (a1 & 0xffff0000u); o_.y = (a2 >> 16) | (a3 & 0xffff0000u); \
                *(LAS v2u*)(vb_ + (8 * dg + 2 * c_) * VROW) = e_; *(LAS v2u*)(vb_ + (8 * dg + 2 * c_ + 1) * VROW) = o_; } } \
        else { _Pragma("unroll") for (int i_ = 0; i_ < 4; ++i_) { const int p_ = t2 + 256 * i_; *(LAS v4u*)(lds + OFF_K + (buf) * KBUF + (p_ >> 4) * KROW + (p_ & 15) * 16) = st[i_]; } } \
        if (MODE == 1 && tid < 64) ckl[(buf) * 64 + tid] = ckreg; } while (0)

    ATT_LOAD(kt_first); ATT_STORE(0);
    __syncthreads();
    for (int it = 0; it < ntiles; ++it) {
        const int kt = kt_first + it * kt_step, buf = it & 1;
        if (it + 1 < ntiles) ATT_LOAD(kt + kt_step);
        const bool active = MODE == 0 ? (kt <= cq && kt >= cq - 8) : (kt <= cq);
        if (active) {
            f32x16 p0, p1;
#pragma unroll
            for (int r = 0; r < 16; ++r) { p0[r] = 0.f; p1[r] = 0.f; }
            const LAS unsigned char* kb = lds + OFF_K + buf * KBUF + q * KROW + 16 * hi;
#pragma unroll
            for (int s = 0; s < 8; ++s) {
                const bf16x8 k0 = *(const LAS bf16x8*)(kb + 32 * s), k1 = *(const LAS bf16x8*)(kb + 32 * KROW + 32 * s);
                p0 = MFMA32(k0, qf[s], p0); p1 = MFMA32(k1, qf[s], p1);
            }
            constexpr float C2 = QK_SCALE * LOG2E;
            const int key0 = kt * 64 + 4 * hi;
            if (MODE == 0) {
                if (cq - kt >= 5) { const float bc = tab[512];
#pragma unroll
                    for (int r = 0; r < 16; ++r) { p0[r] = p0[r] * C2 + bc; p1[r] = p1[r] * C2 + bc; } }
                else { const int d0 = qpos - key0 + 256;
#pragma unroll
                    for (int r = 0; r < 16; ++r) { const int c = (r & 3) + 8 * (r >> 2);
                        int i0 = d0 - c, i1 = d0 - c - 32; i0 = i0 < 0 ? 0 : (i0 > 512 ? 512 : i0); i1 = i1 < 0 ? 0 : (i1 > 512 ? 512 : i1);
                        p0[r] = p0[r] * C2 + tab[i0]; p1[r] = p1[r] * C2 + tab[i1]; } }
            } else {
                const LAS float* ck = ckl + buf * 64 + 4 * hi;
#pragma unroll
                for (int g = 0; g < 4; ++g) { const f32x4 c0 = *(const LAS f32x4*)(ck + 8 * g), c1 = *(const LAS f32x4*)(ck + 32 + 8 * g);
#pragma unroll
                    for (int e = 0; e < 4; ++e) { p0[4 * g + e] = p0[4 * g + e] * C2 + (cqv - c0[e]); p1[4 * g + e] = p1[4 * g + e] * C2 + (cqv - c1[e]); } }
                if (kt == cq) { const float NEG = -__builtin_inff();
#pragma unroll
                    for (int r = 0; r < 16; ++r) { const int key = key0 + (r & 3) + 8 * (r >> 2); if (key > qpos) p0[r] = NEG; if (key + 32 > qpos) p1[r] = NEG; } }
            }
            float mt = p0[0];
#pragma unroll
            for (int r = 1; r < 16; ++r) mt = fmaxf(mt, p0[r]);
#pragma unroll
            for (int r = 0; r < 16; ++r) mt = fmaxf(mt, p1[r]);
            mt = fmaxf(mt, __shfl_xor(mt, 32));
            const float mn = fmaxf(mrun, mt), alpha = __builtin_amdgcn_exp2f(mrun - mn);
            mrun = mn;
            float ps = 0.f;
#pragma unroll
            for (int r = 0; r < 16; ++r) { p0[r] = __builtin_amdgcn_exp2f(p0[r] - mn); p1[r] = __builtin_amdgcn_exp2f(p1[r] - mn); ps += p0[r] + p1[r]; }
            lsum = lsum * alpha + ps;
#pragma unroll
            for (int d = 0; d < 4; ++d)
#pragma unroll
                for (int r = 0; r < 16; ++r) O[d][r] *= alpha;
            bf16x8 pf[4];
            pf[0] = cvt8((f32x8){p0[0], p0[1], p0[2], p0[3], p0[4], p0[5], p0[6], p0[7]});
            pf[1] = cvt8((f32x8){p0[8], p0[9], p0[10], p0[11], p0[12], p0[13], p0[14], p0[15]});
            pf[2] = cvt8((f32x8){p1[0], p1[1], p1[2], p1[3], p1[4], p1[5], p1[6], p1[7]});
            pf[3] = cvt8((f32x8){p1[8], p1[9], p1[10], p1[11], p1[12], p1[13], p1[14], p1[15]});
            const LAS unsigned char* vb = lds + OFF_V + buf * VBUF + q * VROW + 8 * hi;
#pragma unroll
            for (int d = 0; d < 4; ++d)
#pragma unroll
                for (int ks = 0; ks < 4; ++ks) {
                    const v2u lo = *(const LAS v2u*)(vb + d * 32 * VROW + ks * 32), hh = *(const LAS v2u*)(vb + d * 32 * VROW + ks * 32 + 16);
                    const v4u vv = {lo.x, lo.y, hh.x, hh.y};
                    O[d] = MFMA32(__builtin_bit_cast(bf16x8, vv), pf[ks], O[d]);
                }
        }
        if (it + 1 < ntiles) ATT_STORE(buf ^ 1);
        __syncthreads();
    }
#undef ATT_LOAD
#undef ATT_STORE
    const float ltot = lsum + __shfl_xor(lsum, 32), inv = 1.0f / ltot;
    bf16* op = (bf16*)(a.ws + WS_O) + (rowbase + qpos) * D + MODE * 1024 + h * HD + 4 * hi;
#pragma unroll
    for (int d = 0; d < 4; ++d)
#pragma unroll
        for (int g = 0; g < 4; ++g) { const f32x4 v = {O[d][4 * g] * inv, O[d][4 * g + 1] * inv, O[d][4 * g + 2] * inv, O[d][4 * g + 3] * inv};
            *(v2u*)(op + 32 * d + 8 * g) = cvt4(v); }
}
}

namespace s5 {
constexpr int XROW = 272, XIMG = 32 * XROW, OFF_X = 0, OFF_E = 8 * XIMG, LDS_END = OFF_E + 8 * 64 * 8;
static_assert(LDS_END <= RING_BYTES, "s5 LDS");
struct LamC { float lr, li, cr, ci; };
__device__ __forceinline__ LamC lam_coef(const float* are, const float* aim, float dt, int n) {
    const float ar = fminf(are[n], -1e-4f), ai = aim[n];
    const float zr = ar * dt, zi = ai * dt;
    float sn, cs; sincosf(zi, &sn, &cs);
    const float er = expf(zr);
    LamC o; o.lr = er * cs; o.li = er * sn;
    const float sh = sinf(0.5f * zi);
    const float nr = expm1f(zr) * cs - 2.0f * sh * sh, ni = o.li;
    const float den = 1.0f / (ar * ar + ai * ai);
    o.cr = (nr * ar + ni * ai) * den; o.ci = (ni * ar - nr * ai) * den;
    return o;
}
__device__ __forceinline__ float gelu_tanh(float y) {
    const float z = 0.7978845608028654f * (y + 0.044715f * y * y * y);
    return y * __builtin_amdgcn_rcpf(1.0f + __builtin_amdgcn_exp2f(-2.0f * LOG2E * z));
}
__device__ __forceinline__ void s5_unit(CArgs& a, LAS unsigned char* lds, int l, int b, int g, int wave, int lane) {
    const int c32 = lane & 31, hi = lane >> 5;
    const float* are = a.in[8] + (size_t)(l * NG + g) * NS; const float* aim = a.in[9] + (size_t)(l * NG + g) * NS;
    const float dt = expf(a.in[10][l * NG + g]);
    const LamC me = lam_coef(are, aim, dt, lane);
    bf16x8 bb[4];
#pragma unroll
    for (int st = 0; st < 2; ++st) { const int ns = 32 * st + c32; const LamC cc = lam_coef(are, aim, dt, ns);
        const float* br = a.in[11] + ((size_t)(l * NG + g) * NS + ns) * 16 + 8 * hi; const float* bi = a.in[12] + ((size_t)(l * NG + g) * NS + ns) * 16 + 8 * hi;
        f32x8 vr, vi;
#pragma unroll
        for (int j = 0; j < 8; ++j) { const float xr = br[j], xi = bi[j]; vr[j] = cc.cr * xr - cc.ci * xi; vi[j] = cc.cr * xi + cc.ci * xr; }
        bb[st] = cvt8(vr); bb[2 + st] = cvt8(vi); }
    bf16x8 cf[8];
    { const float msk = c32 < 16 ? 1.f : 0.f; const int ii = c32 & 15;
        const float* cr = a.in[13] + ((size_t)(l * NG + g) * 16 + ii) * NS + 4 * hi; const float* ci = a.in[14] + ((size_t)(l * NG + g) * 16 + ii) * NS + 4 * hi;
#pragma unroll
        for (int s = 0; s < 8; ++s) { const f32x4 r4 = *(const f32x4*)(cr + 8 * s), i4 = *(const f32x4*)(ci + 8 * s);
            cf[s] = cvt8((f32x8){r4.x * msk, -i4.x * msk, r4.y * msk, -i4.y * msk, r4.z * msk, -i4.z * msk, r4.w * msk, -i4.w * msk}); } }
    bf16x8 df;
    { const float dv = c32 < 16 ? a.in[15][(size_t)l * SSMW + g * 16 + (c32 & 15)] : 0.f; f32x8 v;
#pragma unroll
        for (int j = 0; j < 8; ++j) v[j] = (8 * hi + j == c32) ? dv : 0.f;
        df = cvt8(v); }

    const bf16* up = (const bf16*)(a.ws + WS_PROJ) + ((size_t)b * SEQ + wave * 1024 + c32) * NPROJ + COL_U + g * 16 + 8 * hi;
    bf16* yg = (bf16*)(a.ws + WS_YG) + ((size_t)b * SEQ + wave * 1024 + c32) * SSMW + g * 16 + 4 * hi;
    LAS unsigned char* ximg = lds + OFF_X + wave * XIMG;
    LAS float* ebuf = (LAS float*)(lds + OFF_E);

    float xr = 0.f, xi = 0.f;
    for (int pass = 0; pass < 2; ++pass) {
        bf16x8 un = *(const bf16x8*)up;
        for (int sc = 0; sc < 32; ++sc) {
            const bf16x8 uf = un;
            if (sc + 1 < 32) un = *(const bf16x8*)(up + (size_t)(sc + 1) * 32 * NPROJ);
            f32x16 z;
#pragma unroll
            for (int r = 0; r < 16; ++r) z[r] = 0.f;
            f32x16 c0 = MFMA32(uf, bb[0], z), c1 = MFMA32(uf, bb[1], z), c2 = MFMA32(uf, bb[2], z), c3 = MFMA32(uf, bb[3], z);
            f32x16 re0, re1, im0, im1;
#pragma unroll
            for (int r = 0; r < 16; ++r) {
                const float f0 = c0[r], f1 = c1[r], f2 = c2[r], f3 = c3[r];
                const auto s0 = __builtin_amdgcn_permlane32_swap(__float_as_uint(f0), __float_as_uint(f1), false, false);
                const auto s1 = __builtin_amdgcn_permlane32_swap(__float_as_uint(f2), __float_as_uint(f3), false, false);
                const unsigned u00 = s0[0], u01 = s0[1], u10 = s1[0], u11 = s1[1];
                re0[r] = __uint_as_float(u00); re1[r] = __uint_as_float(u01); im0[r] = __uint_as_float(u10); im1[r] = __uint_as_float(u11);
            }
#pragma unroll
            for (int q4 = 0; q4 < 4; ++q4) {
#pragma unroll
                for (int i = 0; i < 4; ++i) { const int r = 4 * q4 + i; const float nr = me.lr * xr - me.li * xi + re0[r], ni = me.lr * xi + me.li * xr + im0[r]; xr = nr; xi = ni; re0[r] = nr; im0[r] = ni; }
#pragma unroll
                for (int i = 0; i < 4; ++i) { const int r = 4 * q4 + i; const float nr = me.lr * xr - me.li * xi + re1[r], ni = me.lr * xi + me.li * xr + im1[r]; xr = nr; xi = ni; re1[r] = nr; im1[r] = ni; }
            }
#ifdef SELFTEST
            const bool dbg = (b == 0 && g == 0 && wave == 0 && sc == 0 && pass == 1); float* dbgp = (float*)(a.ws + WS_KNT + 65536);
            if (dbg) {
#pragma unroll
                for (int r = 0; r < 16; ++r) { dbgp[4096 + (crow(r, 0) * 64 + lane) * 2] = re0[r]; dbgp[4096 + (crow(r, 0) * 64 + lane) * 2 + 1] = im0[r]; dbgp[4096 + (crow(r, 1) * 64 + lane) * 2] = re1[r]; dbgp[4096 + (crow(r, 1) * 64 + lane) * 2 + 1] = im1[r]; } }
#endif
            if (pass == 1) {
#pragma unroll
                for (int r = 0; r < 16; ++r) {
                    *(LAS unsigned*)(ximg + crow(r, 0) * XROW + 4 * lane) = cvt2(re0[r], im0[r]);
                    *(LAS unsigned*)(ximg + crow(r, 1) * XROW + 4 * lane) = cvt2(re1[r], im1[r]);
                }
                f32x16 y;
#pragma unroll
                for (int r = 0; r < 16; ++r) y[r] = 0.f;
#pragma unroll
                for (int s = 0; s < 8; ++s) { const bf16x8 xf = *(const LAS bf16x8*)(ximg + c32 * XROW + 32 * s + 16 * hi); y = MFMA32(cf[s], xf, y); }
                y = MFMA32(df, uf, y);
#ifdef SELFTEST
                if (dbg) {
#pragma unroll
                    for (int r = 0; r < 8; ++r) dbgp[8192 + c32 * 16 + crow(r, hi)] = y[r]; }
#endif
                bf16* yo = yg + (size_t)sc * 32 * SSMW;
                *(v2u*)yo = cvt4((f32x4){gelu_tanh(y[0]), gelu_tanh(y[1]), gelu_tanh(y[2]), gelu_tanh(y[3])});
                *(v2u*)(yo + 8) = cvt4((f32x4){gelu_tanh(y[4]), gelu_tanh(y[5]), gelu_tanh(y[6]), gelu_tanh(y[7])});
            }
        }
        if (pass == 0) {
            ebuf[(wave * 64 + lane) * 2] = xr; ebuf[(wave * 64 + lane) * 2 + 1] = xi;
            __syncthreads();
            float pr = me.lr, pi = me.li;
#pragma unroll
            for (int i = 0; i < 10; ++i) { const float nr = pr * pr - pi * pi, ni = 2.f * pr * pi; pr = nr; pi = ni; }
            xr = 0.f; xi = 0.f;
            for (int w2 = 0; w2 < wave; ++w2) { const float er = ebuf[(w2 * 64 + lane) * 2], ei = ebuf[(w2 * 64 + lane) * 2 + 1];
                const float nr = pr * xr - pi * xi + er, ni = pr * xi + pi * xr + ei; xr = nr; xi = ni; }
        }
    }
    __syncthreads();
}
}
#ifdef SELFTEST
namespace st {
constexpr int CW_DIAG = 2048;
__device__ __forceinline__ unsigned hash32(unsigned x) { x ^= x >> 16; x *= 0x7feb352du; x ^= x >> 15; x *= 0x846ca68bu; x ^= x >> 16; return x; }
__device__ __forceinline__ float bf2f(bf16 v) { return __builtin_bit_cast(float, (unsigned)v << 16); }
__device__ __forceinline__ void fail(unsigned* diag, int bit) { atomicOr(diag, 1u << bit); }
__device__ __forceinline__ bool close(float got, float ref, float atol, float rtol) { return fabsf(got - ref) <= atol + rtol * fabsf(ref); }
__device__ __forceinline__ float dot_bf16(const bf16* x, const bf16* y, int K, int lane) { float s = 0.f; for (int k = lane; k < K; k += 64) s += bf2f(x[k]) * bf2f(y[k]); return wave_sum(s); }
__device__ __forceinline__ float sigmoidf(float z) { return 1.0f / (1.0f + expf(-z)); }

__device__ __forceinline__ void check_weights(CArgs& a, unsigned* diag, int wave, int lane) {
    for (int l = 0; l < LAYERS; ++l) {
        const unsigned char* wl = a.ws + WS_W + (size_t)l * W_LAYER;
        for (int it = 0; it < 4; ++it) {
            const unsigned hsh = hash32((unsigned)(l * 1000 + wave * 64 + lane + it * 7919));
            bool ok = true;
            { const int n = hsh % NPROJ, k = (hsh >> 13) % D; const float ref = a.in[1][(size_t)l * D * INCOLS + (size_t)k * INCOLS + (n < COL_U ? n : n + 8)] * a.in[3][l * D + k];
              ok = ok && close(bf2f(((const bf16*)(wl + W_IN))[(size_t)n * D + k]), ref, 1e-6f, 0.01f); }
            { const int n = hsh % SSMW, k = (hsh >> 13) % SSMW; const float ref = a.in[16][(size_t)l * SSMW * SSMW + (size_t)k * SSMW + n];
              ok = ok && close(bf2f(((const bf16*)(wl + W_GLU))[(size_t)n * SSMW + k]), ref, 1e-6f, 0.01f); }
            { const int n = hsh % D, k = (hsh >> 13) % D; const float ref = a.in[2][(size_t)l * D * D + (size_t)k * D + n] * a.in[5][l * D + k];
              ok = ok && close(bf2f(((const bf16*)(wl + W_OUT))[(size_t)n * D + k]), ref, 1e-6f, 0.01f); }
            { const int r = hsh % NGU, k = (hsh >> 13) % D; const int tile = r >> 8, within = r & 255; const float* src = within < 128 ? a.in[20] : a.in[21];
              const float ref = src[(size_t)l * D * DFF + (size_t)k * DFF + 128 * tile + (within & 127)] * a.in[18][l * D + k];
              ok = ok && close(bf2f(((const bf16*)(wl + W_GU))[(size_t)r * D + k]), ref, 1e-6f, 0.01f); }
            { const int n = hsh % D, k = (hsh >> 13) % DFF; const float ref = a.in[22][(size_t)l * DFF * D + (size_t)k * D + n];
              ok = ok && close(bf2f(((const bf16*)(wl + W_D))[(size_t)n * DFF + k]), ref, 1e-6f, 0.01f); }
            if (!ok) fail(diag, 6);
        }
    }
}
__device__ __forceinline__ void check_norm_fb(CArgs& a, unsigned* diag, int l, const float* xsrc, int wave, int lane) {
    const int m = hash32(77u + wave) % M; const float* x = xsrc + (size_t)m * D;
    float ss = 0.f; for (int k = lane; k < D; k += 64) ss += x[k] * x[k];
    ss = wave_sum(ss); const float rstd = 1.0f / sqrtf(ss / D + RMS_EPS);
    const bf16* H = (const bf16*)(a.ws + WS_H) + (size_t)m * D; bool ok = true;
    for (int k = lane; k < D; k += 64) ok = ok && close(bf2f(H[k]), x[k] * rstd, 1e-3f, 0.01f);
    for (int hh = 0; hh < NH; ++hh) { float s = 0.f;
        for (int k = lane; k < D; k += 64) s += x[k] * rstd * a.in[3][l * D + k] * a.in[1][(size_t)l * D * INCOLS + (size_t)k * INCOLS + COL_U + hh];
        s = wave_sum(s) + a.in[7][l * NH + hh]; const float ls = fminf(s, 0.f) - log1pf(expf(-fabsf(s)));
        const int b = m / SEQ, sq = m % SEQ; ok = ok && close(((const float*)(a.ws + WS_LS))[(size_t)(b * NH + hh) * SEQ + sq], ls, 2e-3f, 2e-3f); }
    if (!__all(ok)) { if (lane == 0) fail(diag, 8); }
}
__device__ __forceinline__ void check_cum(CArgs& a, unsigned* diag, int wave, int lane) {
    const int seq = hash32(5u + wave) % (BATCH * NH), s = hash32(99u + wave) % SEQ; const float* ls = (const float*)(a.ws + WS_LS) + (size_t)seq * SEQ;
    float t = 0.f; for (int i = lane; i <= s; i += 64) t += ls[i];
    t = wave_sum(t); const float got = ((const float*)(a.ws + WS_CUM))[(size_t)seq * SEQ + s];
    if (!close(got, t, 0.05f, 1e-3f)) { if (lane == 0) fail(diag, 8); }
}
template <bool F32OUT>
__device__ __forceinline__ void check_gemm(unsigned* diag, int bit, const bf16* A, int lda, const bf16* Bt, int K, const void* Out, int ldo, int Mr, int N, unsigned seed, int wave, int lane) {
    for (int it = 0; it < 4; ++it) { const unsigned hsh = hash32(seed + wave * 16 + it); const int m = hsh % Mr, n = (hsh >> 11) % N;
        const float ref = dot_bf16(A + (size_t)m * lda, Bt + (size_t)n * K, K, lane);
        const float got = F32OUT ? ((const float*)Out)[(size_t)m * ldo + n] : bf2f(((const bf16*)Out)[(size_t)m * ldo + n]);
        if (!close(got, ref, 0.02f, 0.02f)) { if (lane == 0) fail(diag, bit); } }
}
template <int MODE>
__device__ __forceinline__ void check_attn(CArgs& a, unsigned* diag, int l, int wave, int lane) {
    const unsigned hsh = hash32(1234u + MODE * 100 + wave);
    const int b = hsh & 1, h = (hsh >> 1) & 7; int qpos = (hsh >> 4) % SEQ; if (MODE == 1 && wave >= 2) qpos %= 1500;
    if (wave == 0) qpos = 17; if (wave == 1) qpos = MODE == 0 ? 8191 : 700;
    const bf16* P = (const bf16*)(a.ws + WS_PROJ); const int colq = MODE == 0 ? COL_QA : COL_QB, colk = MODE == 0 ? COL_KA : COL_KB, colv = MODE == 0 ? COL_VA : COL_VB;
    const bf16* qrow = P + ((size_t)b * SEQ + qpos) * NPROJ + colq + h * HD;
    const float q0 = bf2f(qrow[lane]), q1 = bf2f(qrow[lane + 64]);
    const float* cum = (const float*)(a.ws + WS_CUM) + (size_t)(b * NH + h) * SEQ;
    const float* rb = a.in[6] + (size_t)(l * NH + h) * 513;
    int klo, khi;
    if (MODE == 0) { const int c = qpos / 64; klo = (c - 8) * 64; if (klo < 0) klo = 0; khi = c * 64 + 63; } else { klo = 0; khi = qpos; }
    float mx = -1e30f, lsum = 0.f, o0 = 0.f, o1 = 0.f;
    for (int j = klo; j <= khi; ++j) {
        const bf16* krow = P + ((size_t)b * SEQ + j) * NPROJ + colk + h * HD; const bf16* vrow = P + ((size_t)b * SEQ + j) * NPROJ + colv + h * HD;
        float s = wave_sum(q0 * bf2f(krow[lane]) + q1 * bf2f(krow[lane + 64])) * QK_SCALE;
        if (MODE == 0) { int dd = qpos - j; dd = dd < -256 ? -256 : (dd > 256 ? 256 : dd); s += rb[dd + 256]; } else s += cum[qpos] - cum[j];
        const float mn = fmaxf(mx, s), al = expf(mx - mn), p = expf(s - mn);
        lsum = lsum * al + p; o0 = o0 * al + p * bf2f(vrow[lane]); o1 = o1 * al + p * bf2f(vrow[lane + 64]); mx = mn;
    }
    const bf16* orow = (const bf16*)(a.ws + WS_O) + ((size_t)b * SEQ + qpos) * D + MODE * 1024 + h * HD;
    const bool ok = close(bf2f(orow[lane]), o0 / lsum, 0.02f, 0.03f) && close(bf2f(orow[lane + 64]), o1 / lsum, 0.02f, 0.03f);
    if (!__all(ok)) { if (lane == 0) fail(diag, 1 + MODE); }
}
__device__ __forceinline__ void check_s5(CArgs& a, unsigned* diag, int l, int wave, int lane) {
    const unsigned hsh = hash32(4321u + wave); const int b = hsh & 1, g = (hsh >> 1) % NG, t = wave == 0 ? 3 : wave == 1 ? 31 : wave == 2 ? 33 : wave == 3 ? 100 : wave == 4 ? 1023 : wave == 5 ? 1024 : wave == 6 ? 1100 : 3000;
    const float ar = fminf(a.in[8][(size_t)(l * NG + g) * NS + lane], -1e-4f), ai = a.in[9][(size_t)(l * NG + g) * NS + lane], dt = expf(a.in[10][l * NG + g]);
    const float er = expf(ar * dt), lr = er * cosf(ai * dt), li = er * sinf(ai * dt);
    const float nr = lr - 1.f, ni = li, den = ar * ar + ai * ai, cr = (nr * ar + ni * ai) / den, ci = (ni * ar - nr * ai) / den;
    float bbr[16], bbi[16];
#pragma unroll
    for (int j = 0; j < 16; ++j) { const float xr = a.in[11][((size_t)(l * NG + g) * NS + lane) * 16 + j], xi = a.in[12][((size_t)(l * NG + g) * NS + lane) * 16 + j]; bbr[j] = cr * xr - ci * xi; bbi[j] = cr * xi + ci * xr; }
    const bf16* P = (const bf16*)(a.ws + WS_PROJ);
    float xr = 0.f, xi = 0.f;
    for (int s = 0; s <= t; ++s) { const bf16* u = P + ((size_t)b * SEQ + s) * NPROJ + COL_U + g * 16; float br = 0.f, bi = 0.f;
#pragma unroll
        for (int j = 0; j < 16; ++j) { const float uv = bf2f(u[j]); br += bbr[j] * uv; bi += bbi[j] * uv; }
        const float tr = lr * xr - li * xi + br, ti = lr * xi + li * xr + bi; xr = tr; xi = ti; }
    const bf16* u = P + ((size_t)b * SEQ + t) * NPROJ + COL_U + g * 16; const bf16* yg = (const bf16*)(a.ws + WS_YG) + ((size_t)b * SEQ + t) * SSMW + g * 16;
    bool ok = true;
    for (int i = 0; i < 16; ++i) { const float c_r = a.in[13][((size_t)(l * NG + g) * 16 + i) * NS + lane], c_i = a.in[14][((size_t)(l * NG + g) * 16 + i) * NS + lane];
        float y = wave_sum(c_r * xr - c_i * xi) + a.in[15][(size_t)l * SSMW + g * 16 + i] * bf2f(u[i]);
        const float z = 0.7978845608028654f * (y + 0.044715f * y * y * y); y = y / (1.0f + expf(-2.0f * z));
        ok = ok && close(bf2f(yg[i]), y, 0.01f, 0.03f); }
    if (!ok) { if (lane == 0) fail(diag, 3); }
}
__device__ __forceinline__ void check_glu(CArgs& a, unsigned* diag, int l, int wave, int lane) {
    for (int it = 0; it < 4; ++it) { const unsigned hsh = hash32(555u + wave * 16 + it); const int m = hsh % M, n = (hsh >> 11) % SSMW;
        const bf16* Y = (const bf16*)(a.ws + WS_YG) + (size_t)m * SSMW;
        const float z = dot_bf16(Y, (const bf16*)(a.ws + WS_W + (size_t)l * W_LAYER + W_GLU) + (size_t)n * SSMW, SSMW, lane) + a.in[17][(size_t)l * SSMW + n];
        const float ref = bf2f(Y[n]) * sigmoidf(z), got = bf2f(((const bf16*)(a.ws + WS_O))[(size_t)m * D + 2048 + n]);
        if (!close(got, ref, 0.01f, 0.02f)) { if (lane == 0) fail(diag, 4); } }
}
__device__ __forceinline__ void check_act(CArgs& a, unsigned* diag, int l, int wave, int lane) {
    for (int it = 0; it < 4; ++it) { const unsigned hsh = hash32(777u + wave * 16 + it); const int m = hsh % M, n = (hsh >> 11) % DFF;
        const bf16* H = (const bf16*)(a.ws + WS_H) + (size_t)m * D; const bf16* W = (const bf16*)(a.ws + WS_W + (size_t)l * W_LAYER + W_GU);
        const int tile = n >> 7, within = n & 127;
        const float gt = dot_bf16(H, W + (size_t)(256 * tile + within) * D, D, lane), up = dot_bf16(H, W + (size_t)(256 * tile + 128 + within) * D, D, lane);
        const float ref = gt * sigmoidf(gt) * up, got = bf2f(((const bf16*)(a.ws + WS_ACT))[(size_t)m * DFF + n]);
        if (!close(got, ref, 0.02f, 0.03f)) { if (lane == 0) fail(diag, 5); } }
}
__device__ __forceinline__ void check_mix(CArgs& a, unsigned* diag, int wave, int lane) {
    const int m = hash32(31u + wave) % M; const bf16* X = (const bf16*)(a.ws + WS_O) + (size_t)m * D; float sa = 0.f, sb = 0.f, sc = 0.f;
    for (int k = lane; k < 1024; k += 64) { const float x = bf2f(X[k]), y = bf2f(X[1024 + k]); sa += x * x; sb += y * y; }
    for (int k = lane; k < 2048; k += 64) { const float x = bf2f(X[2048 + k]); sc += x * x; }
    sa = wave_sum(sa) / 1024.f; sb = wave_sum(sb) / 1024.f; sc = wave_sum(sc) / 2048.f;
    if (!(close(sa, 1.f, 0.f, 0.02f) && close(sb, 1.f, 0.f, 0.02f) && close(sc, 1.f, 0.f, 0.02f))) { if (lane == 0) fail(diag, 8); }
}
__device__ __forceinline__ void check_post(CArgs& a, unsigned* diag, const float* xsrc_old_is_gone, const float* gpost, bool check_h, int wave, int lane) {
    const int m = hash32(911u + wave) % M; const float* y = (const float*)(a.ws + WS_Y32) + (size_t)m * D; const float* xn = a.out + (size_t)m * D;
    bool ok = true;
    if (xsrc_old_is_gone) { float ss = 0.f; for (int k = lane; k < D; k += 64) ss += y[k] * y[k];
        ss = wave_sum(ss); const float ry = 1.0f / sqrtf(ss / D + RMS_EPS);
        for (int k = lane; k < D; k += 64) ok = ok && close(xn[k], xsrc_old_is_gone[(size_t)m * D + k] + y[k] * ry * gpost[k], 1e-4f, 1e-4f); }
    if (check_h) { float ss = 0.f; for (int k = lane; k < D; k += 64) ss += xn[k] * xn[k];
        ss = wave_sum(ss); const float r = 1.0f / sqrtf(ss / D + RMS_EPS); const bf16* H = (const bf16*)(a.ws + WS_H) + (size_t)m * D;
        for (int k = lane; k < D; k += 64) ok = ok && close(bf2f(H[k]), xn[k] * r, 1e-3f, 0.01f); }
    if (!__all(ok)) { if (lane == 0) fail(diag, 8); }
}
__device__ __forceinline__ void check_s5_dump(CArgs& a, unsigned* diag2, int l, int lane) {
    const int b = 0, g = 0; const float* dbgp = (const float*)(a.ws + WS_KNT + 65536);
    const float ar = fminf(a.in[8][(size_t)(l * NG + g) * NS + lane], -1e-4f), ai = a.in[9][(size_t)(l * NG + g) * NS + lane], dt = expf(a.in[10][l * NG + g]);
    const float er = expf(ar * dt), lr = er * cosf(ai * dt), li = er * sinf(ai * dt);
    const float nr = lr - 1.f, ni = li, den = ar * ar + ai * ai, cr = (nr * ar + ni * ai) / den, ci = (ni * ar - nr * ai) / den;
    float bbr[16], bbi[16];
#pragma unroll
    for (int j = 0; j < 16; ++j) { const float xr = a.in[11][((size_t)(l * NG + g) * NS + lane) * 16 + j], xi = a.in[12][((size_t)(l * NG + g) * NS + lane) * 16 + j]; bbr[j] = cr * xr - ci * xi; bbi[j] = cr * xi + ci * xr; }
    const bf16* P = (const bf16*)(a.ws + WS_PROJ);
    float xr = 0.f, xi = 0.f; bool okbu = true, okx = true, oky = true, oky2 = true;
    for (int s = 0; s < 32; ++s) { const bf16* u = P + ((size_t)b * SEQ + s) * NPROJ + COL_U + g * 16; float br = 0.f, bi = 0.f;
#pragma unroll
        for (int j = 0; j < 16; ++j) { const float uv = bf2f(u[j]); br += bbr[j] * uv; bi += bbi[j] * uv; }
        { const float pxr = s ? dbgp[4096 + ((s - 1) * 64 + lane) * 2] : 0.f, pxi = s ? dbgp[4096 + ((s - 1) * 64 + lane) * 2 + 1] : 0.f;
          const float gbr = dbgp[4096 + (s * 64 + lane) * 2] - (lr * pxr - li * pxi), gbi = dbgp[4096 + (s * 64 + lane) * 2 + 1] - (lr * pxi + li * pxr);
          okbu = okbu && close(gbr, br, 3e-4f, 0.02f) && close(gbi, bi, 3e-4f, 0.02f); }
        const float tr = lr * xr - li * xi + br, ti = lr * xi + li * xr + bi; xr = tr; xi = ti;
        okx = okx && close(dbgp[4096 + (s * 64 + lane) * 2], xr, 5e-4f, 0.02f) && close(dbgp[4096 + (s * 64 + lane) * 2 + 1], xi, 5e-4f, 0.02f);
        const float dxr = dbgp[4096 + (s * 64 + lane) * 2], dxi = dbgp[4096 + (s * 64 + lane) * 2 + 1];
        for (int i = 0; i < 16; ++i) { const float c_r = a.in[13][((size_t)(l * NG + g) * 16 + i) * NS + lane], c_i = a.in[14][((size_t)(l * NG + g) * 16 + i) * NS + lane];
            const float du = a.in[15][(size_t)l * SSMW + g * 16 + i] * bf2f(u[i]);
            const float y1 = wave_sum(c_r * xr - c_i * xi) + du, y2 = wave_sum(c_r * dxr - c_i * dxi) + du, got = dbgp[8192 + s * 16 + i];
            oky = oky && close(got, y1, 0.01f, 0.02f); oky2 = oky2 && close(got, y2, 0.01f, 0.02f); }
    }
    if (!__all(okbu)) { if (lane == 0) fail(diag2, 0); }
    if (!__all(okx)) { if (lane == 0) fail(diag2, 1); }
    if (!oky) { if (lane == 0) fail(diag2, 2); }
    if (!oky2) { if (lane == 0) fail(diag2, 3); }
}
}
#endif
#ifndef ST_SEL
#define ST_SEL 0xFFFF
#endif
#define ST_ON(k) ((ST_SEL >> (k)) & 1)
#ifndef ST_LAYER
#define ST_LAYER 0
#endif
#ifndef PH_ENABLE
#define PH_ENABLE 0xFFFFFF
#endif
#define PH(b) ((PH_ENABLE >> (b)) & 1)
#define argp() (*({ CArgs* p_ = (CArgs*)__builtin_amdgcn_kernarg_segment_ptr(); asm volatile("" : "+s"(p_)); p_; }))
#define GRID_BAR() do { XcdBarrier b_ = bar; asm volatile("" : "+s"(b_.bar), "+s"(b_.x)); xcd_barrier(b_); } while (0)
#define tidp() ({ int t_ = (int)threadIdx.x; asm volatile("" : "+v"(t_)); t_; })
__global__ void __launch_bounds__(NWAVES * 64, 2) hybrid_fwd(Args args) {
    extern __shared__ __attribute__((aligned(16))) unsigned char lds_raw[];
    LAS unsigned char* lds = (LAS unsigned char*)lds_raw;
    const int tid = threadIdx.x, lane = tid & 63, wave = __builtin_amdgcn_readfirstlane(tid >> 6);
    const int G = gridDim.x, bx = blockIdx.x;
    const int vcu = (G % 8 == 0) ? (bx % 8) * (G / 8) + bx / 8 : bx;
    const int gw = vcu * NWAVES + wave, NGW = G * NWAVES;
    for (int u = tid; u < (LDS_BYTES - LDSCTL_OFF) / 4; u += NWAVES * 64) ((LAS unsigned*)(lds + LDSCTL_OFF))[u] = 0u;
    __syncthreads();
    volatile LAS unsigned* MISC = (volatile LAS unsigned*)(lds + MISC_OFF);
    XcdBarrier bar = xcd_barrier_post((unsigned*)(argp().ws + WS_CTL) + CW_BAR, MISC + 8);

    if (PH(0)) p0_weights(argp(), lds, gw, NGW, wave, tidp() & 63);
    __syncthreads();
    if (PH(1)) { const int t = tidp(); phase_norm0(argp(), lds, gw, NGW, t, t & 63); }
    GRID_BAR();
#ifdef SELFTEST
    { CArgs& A_ = argp(); unsigned* diag = (unsigned*)(A_.ws + WS_CTL) + st::CW_DIAG; const int ln = tidp() & 63; if (ST_ON(0) && vcu == 0) st::check_weights(A_, diag, wave, ln); if (ST_ON(0) && vcu == 1) st::check_norm_fb(A_, diag, 0, A_.in[0], wave, ln); }
    GRID_BAR();
#define ST(cond, code) do { if (l == ST_LAYER && (cond)) { CArgs& A_ = argp(); unsigned* diag = (unsigned*)(A_.ws + WS_CTL) + st::CW_DIAG; const int ln = tidp() & 63; code; } GRID_BAR(); } while (0)
#else
#define ST(cond, code) do { } while (0)
#endif

    for (int l = 0; l < LAYERS; ++l) {
        if (PH(2)) { unsigned char* ws = argp().ws; unsigned char* wl = ws + WS_W + (size_t)l * W_LAYER; pg8::Gemm g{(const pg8::bf16_t*)(ws + WS_H), (const pg8::bf16_t*)(wl + W_IN), M, NPROJ, D}; pg8::StaticOrder S; S.init(M, NPROJ, G, bx);
          pg8::EpiStoreBf16 E{(pg8::bf16_t*)(ws + WS_PROJ), NPROJ};
          pg8::gemm_phase<pg8::EpiStoreBf16, pg8::StaticOrder, PG8_ALIGN, PG8_SP2>(lds + RING_OFF, g, S, E, tidp()); }
        GRID_BAR();
        ST(ST_ON(1) && vcu == 2, st::check_gemm<false>(diag, 0, (const bf16*)(A_.ws + WS_H), D, (const bf16*)(A_.ws + WS_W + (size_t)l * W_LAYER + W_IN), D, A_.ws + WS_PROJ, NPROJ, M, NPROJ, 101u, wave, ln));
        if (PH(3)) phase_cum_knorm(argp(), l, gw, NGW, tidp() & 63);
        GRID_BAR();
        ST(ST_ON(2) && vcu == 3, st::check_cum(A_, diag, wave, ln));
        if (PH(4)) for (int u = vcu; u < BATCH * NG; u += G) s5::s5_unit(argp(), lds, l, u >> 7, u & 127, wave, tidp() & 63);
        if (PH(5)) for (int u = vcu; u < 256; u += G) { const int bh = u >> 4, x = u & 15;
            for (int k = 0; k < 2; ++k) { const int t = tidp(); att::attn_unit<0>(argp(), lds, l, bh >> 3, bh & 7, k ? x + 16 : x, t, wave, t & 63); } }
        if (PH(6)) for (int u = vcu; u < 256; u += G) { const int bh = u >> 4, x = u & 15;
            for (int k = 0; k < 2; ++k) { const int t = tidp(); att::attn_unit<1>(argp(), lds, l, bh >> 3, bh & 7, k ? 31 - x : x, t, wave, t & 63); } }
        GRID_BAR();
        ST(ST_ON(3) && vcu >= 4 && vcu <= 7, if (vcu == 4) st::check_attn<0>(A_, diag, l, wave, ln); if (vcu == 5) st::check_attn<1>(A_, diag, l, wave, ln); if (vcu == 6) st::check_s5(A_, diag, l, wave, ln); if (vcu == 7 && wave == 0) st::check_s5_dump(A_, diag + 64, l, ln));
        if (PH(7)) { CArgs& A_ = argp(); unsigned char* ws = A_.ws; unsigned char* wl = ws + WS_W + (size_t)l * W_LAYER; pg8::Gemm g{(const pg8::bf16_t*)(ws + WS_YG), (const pg8::bf16_t*)(wl + W_GLU), M, SSMW, SSMW}; pg8::StaticOrder S; S.init(M, SSMW, G, bx);
          pg8::EpiGlu E{(const pg8::bf16_t*)(ws + WS_YG), SSMW, (pg8::bf16_t*)(ws + WS_O) + 2048, D, A_.in[17] + (size_t)l * SSMW};
          pg8::gemm_phase<pg8::EpiGlu, pg8::StaticOrder, PG8_ALIGN, PG8_SP2>(lds + RING_OFF, g, S, E, tidp()); }
        GRID_BAR();
        ST(ST_ON(4) && vcu == 7, st::check_glu(A_, diag, l, wave, ln));
        if (PH(8)) phase_mixnorm(argp(), gw, NGW, tidp() & 63);
        GRID_BAR();
        ST(ST_ON(5) && vcu == 8, st::check_mix(A_, diag, wave, ln));
        if (PH(9)) { unsigned char* ws = argp().ws; unsigned char* wl = ws + WS_W + (size_t)l * W_LAYER; pg8::Gemm g{(const pg8::bf16_t*)(ws + WS_O), (const pg8::bf16_t*)(wl + W_OUT), M, D, D}; pg8::StaticOrder S; S.init(M, D, G, bx);
          pg8::EpiStoreF32 E{(float*)(ws + WS_Y32), D};
          pg8::gemm_phase<pg8::EpiStoreF32, pg8::StaticOrder, PG8_ALIGN, PG8_SP2>(lds + RING_OFF, g, S, E, tidp()); }
        GRID_BAR();
        ST(ST_ON(6) && vcu == 9, st::check_gemm<true>(diag, 7, (const bf16*)(A_.ws + WS_O), D, (const bf16*)(A_.ws + WS_W + (size_t)l * W_LAYER + W_OUT), D, A_.ws + WS_Y32, D, M, D, 202u, wave, ln));
        if (PH(10)) { CArgs& A_ = argp(); phase_post<true, false>(A_, lds, l == 0 ? A_.in[0] : (const float*)A_.out, A_.in[4] + (size_t)l * D, 0, gw, NGW, tidp(), tidp() & 63); }
        GRID_BAR();
        ST(ST_ON(7) && vcu == 10, st::check_post(A_, diag, l == 0 ? A_.in[0] : nullptr, A_.in[4] + (size_t)l * D, true, wave, ln));
        if (PH(11)) { unsigned char* ws = argp().ws; unsigned char* wl = ws + WS_W + (size_t)l * W_LAYER; pg8::Gemm g{(const pg8::bf16_t*)(ws + WS_H), (const pg8::bf16_t*)(wl + W_GU), M, NGU, D}; pg8::StaticOrder S; S.init(M, NGU, G, bx);
          pg8::EpiSwiGlu E{(pg8::bf16_t*)(ws + WS_ACT), DFF};
          pg8::gemm_phase<pg8::EpiSwiGlu, pg8::StaticOrder, PG8_ALIGN, PG8_SP2>(lds + RING_OFF, g, S, E, tidp()); }
        GRID_BAR();
        ST(ST_ON(8) && vcu == 11, st::check_act(A_, diag, l, wave, ln));
        if (PH(12)) { unsigned char* ws = argp().ws; unsigned char* wl = ws + WS_W + (size_t)l * W_LAYER; pg8::Gemm g{(const pg8::bf16_t*)(ws + WS_ACT), (const pg8::bf16_t*)(wl + W_D), M, D, DFF}; pg8::StaticOrder S; S.init(M, D, G, bx);
          pg8::EpiStoreF32 E{(float*)(ws + WS_Y32), D};
          pg8::gemm_phase<pg8::EpiStoreF32, pg8::StaticOrder, PG8_ALIGN, PG8_SP2>(lds + RING_OFF, g, S, E, tidp()); }
        GRID_BAR();
        ST(ST_ON(9) && vcu == 12, st::check_gemm<true>(diag, 9, (const bf16*)(A_.ws + WS_ACT), DFF, (const bf16*)(A_.ws + WS_W + (size_t)l * W_LAYER + W_D), DFF, A_.ws + WS_Y32, D, M, D, 303u, wave, ln));
        if (!PH(13)) {} else if (l + 1 < LAYERS) { CArgs& A_ = argp(); phase_post<true, true>(A_, lds, (const float*)A_.out, A_.in[19] + (size_t)l * D, l + 1, gw, NGW, tidp(), tidp() & 63); GRID_BAR(); }
        else { CArgs& A_ = argp(); phase_post<false, false>(A_, lds, (const float*)A_.out, A_.in[19] + (size_t)l * D, 0, gw, NGW, tidp(), tidp() & 63); }
    }
#ifdef SELFTEST
    GRID_BAR();
    if (bx == 0 && tid == 0) { unsigned* diag = (unsigned*)(argp().ws + WS_CTL) + st::CW_DIAG; const unsigned mask = __hip_atomic_load(diag, RLX_AGENT);
        const unsigned mask2 = __hip_atomic_load(diag + 64, RLX_AGENT);
        if (mask2) argp().out[1] = (float)(10u + mask2) * 1.0e6f;
        else if (mask) { float v = (float)(10u + (mask & 63u)) * 1000.0f; for (unsigned e = 0; e < (mask >> 6); ++e) v *= 10.0f; argp().out[0] = v; } }
#endif
}

extern "C" void kernel_launch(void* const* d_in, const int* in_sizes, int n_in, void* d_out, int out_size, void* d_ws, size_t ws_size, hipStream_t stream) {
    static int grid = 0;
    if (grid == 0) {
        if (n_in != 23 || in_sizes[0] != M * D || out_size != M * D || ws_size < WS_END) {
            fprintf(stderr, "kernel_launch: unexpected shapes: n_in %d in0 %d out %d ws %zu (need %zu)\n", n_in, n_in > 0 ? in_sizes[0] : -1, out_size, ws_size, (size_t)WS_END); grid = -1; return; }
        int dev = 0, cus = 0, per_cu = 0;
        if (hipGetDevice(&dev) != hipSuccess || hipDeviceGetAttribute(&cus, hipDeviceAttributeMultiprocessorCount, dev) != hipSuccess) { grid = -1; return; }
        if (hipFuncSetAttribute((const void*)hybrid_fwd, hipFuncAttributeMaxDynamicSharedMemorySize, LDS_BYTES) != hipSuccess) { fprintf(stderr, "kernel_launch: hipFuncSetAttribute failed\n"); grid = -1; return; }
        if (hipOccupancyMaxActiveBlocksPerMultiprocessor(&per_cu, (const void*)hybrid_fwd, NWAVES * 64, LDS_BYTES) != hipSuccess || per_cu < 1)
            fprintf(stderr, "kernel_launch: occupancy query reports %d workgroups per CU\n", per_cu);
        (void)hipGetLastError();
        grid = cus;
    }
    if (grid < 0) return;
    if (hipMemsetAsync((char*)d_ws + WS_CTL, 0, CTL_ZERO_BYTES, stream) != hipSuccess) return;
    Args a{};
    for (int i = 0; i < 23; ++i) a.in[i] = (const float*)d_in[i];
    a.out = (float*)d_out; a.ws = (unsigned char*)d_ws;
    hipLaunchKernelGGL(hybrid_fwd, dim3(grid), dim3(NWAVES * 64), LDS_BYTES, stream, a);
    const hipError_t le = hipPeekAtLastError();
    if (le != hipSuccess) fprintf(stderr, "kernel_launch: launch failed: %s\n", hipGetErrorName(le));
}
```

```cpp
#include <hip/hip_runtime.h>
#include <cstdio>
#include <cstdint>
namespace pg8 {
#define PG8_LAS __attribute__((address_space(3)))
typedef unsigned short bf16_t;
typedef short bf16x8 __attribute__((ext_vector_type(8)));
typedef float f32x4 __attribute__((ext_vector_type(4)));
typedef unsigned u32x4 __attribute__((ext_vector_type(4)));
constexpr int BM = 256, BK = 64, HALF = 128, HTB = HALF * BK * 2  , STAGE_BYTES = 8 * HTB, NXCD = 8, WGM = 8;

__host__ __device__ __forceinline__ int lds_byte(int r, int c) { const int st = (r >> 4) * 2 + (c >> 5), rr = r & 15, cc = c & 31, ob = rr * 64 + cc * 2; return st * 1024 + (ob ^ (((ob >> 9) & 1) << 5)); }
__host__ __device__ __forceinline__ void stage_rc(int b, int& R, int& C) { const int st = b / 1024, sb = b % 1024, swz = sb ^ (((sb >> 9) & 1) << 5); R = (st >> 1) * 16 + swz / 64; C = (st & 1) * 32 + (swz % 64) / 2; }
__host__ __device__ __forceinline__ int perm32(int rho) { const int n = rho >> 4, i = rho & 15; return 8 * (i >> 2) + 4 * n + (i & 3); }

struct Unit { int pm, pn; };
struct Gemm { const bf16_t* A; const bf16_t* Bt; int M, N, K; };

struct StaticOrder {
    int nM, nN, nwg, G, c;
    __host__ __device__ void init(int M, int N, int G_, int c_) { nM = M / BM; nN = N / BM; nwg = nM * nN; G = G_; c = c_; }
    __host__ __device__ bool next(int i, Unit& u) const {
        const long L = (long)i * G + c; if (L >= nwg) return false;
        int wgid = (int)L; { const int q = nwg / NXCD, r = nwg % NXCD, xcd = wgid % NXCD, off = wgid / NXCD; wgid = (xcd < r ? xcd * (q + 1) : r * (q + 1) + (xcd - r) * q) + off; }
        const int nig = WGM * nN, gid = wgid / nig, fm = gid * WGM, gsz = (nM - fm) < WGM ? (nM - fm) : WGM;
        u.pm = fm + ((wgid % nig) % gsz); u.pn = (wgid % nig) / gsz; return true;
    }
    __device__ __forceinline__ void a_ready(const Unit&) const {}
    __device__ __forceinline__ void done(const Unit&) const {}
};

__device__ __forceinline__ unsigned cvt_pk_bf16(float lo, float hi) { unsigned r; asm volatile("v_cvt_pk_bf16_f32 %0, %1, %2" : "=v"(r) : "v"(lo), "v"(hi)); return r; }
typedef unsigned u32x2 __attribute__((ext_vector_type(2)));
__device__ __forceinline__ float sigm(float z) { return __builtin_amdgcn_rcpf(1.0f + __builtin_amdgcn_exp2f(-1.4426950408889634f * z)); }
__device__ __forceinline__ float bflo(unsigned w) { return __builtin_bit_cast(float, w << 16); }
__device__ __forceinline__ float bfhi(unsigned w) { return __builtin_bit_cast(float, w & 0xffff0000u); }
struct EpiStoreBf16 {
    static constexpr bool PERM = true, AFTER_DRAIN = false;
    bf16_t* O; int ldc;
    __device__ __forceinline__ void operator()(const f32x4 (&acc)[2][2][4][2], const Unit& u, int wr, int wc, int fr, int fq) const {
        const int row0 = u.pm * BM + wr * 64 + fr, col0 = u.pn * BM + wc * 32 + 8 * fq;
#pragma unroll
        for (int ai = 0; ai < 2; ++ai)
#pragma unroll
            for (int m = 0; m < 4; ++m) { bf16_t* rowp = O + (size_t)(row0 + ai * HALF + m * 16) * ldc + col0;
#pragma unroll
                for (int bj = 0; bj < 2; ++bj) { const f32x4 v0 = acc[ai][bj][m][0], v1 = acc[ai][bj][m][1];
                    u32x4 w; w.x = cvt_pk_bf16(v0[0], v0[1]); w.y = cvt_pk_bf16(v0[2], v0[3]); w.z = cvt_pk_bf16(v1[0], v1[1]); w.w = cvt_pk_bf16(v1[2], v1[3]);
                    *(u32x4*)(rowp + bj * HALF) = w; } }
    }
};
struct EpiStoreF32 {
    static constexpr bool PERM = false, AFTER_DRAIN = false;
    float* C; int ldc;
    __device__ __forceinline__ void operator()(const f32x4 (&acc)[2][2][4][2], const Unit& u, int wr, int wc, int fr, int fq) const {
        const int row0 = u.pm * BM + wr * 64 + fr, col0 = u.pn * BM + wc * 32 + 4 * fq;
#pragma unroll
        for (int ai = 0; ai < 2; ++ai)
#pragma unroll
            for (int m = 0; m < 4; ++m) { float* rowp = C + (size_t)(row0 + ai * HALF + m * 16) * ldc + col0;
#pragma unroll
                for (int bj = 0; bj < 2; ++bj)
#pragma unroll
                    for (int n = 0; n < 2; ++n) *(f32x4*)(rowp + bj * HALF + n * 16) = acc[ai][bj][m][n]; }
    }
};
struct EpiGlu {
    static constexpr bool PERM = true, AFTER_DRAIN = false;
    const bf16_t* Y; int ldy; bf16_t* O; int ldo; const float* bias;
    __device__ __forceinline__ void operator()(const f32x4 (&acc)[2][2][4][2], const Unit& u, int wr, int wc, int fr, int fq) const {
        const int row0 = u.pm * BM + wr * 64 + fr, col0 = u.pn * BM + wc * 32 + 8 * fq;
        f32x4 bv[2][2];
#pragma unroll
        for (int bj = 0; bj < 2; ++bj)
#pragma unroll
            for (int n = 0; n < 2; ++n) bv[bj][n] = *(const f32x4*)(bias + col0 + bj * HALF + 4 * n);
#pragma unroll
        for (int ai = 0; ai < 2; ++ai)
#pragma unroll
            for (int m = 0; m < 4; ++m) { const size_t r = (size_t)(row0 + ai * HALF + m * 16);
#pragma unroll
                for (int bj = 0; bj < 2; ++bj) { const u32x4 yv = *(const u32x4*)(Y + r * ldy + col0 + bj * HALF);
                    const f32x4 z0 = acc[ai][bj][m][0] + bv[bj][0], z1 = acc[ai][bj][m][1] + bv[bj][1];
                    u32x4 w;
                    w.x = cvt_pk_bf16(bflo(yv.x) * sigm(z0[0]), bfhi(yv.x) * sigm(z0[1])); w.y = cvt_pk_bf16(bflo(yv.y) * sigm(z0[2]), bfhi(yv.y) * sigm(z0[3]));
                    w.z = cvt_pk_bf16(bflo(yv.z) * sigm(z1[0]), bfhi(yv.z) * sigm(z1[1])); w.w = cvt_pk_bf16(bflo(yv.w) * sigm(z1[2]), bfhi(yv.w) * sigm(z1[3]));
                    *(u32x4*)(O + r * ldo + col0 + bj * HALF) = w; } }
    }
};
struct EpiSwiGlu {
    static constexpr bool PERM = true, AFTER_DRAIN = false;
    bf16_t* O; int ldc;
    __device__ __forceinline__ void operator()(const f32x4 (&acc)[2][2][4][2], const Unit& u, int wr, int wc, int fr, int fq) const {
        const int row0 = u.pm * BM + wr * 64 + fr, col0 = u.pn * HALF + wc * 32 + 8 * fq;
#pragma unroll
        for (int ai = 0; ai < 2; ++ai)
#pragma unroll
            for (int m = 0; m < 4; ++m) { bf16_t* rowp = O + (size_t)(row0 + ai * HALF + m * 16) * ldc + col0;
                const f32x4 g0 = acc[ai][0][m][0], g1 = acc[ai][0][m][1], u0 = acc[ai][1][m][0], u1 = acc[ai][1][m][1];
                u32x4 w;
                w.x = cvt_pk_bf16(g0[0] * sigm(g0[0]) * u0[0], g0[1] * sigm(g0[1]) * u0[1]); w.y = cvt_pk_bf16(g0[2] * sigm(g0[2]) * u0[2], g0[3] * sigm(g0[3]) * u0[3]);
                w.z = cvt_pk_bf16(g1[0] * sigm(g1[0]) * u1[0], g1[1] * sigm(g1[1]) * u1[1]); w.w = cvt_pk_bf16(g1[2] * sigm(g1[2]) * u1[2], g1[3] * sigm(g1[3]) * u1[3]);
                *(u32x4*)rowp = w; }
    }
};
template <class Epi, class Sched, bool ALIGN_EPI = false, bool SP2 = false>
__device__ __forceinline__ void gemm_phase(PG8_LAS unsigned char* lds, const Gemm g, const Sched& S, const Epi& E, const int tid) {
    const int wid = __builtin_amdgcn_readfirstlane(tid >> 6), lane = tid & 63, wr = wid >> 2, wc = wid & 3, fr = lane & 15, fq = lane >> 4;
    const int K = g.K, nt = K / BK;
    unsigned voffA[2], voffB[2];
#pragma unroll
    for (int i = 0; i < 2; ++i) { int R, C; stage_rc(tid * 16 + i * 8192, R, C); const int Rb = Epi::PERM ? ((R & ~31) + perm32(R & 31)) : R;
        voffA[i] = (unsigned)(R * K + C) * 2u; voffB[i] = (unsigned)(Rb * K + C) * 2u; }
    const size_t kstep = (size_t)(BK * 2);
    const size_t hstep = (size_t)HALF * K * 2;
    const size_t tstep = 2 * hstep;
    const unsigned ldsw = (unsigned)wid * 1024u;
    const int aoff = lds_byte(wr * 64 + fr, fq * 8), boff = lds_byte(wc * 32 + fr, fq * 8);
#define PG8_SA(b, h) (((b) * 2 + (h)) * HTB)
#define PG8_SB(b, h) ((4 + (b) * 2 + (h)) * HTB)
#define PG8_STAGE(bufoff, gbase, voff) do { _Pragma("unroll") for (int _i = 0; _i < 2; ++_i) \
        __builtin_amdgcn_global_load_lds((const unsigned*)((const char*)(gbase) + (voff)[_i]), (PG8_LAS unsigned*)(lds + (bufoff) + ldsw + _i * 8192), 16, 0, 0); } while (0)
#define PG8_LDA(dst, b, h) do { _Pragma("unroll") for (int m = 0; m < 4; ++m) _Pragma("unroll") for (int k = 0; k < 2; ++k) dst[m][k] = *(const PG8_LAS bf16x8*)(lds + PG8_SA(b, h) + aoff + m * 2048 + k * 1024); } while (0)
#define PG8_LDB(dst, b, h) do { _Pragma("unroll") for (int n = 0; n < 2; ++n) _Pragma("unroll") for (int k = 0; k < 2; ++k) dst[n][k] = *(const PG8_LAS bf16x8*)(lds + PG8_SB(b, h) + boff + n * 2048 + k * 1024); } while (0)
#define PG8_MMA(ai, bj, At, Bt) do { __builtin_amdgcn_s_setprio(1); _Pragma("unroll") for (int m = 0; m < 4; ++m) _Pragma("unroll") for (int n = 0; n < 2; ++n) _Pragma("unroll") for (int k = 0; k < 2; ++k) \
        acc[ai][bj][m][n] = __builtin_amdgcn_mfma_f32_16x16x32_bf16(Bt[n][k], At[m][k], acc[ai][bj][m][n], 0, 0, 0); __builtin_amdgcn_s_setprio(0); } while (0)
#define PG8_WAIT_V(n) asm volatile("s_waitcnt vmcnt(" #n ")" ::: "memory")
#define PG8_WAIT_L(n) asm volatile("s_waitcnt lgkmcnt(" #n ")" ::: "memory")
#define PG8_BAR __builtin_amdgcn_s_barrier()
#define PG8_SCHED __builtin_amdgcn_sched_barrier(0)
    Unit cur, nxt; int ui = 0;
    if (!S.next(0, cur)) return;
    f32x4 acc[2][2][4][2];
#pragma unroll
    for (int a = 0; a < 2; ++a)
#pragma unroll
        for (int b = 0; b < 2; ++b)
#pragma unroll
            for (int m = 0; m < 4; ++m)
#pragma unroll
                for (int n = 0; n < 2; ++n) acc[a][b][m][n] = (f32x4){0.f, 0.f, 0.f, 0.f};
    bf16x8 At[4][2], B0[2][2], B1[2][2];
    const char* cA = (const char*)g.A + (size_t)cur.pm * tstep; const char* cB = (const char*)g.Bt + (size_t)cur.pn * tstep;
    S.a_ready(cur);
    if constexpr (SP2) {
        PG8_STAGE(PG8_SB(0, 0), cB, voffB); PG8_STAGE(PG8_SB(0, 1), cB + hstep, voffB); PG8_STAGE(PG8_SA(0, 0), cA, voffA); PG8_STAGE(PG8_SA(0, 1), cA + hstep, voffA);
        if (wr == 1) PG8_BAR;
        PG8_WAIT_V(2); PG8_BAR;
        PG8_STAGE(PG8_SB(1, 0), cB + kstep, voffB); PG8_STAGE(PG8_SA(1, 0), cA + kstep, voffA); PG8_STAGE(PG8_SB(1, 1), cB + hstep + kstep, voffB);
        PG8_WAIT_V(6); PG8_BAR;
    } else {
        PG8_STAGE(PG8_SB(0, 0), cB, voffB); PG8_STAGE(PG8_SA(0, 0), cA, voffA); PG8_STAGE(PG8_SB(0, 1), cB + hstep, voffB); PG8_STAGE(PG8_SA(0, 1), cA + hstep, voffA);
        if (wr == 1) PG8_BAR;
        PG8_WAIT_V(4); PG8_BAR;
        PG8_STAGE(PG8_SB(1, 0), cB + kstep, voffB); PG8_STAGE(PG8_SA(1, 0), cA + kstep, voffA); PG8_STAGE(PG8_SB(1, 1), cB + hstep + kstep, voffB);
        PG8_WAIT_V(6); PG8_BAR;
    }
    for (;;) {
        const bool has_next = S.next(ui + 1, nxt);
        const char* nA = has_next ? (const char*)g.A + (size_t)nxt.pm * tstep : cA; const char* nB = has_next ? (const char*)g.Bt + (size_t)nxt.pn * tstep : cB;
        for (int t = 0; t < nt; t += 2) {
            const bool last = (t == nt - 2);
            const char* a1 = cA + (size_t)(t + 1) * kstep;
            const char* a2 = last ? nA : cA + (size_t)(t + 2) * kstep; const char* b2 = last ? nB : cB + (size_t)(t + 2) * kstep;
            const char* a3 = a2 + kstep; const char* b3 = b2 + kstep;
            if (last && has_next) S.a_ready(nxt);
            if constexpr (SP2) {
            PG8_LDB(B0, 0, 0); PG8_LDB(B1, 0, 1); PG8_SCHED; PG8_LDA(At, 0, 0); PG8_STAGE(PG8_SA(1, 1), a1 + hstep, voffA);
            PG8_WAIT_V(8); PG8_WAIT_L(0); PG8_BAR; PG8_MMA(0, 0, At, B0); PG8_MMA(0, 1, At, B1); PG8_BAR; PG8_SCHED;
            PG8_LDA(At, 0, 1); PG8_STAGE(PG8_SB(0, 0), b2, voffB); PG8_STAGE(PG8_SB(0, 1), b2 + hstep, voffB); PG8_STAGE(PG8_SA(0, 0), a2, voffA);
            PG8_WAIT_V(8); PG8_WAIT_L(0); PG8_BAR; PG8_MMA(1, 0, At, B0); PG8_MMA(1, 1, At, B1); PG8_BAR; PG8_SCHED;
            PG8_LDB(B0, 1, 0); PG8_LDB(B1, 1, 1); PG8_SCHED; PG8_LDA(At, 1, 0); PG8_STAGE(PG8_SA(0, 1), a2 + hstep, voffA);
            PG8_WAIT_V(8); PG8_WAIT_L(0); PG8_BAR; PG8_MMA(0, 0, At, B0); PG8_MMA(0, 1, At, B1); PG8_BAR; PG8_SCHED;
            PG8_LDA(At, 1, 1); PG8_STAGE(PG8_SB(1, 0), b3, voffB); PG8_STAGE(PG8_SB(1, 1), b3 + hstep, voffB); PG8_STAGE(PG8_SA(1, 0), a3, voffA);
            PG8_WAIT_V(8); PG8_WAIT_L(0); PG8_BAR; PG8_MMA(1, 0, At, B0); PG8_MMA(1, 1, At, B1); PG8_BAR; PG8_SCHED;
            } else {
            PG8_LDB(B0, 0, 0); PG8_SCHED; PG8_LDA(At, 0, 0); PG8_STAGE(PG8_SA(1, 1), a1 + hstep, voffA);
            PG8_WAIT_L(8); PG8_BAR; PG8_WAIT_L(0); PG8_MMA(0, 0, At, B0); PG8_BAR; PG8_SCHED;
            PG8_LDB(B1, 0, 1); PG8_STAGE(PG8_SB(0, 0), b2, voffB);
            PG8_BAR; PG8_WAIT_L(0); PG8_MMA(0, 1, At, B1); PG8_BAR;
            PG8_LDA(At, 0, 1); PG8_STAGE(PG8_SA(0, 0), a2, voffA);
            PG8_BAR; PG8_WAIT_L(0); PG8_MMA(1, 0, At, B0); PG8_BAR; PG8_SCHED;
            PG8_STAGE(PG8_SB(0, 1), b2 + hstep, voffB);
            PG8_WAIT_V(6); PG8_BAR; PG8_MMA(1, 1, At, B1); PG8_BAR;
            PG8_LDB(B0, 1, 0); PG8_SCHED; PG8_LDA(At, 1, 0); PG8_STAGE(PG8_SA(0, 1), a2 + hstep, voffA);
            PG8_WAIT_L(8); PG8_BAR; PG8_WAIT_L(0); PG8_MMA(0, 0, At, B0); PG8_BAR; PG8_SCHED;
            PG8_LDB(B1, 1, 1); PG8_STAGE(PG8_SB(1, 0), b3, voffB);
            PG8_BAR; PG8_WAIT_L(0); PG8_MMA(0, 1, At, B1); PG8_BAR;
            PG8_LDA(At, 1, 1); PG8_STAGE(PG8_SA(1, 0), a3, voffA);
            PG8_BAR; PG8_WAIT_L(0); PG8_MMA(1, 0, At, B0); PG8_BAR; PG8_SCHED;
            PG8_STAGE(PG8_SB(1, 1), b3 + hstep, voffB);
            PG8_WAIT_V(6); PG8_BAR; PG8_MMA(1, 1, At, B1); PG8_BAR;
            }
        }
        if constexpr (ALIGN_EPI) { if (wr == 0) PG8_BAR; }
        if constexpr (!Epi::AFTER_DRAIN) { E(acc, cur, wr, wc, fr, fq); S.done(cur); }
        if (!has_next) break;
#pragma unroll
        for (int a = 0; a < 2; ++a)
#pragma unroll
            for (int b = 0; b < 2; ++b)
#pragma unroll
                for (int m = 0; m < 4; ++m)
#pragma unroll
                    for (int n = 0; n < 2; ++n) acc[a][b][m][n] = (f32x4){0.f, 0.f, 0.f, 0.f};
        cur = nxt; cA = nA; cB = nB; ++ui;
        if constexpr (ALIGN_EPI) { if (wr == 1) PG8_BAR; }
    }
    PG8_WAIT_V(0);
    if constexpr (!ALIGN_EPI) { if (wr == 0) PG8_BAR; }
    PG8_BAR;
    if constexpr (Epi::AFTER_DRAIN) { E.fused(acc, cur, wr, wc, fr, fq, lds, wid, lane); S.done(cur); }
#undef PG8_SA
#undef PG8_SB
#undef PG8_STAGE
#undef PG8_LDA
#undef PG8_LDB
#undef PG8_MMA
#undef PG8_WAIT_V
#undef PG8_WAIT_L
#undef PG8_BAR
#undef PG8_SCHED
}
}
#ifndef PG8_SP2
#define PG8_SP2 true
#endif
#ifndef PG8_ALIGN
#define PG8_ALIGN true
#endif

constexpr int NWAVES = 8;
constexpr int BATCH = 2, SEQ = 8192, M = BATCH * SEQ, D = 4096, INCOLS = 8200, NPROJ = 8192, DFF = 11008, NGU = 2 * DFF;
constexpr int HD = 128, NH = 8, SSMW = 2048, NG = 128, NS = 64, LAYERS = 2;
constexpr int COL_QA = 0, COL_KA = 1024, COL_VA = 2048, COL_QB = 3072, COL_KB = 4096, COL_VB = 5120, COL_U = 6144;
constexpr float RMS_EPS = 1e-6f;
constexpr float LOG2E = 1.4426950408889634f;
constexpr float QK_SCALE = 0.08838834764831845f;

constexpr size_t MiB = 1u << 20;
constexpr size_t WS_CTL = 0, CTL_ZERO_BYTES = 1 * MiB;
constexpr size_t WS_LS = 3 * MiB;
constexpr size_t WS_CUM = 4 * MiB;
constexpr size_t WS_KNT = 5 * MiB;
constexpr size_t WS_W = 16 * MiB;
constexpr size_t W_IN = 0, W_GLU = 64 * MiB, W_OUT = 72 * MiB, W_GU = 104 * MiB, W_D = 276 * MiB, W_LAYER = 362 * MiB;
constexpr size_t WS_H = WS_W + 2 * W_LAYER;
constexpr size_t WS_PROJ = WS_H + 128 * MiB;
constexpr size_t WS_YG = WS_PROJ + 256 * MiB;
constexpr size_t WS_O = WS_YG + 64 * MiB;
constexpr size_t WS_Y32 = WS_O + 128 * MiB;
constexpr size_t WS_ACT = WS_PROJ;
constexpr size_t WS_END = WS_Y32 + 256 * MiB;
static_assert(WS_ACT + (size_t)M * DFF * 2 <= WS_Y32, "ACT overlay");
constexpr int CW_TMO = 0, CW_BAR = 4096;

constexpr int RING_OFF = 0, RING_BYTES = 131072;
constexpr int LDSCTL_OFF = RING_BYTES, MISC_OFF = LDSCTL_OFF + 320;
constexpr int LDS_BYTES = 147456;

#define GAS __attribute__((address_space(1)))
#define LAS __attribute__((address_space(3)))
typedef unsigned short bf16;
typedef unsigned v4u __attribute__((ext_vector_type(4)));
typedef unsigned v2u __attribute__((ext_vector_type(2)));
typedef float f32x4 __attribute__((ext_vector_type(4)));
typedef float f32x8 __attribute__((ext_vector_type(8)));
typedef float f32x16 __attribute__((ext_vector_type(16)));
typedef short bf16x8 __attribute__((ext_vector_type(8)));
typedef __bf16 bfv8 __attribute__((ext_vector_type(8)));
typedef __bf16 bfv4 __attribute__((ext_vector_type(4)));
typedef __bf16 bfv2 __attribute__((ext_vector_type(2)));
typedef GAS unsigned gu32;
#define RLX_AGENT __ATOMIC_RELAXED, __HIP_MEMORY_SCOPE_AGENT
#define MFMA32(a, b, c) __builtin_amdgcn_mfma_f32_32x32x16_bf16((a), (b), (c), 0, 0, 0)

__device__ __forceinline__ bf16x8 cvt8(f32x8 v) { return __builtin_bit_cast(bf16x8, __builtin_convertvector(v, bfv8)); }
__device__ __forceinline__ v2u cvt4(f32x4 v) { return __builtin_bit_cast(v2u, __builtin_convertvector(v, bfv4)); }
__device__ __forceinline__ unsigned cvt2(float a, float b) { typedef float f2 __attribute__((ext_vector_type(2))); f2 v = {a, b}; return __builtin_bit_cast(unsigned, __builtin_convertvector(v, bfv2)); }
__device__ __forceinline__ float bf_lo(unsigned w) { return __builtin_bit_cast(float, w << 16); }
__device__ __forceinline__ float bf_hi(unsigned w) { return __builtin_bit_cast(float, w & 0xffff0000u); }
__device__ __forceinline__ float wave_sum(float v) {
#pragma unroll
    for (int o = 1; o < 64; o <<= 1) v += __shfl_xor(v, o);
    return v;
}
__device__ __forceinline__ int crow(int r, int hi) { return (r & 3) + 8 * (r >> 2) + 4 * hi; }

#define XB_TMO      128
#define XB_XCNT(j)  (256  + 64 * (j))
#define XB_XSUB(j)  (1280 + 64 * (j))
#define XB_XGEN(j)  (2304 + 64 * (j))
#define XB_TOP      3328
#define XB_TOPGEN   3392
#define XCD_BAR_WORDS 3456
#define XB_SPIN_CAP (1u << 18)

__device__ __forceinline__ unsigned xb_ld(unsigned* p)              { return __hip_atomic_load(p, __ATOMIC_RELAXED, __HIP_MEMORY_SCOPE_AGENT); }
__device__ __forceinline__ unsigned xb_add(unsigned* p, unsigned v) { return __hip_atomic_fetch_add(p, v, __ATOMIC_RELAXED, __HIP_MEMORY_SCOPE_AGENT); }
__device__ __forceinline__ unsigned xb_xcc_id() { return (unsigned)__builtin_amdgcn_s_getreg((3 << 11) | 20) & 0xFu; }
#define XB_SPIN(cond, bar) do { unsigned _sp = 0; while (cond) { __builtin_amdgcn_s_sleep(1); \
    if ((++_sp & 255u) == 0u) { if (xb_ld(&(bar)[XB_TMO])) break; if (_sp > XB_SPIN_CAP) { atomicAdd(&(bar)[XB_TMO], 1u); break; } } } } while (0)

struct XcdBarrier {
    unsigned* bar; unsigned x;
    volatile LAS unsigned* st;
};

__device__ __forceinline__ XcdBarrier xcd_barrier_post(unsigned* bar, volatile LAS unsigned* st) {
    XcdBarrier b; b.bar = bar; b.x = xb_xcc_id(); b.st = st;
    if (threadIdx.x == 0) (void)xb_add(&bar[XB_XCNT(b.x)], 1u);
    return b;
}
__device__ __forceinline__ void xcd_barrier_complete(unsigned* bar, unsigned x, unsigned& nloc, unsigned& nx) {
    const unsigned G = gridDim.x * gridDim.y * gridDim.z;
    unsigned sum, cnt, mine, sp = 0u;
    for (;;) {
        sum = 0u; cnt = 0u; mine = 0u;
#pragma unroll
        for (unsigned j = 0; j < 16; ++j) { const unsigned c = xb_ld(&bar[XB_XCNT(j)]); sum += c; cnt += (c > 0u) ? 1u : 0u; mine = (j == x) ? c : mine; }
        if (sum == G) break;
        __builtin_amdgcn_s_sleep(1);
        if ((++sp & 255u) == 0u) { if (xb_ld(&bar[XB_TMO])) break; if (sp > XB_SPIN_CAP) { atomicAdd(&bar[XB_TMO], 1u); break; } }
    }
    nloc = mine > 0u ? mine : 1u; nx = cnt > 0u ? cnt : 1u;
}

__device__ __forceinline__ void xcd_barrier(const XcdBarrier& b) {
    asm volatile("s_waitcnt vmcnt(0)" ::: "memory");
    __syncthreads();
    if (threadIdx.x == 0) {
        unsigned* bar = b.bar;
        __builtin_amdgcn_s_waitcnt(0);
        unsigned nloc = b.st[0], nx = b.st[1];
        if (nloc == 0u) { xcd_barrier_complete(bar, b.x, nloc, nx); b.st[0] = nloc; b.st[1] = nx; }
        const unsigned old = xb_add(&bar[XB_XSUB(b.x)], 1u);
        const unsigned gen = old / nloc;
        if (old + 1u == (gen + 1u) * nloc) {
            __builtin_amdgcn_fence(__ATOMIC_RELEASE, "agent");
            asm volatile("s_waitcnt vmcnt(0)" ::: "memory");
            const unsigned og = xb_add(&bar[XB_TOP], 1u);
            const unsigned tg = og / nx;
            if (og + 1u == (tg + 1u) * nx) xb_add(&bar[XB_TOPGEN], 1u);
            else XB_SPIN(xb_ld(&bar[XB_TOPGEN]) == tg, bar);
            __builtin_amdgcn_fence(__ATOMIC_ACQUIRE, "agent");
            xb_add(&bar[XB_XGEN(b.x)], 1u);
            asm volatile("s_waitcnt vmcnt(0)" ::: "memory");
        } else {
            XB_SPIN(xb_ld(&bar[XB_XGEN(b.x)]) == gen, bar);
            __builtin_amdgcn_fence(__ATOMIC_ACQUIRE, "agent");
            asm volatile("s_waitcnt vmcnt(0)" ::: "memory");
        }
    }
    __syncthreads();
}


__device__ __forceinline__ void p0_item(const float* W, int ld, int col0, int k0, const float* gain, bf16* dst, int dstK, LAS float* scr, int lane) {
#pragma unroll 8
    for (int i = 0; i < 32; ++i) { const int kk = 2 * i + (lane >> 5); float w = W[(size_t)(k0 + kk) * ld + col0 + (lane & 31)]; if (gain) w *= gain[k0 + kk]; scr[kk * 33 + (lane & 31)] = w; }
    asm volatile("s_waitcnt lgkmcnt(0)" ::: "memory");
    const int c = lane & 7;
#pragma unroll
    for (int j = 0; j < 4; ++j) { const int n = (lane >> 3) + 8 * j; const LAS float* s = scr + (8 * c) * 33 + n;
        f32x8 v = {s[0 * 33], s[1 * 33], s[2 * 33], s[3 * 33], s[4 * 33], s[5 * 33], s[6 * 33], s[7 * 33]};
        *(bf16x8*)(dst + (size_t)n * dstK + 8 * c) = cvt8(v); }
    asm volatile("s_waitcnt lgkmcnt(0)" ::: "memory");
}
constexpr int I_IN = (D / 64) * (NPROJ / 32), I_GLU = (SSMW / 64) * (SSMW / 32), I_OUT = (D / 64) * (D / 32), I_GU = (D / 64) * (NGU / 32), I_D = (DFF / 64) * (D / 32);
constexpr int I_LAYER = I_IN + I_GLU + I_OUT + I_GU + I_D;

struct Args { const float* in[23]; float* out; unsigned char* ws; };
typedef const __attribute__((address_space(4))) Args CArgs;

__device__ __forceinline__ void p0_weights(CArgs& a, LAS unsigned char* lds, int gw, int NGW, int wave, int lane) {
    LAS float* scr = (LAS float*)(lds + RING_OFF + wave * 16384);
    for (int it = gw; it < LAYERS * I_LAYER; it += NGW) {
        const int l = it / I_LAYER; int r = it - l * I_LAYER;
        unsigned char* wl = a.ws + WS_W + (size_t)l * W_LAYER;
        if (r < I_IN) { const int kb = r / (NPROJ / 32), nb = r % (NPROJ / 32); const int n0 = 32 * nb;
            p0_item(a.in[1] + (size_t)l * D * INCOLS, INCOLS, n0 + (n0 >= COL_U ? 8 : 0), 64 * kb, a.in[3] + l * D, (bf16*)(wl + W_IN) + (size_t)n0 * D + 64 * kb, D, scr, lane); continue; }
        r -= I_IN;
        if (r < I_GLU) { const int kb = r / (SSMW / 32), nb = r % (SSMW / 32);
            p0_item(a.in[16] + (size_t)l * SSMW * SSMW, SSMW, 32 * nb, 64 * kb, nullptr, (bf16*)(wl + W_GLU) + (size_t)(32 * nb) * SSMW + 64 * kb, SSMW, scr, lane); continue; }
        r -= I_GLU;
        if (r < I_OUT) { const int kb = r / (D / 32), nb = r % (D / 32);
            p0_item(a.in[2] + (size_t)l * D * D, D, 32 * nb, 64 * kb, a.in[5] + l * D, (bf16*)(wl + W_OUT) + (size_t)(32 * nb) * D + 64 * kb, D, scr, lane); continue; }
        r -= I_OUT;
        if (r < I_GU) { const int kb = r / (NGU / 32), nb = r % (NGU / 32); const int n0 = 32 * nb, tile = n0 >> 8, within = n0 & 255;
            const float* src = (within < 128 ? a.in[20] : a.in[21]) + (size_t)l * D * DFF;
            p0_item(src, DFF, 128 * tile + (within & 127), 64 * kb, a.in[18] + l * D, (bf16*)(wl + W_GU) + (size_t)n0 * D + 64 * kb, D, scr, lane); continue; }
        r -= I_GU;
        { const int kb = r / (D / 32), nb = r % (D / 32);
            p0_item(a.in[22] + (size_t)l * DFF * D, D, 32 * nb, 64 * kb, nullptr, (bf16*)(wl + W_D) + (size_t)(32 * nb) * DFF + 64 * kb, DFF, scr, lane); }
    }
}

__device__ __forceinline__ void load_row(const float* p, int lane, f32x4 (&v)[16]) {
    const f32x4* q = (const f32x4*)p + lane;
#pragma unroll
    for (int j = 0; j < 16; ++j) v[j] = q[64 * j];
}
__device__ __forceinline__ float row_sumsq(const f32x4 (&v)[16]) {
    float s = 0.f;
#pragma unroll
    for (int j = 0; j < 16; ++j) s += (v[j].x * v[j].x + v[j].y * v[j].y) + (v[j].z * v[j].z + v[j].w * v[j].w);
    return wave_sum(s);
}
__device__ __forceinline__ void store_h(bf16* hrow, int lane, const f32x4 (&v)[16], float rstd) {
    v2u* o = (v2u*)hrow + lane;
#pragma unroll
    for (int j = 0; j < 16; ++j) o[64 * j] = cvt4(v[j] * rstd);
}
__device__ __forceinline__ void build_wfb(LAS float* wfb, const float* w_in_l, const float* g, int tid) {
    for (int idx = tid; idx < 8 * D; idx += NWAVES * 64) { const int k = idx >> 3, hh = idx & 7; wfb[hh * D + k] = g[k] * w_in_l[(size_t)k * INCOLS + COL_U + hh]; }
}
__device__ __forceinline__ void fb_emit(const f32x4 (&v)[16], float rstd, const LAS float* wfb, const float* bfg, float* LS, int m, int lane) {
    float acc[8];
#pragma unroll
    for (int hh = 0; hh < 8; ++hh) acc[hh] = 0.f;
#pragma unroll
    for (int j = 0; j < 16; ++j) {
#pragma unroll
        for (int hh = 0; hh < 8; ++hh) { const f32x4 w = *(const LAS f32x4*)(wfb + hh * D + 256 * j + 4 * lane); acc[hh] += (v[j].x * w.x + v[j].y * w.y) + (v[j].z * w.z + v[j].w * w.w); }
        asm volatile("" ::: "memory");
    }
    float mine = 0.f;
#pragma unroll
    for (int hh = 0; hh < 8; ++hh) { const float s = wave_sum(acc[hh]); mine = (lane == hh) ? s : mine; }
    if (lane < 8) { const float z = mine * rstd + bfg[lane]; const float ls = fminf(z, 0.f) - log1pf(expf(-fabsf(z)));
        const int b = m / SEQ, s = m - b * SEQ; LS[(size_t)(b * NH + lane) * SEQ + s] = ls; }
}
__device__ __forceinline__ void phase_norm0(CArgs& a, LAS unsigned char* lds, int gw, int NGW, int tid, int lane) {
    LAS float* wfb = (LAS float*)(lds + RING_OFF);
    build_wfb(wfb, a.in[1], a.in[3], tid);
    __syncthreads();
    bf16* H = (bf16*)(a.ws + WS_H); float* LS = (float*)(a.ws + WS_LS);
    for (int m = gw; m < M; m += NGW) {
        f32x4 v[16]; load_row(a.in[0] + (size_t)m * D, lane, v);
        const float rstd = 1.0f / sqrtf(row_sumsq(v) * (1.0f / D) + RMS_EPS);
        store_h(H + (size_t)m * D, lane, v, rstd);
        fb_emit(v, rstd, wfb, a.in[7], LS, m, lane);
    }
    __syncthreads();
}
template <bool WRITE_H, bool DO_FB>
__device__ __forceinline__ void phase_post(CArgs& a, LAS unsigned char* lds, const float* xsrc, const float* gpost, int lnext, int gw, int NGW, int tid, int lane) {
    LAS float* wfb = (LAS float*)(lds + RING_OFF);
    if (DO_FB) { build_wfb(wfb, a.in[1] + (size_t)lnext * D * INCOLS, a.in[3] + lnext * D, tid); __syncthreads(); }
    const float* Y = (const float*)(a.ws + WS_Y32); bf16* H = (bf16*)(a.ws + WS_H); float* LS = (float*)(a.ws + WS_LS);
    for (int m = gw; m < M; m += NGW) {
        f32x4 v[16], y[16]; load_row(Y + (size_t)m * D, lane, y);
        const float ry = 1.0f / sqrtf(row_sumsq(y) * (1.0f / D) + RMS_EPS);
        const f32x4* gq = (const f32x4*)gpost + lane; const f32x4* xq = (const f32x4*)(xsrc + (size_t)m * D) + lane;
        f32x4* o = (f32x4*)(a.out + (size_t)m * D) + lane;
#pragma unroll
        for (int j = 0; j < 16; ++j) { v[j] = xq[64 * j] + (y[j] * ry) * gq[64 * j]; o[64 * j] = v[j];
            if ((j & 3) == 3) asm volatile("" ::: "memory"); }
        if (WRITE_H) {
            const float rstd = 1.0f / sqrtf(row_sumsq(v) * (1.0f / D) + RMS_EPS);
            store_h(H + (size_t)m * D, lane, v, rstd);
            if (DO_FB) fb_emit(v, rstd, wfb, a.in[7] + lnext * NH, LS, m, lane);
        }
    }
    if (DO_FB) __syncthreads();
}
__device__ __forceinline__ void phase_mixnorm(CArgs& a, int gw, int NGW, int lane) {
    bf16* O = (bf16*)(a.ws + WS_O);
    for (int m = gw; m < M; m += NGW) {
        v4u* p = (v4u*)(O + (size_t)m * D) + lane; v4u w[8]; float ss[8];
#pragma unroll
        for (int j = 0; j < 8; ++j) w[j] = p[64 * j];
#pragma unroll
        for (int j = 0; j < 8; ++j) { float s = 0.f;
#pragma unroll
            for (int e = 0; e < 4; ++e) { const float lo = bf_lo(w[j][e]), hi = bf_hi(w[j][e]); s += lo * lo + hi * hi; }
            ss[j] = s; }
        const float sa = wave_sum(ss[0] + ss[1]), sb = wave_sum(ss[2] + ss[3]), sc = wave_sum((ss[4] + ss[5]) + (ss[6] + ss[7]));
        const float ra = 1.0f / sqrtf(sa * (1.0f / 1024.f) + RMS_EPS), rb = 1.0f / sqrtf(sb * (1.0f / 1024.f) + RMS_EPS), rc = 1.0f / sqrtf(sc * (1.0f / 2048.f) + RMS_EPS);
#pragma unroll
        for (int j = 0; j < 8; ++j) { const float r = j < 2 ? ra : (j < 4 ? rb : rc); v4u o;
#pragma unroll
            for (int e = 0; e < 4; ++e) o[e] = cvt2(bf_lo(w[j][e]) * r, bf_hi(w[j][e]) * r);
            p[64 * j] = o; }
    }
}
__device__ __forceinline__ void phase_cum_knorm(CArgs& a, int l, int gw, int NGW, int lane) {
    if (gw < BATCH * NH) {
        const float* ls = (const float*)(a.ws + WS_LS) + (size_t)gw * SEQ; float* cum = (float*)(a.ws + WS_CUM) + (size_t)gw * SEQ; float carry = 0.f;
        for (int c = 0; c < SEQ / 1024; ++c) {
            f32x4 q[4];
#pragma unroll
            for (int i = 0; i < 4; ++i) q[i] = *(const f32x4*)(ls + c * 1024 + lane * 16 + 4 * i);
            float run = 0.f;
#pragma unroll
            for (int i = 0; i < 4; ++i) { q[i].x += run; q[i].y += q[i].x; q[i].z += q[i].y; q[i].w += q[i].z; run = q[i].w; }
            float inc = run;
#pragma unroll
            for (int o = 1; o < 64; o <<= 1) { const float t = __shfl_up(inc, o); if (lane >= o) inc += t; }
            const float excl = (inc - run) + carry;
#pragma unroll
            for (int i = 0; i < 4; ++i) *(f32x4*)(cum + c * 1024 + lane * 16 + 4 * i) = q[i] + excl;
            carry += __shfl(inc, 63);
        }
    }
    const bf16* P = (const bf16*)(a.ws + WS_PROJ); float* knt = (float*)(a.ws + WS_KNT);
    for (int t = gw; t < BATCH * NH * (SEQ / 64); t += NGW) {
        const int bh = t / (SEQ / 64), kt = t % (SEQ / 64), b = bh / NH, h = bh % NH; float mx = 0.f;
        const bf16* base = P + (size_t)(b * SEQ + kt * 64) * NPROJ + COL_KB + h * HD + 8 * (lane & 15);
#pragma unroll 4
        for (int it = 0; it < 16; ++it) { const v4u w = *(const v4u*)(base + (size_t)(it * 4 + (lane >> 4)) * NPROJ); float s = 0.f;
#pragma unroll
            for (int e = 0; e < 4; ++e) { const float lo = bf_lo(w[e]), hi = bf_hi(w[e]); s += lo * lo + hi * hi; }
            s += __shfl_xor(s, 1); s += __shfl_xor(s, 2); s += __shfl_xor(s, 4); s += __shfl_xor(s, 8); mx = fmaxf(mx, s); }
        mx = fmaxf(mx, __shfl_xor(mx, 16)); mx = fmaxf(mx, __shfl_xor(mx, 32));
        if (lane == 0) knt[t] = sqrtf(mx);
    }
}
namespace att {
#ifndef B_SKIP
#define B_SKIP 1
#endif
constexpr float SKIP_T = 30.0f;
constexpr int KROW = 272, VROW = 136, KBUF = 64 * KROW, VBUF = 128 * VROW;
constexpr int OFF_K = 0, OFF_V = 2 * KBUF, OFF_TAB = 2 * KBUF + 2 * VBUF, OFF_CK = OFF_TAB + 2304, OFF_RED = OFF_CK + 512, LDS_END = OFF_RED + 64;
static_assert(LDS_END <= RING_BYTES, "attention LDS");

template <int MODE>
__device__ __forceinline__ void attn_unit(CArgs& a, LAS unsigned char* lds, int l, int b, int h, int qb, int tid, int wave, int lane) {
    const bf16* P = (const bf16*)(a.ws + WS_PROJ);
    const int colq = MODE == 0 ? COL_QA : COL_QB, colk = MODE == 0 ? COL_KA : COL_KB, colv = MODE == 0 ? COL_VA : COL_VB;
    const int q = lane & 31, hi = lane >> 5;
    const int qpos = qb * 256 + wave * 32 + q;
    const size_t rowbase = (size_t)b * SEQ;
    const float* cum = (const float*)(a.ws + WS_CUM) + (size_t)(b * NH + h) * SEQ;
    LAS float* tab = (LAS float*)(lds + OFF_TAB);
    LAS float* ckl = (LAS float*)(lds + OFF_CK);

    int kt_first, ntiles, kt_step;
    if (MODE == 0) { kt_first = 4 * qb - 8 < 0 ? 0 : 4 * qb - 8; ntiles = 4 * qb + 3 - kt_first + 1; kt_step = 1; }
    else { kt_first = 4 * qb + 3; ntiles = 4 * qb + 4; kt_step = -1; }
    const int cq = 4 * qb + (wave >> 1);

    if (MODE == 0) { const float* rb = a.in[6] + (size_t)(l * NH + h) * 513; for (int i = tid; i < 513; i += NWAVES * 64) tab[i] = rb[i] * LOG2E; }

    bf16x8 qf[8];
    { const bf16* qp = P + (rowbase + qpos) * NPROJ + colq + h * HD + 8 * hi;
#pragma unroll
        for (int s = 0; s < 8; ++s) qf[s] = *(const bf16x8*)(qp + 16 * s); }
    float cqv = 0.f; if (MODE == 1) cqv = cum[qpos] * LOG2E;
    if (MODE == 1 && B_SKIP) {
        float ss = 0.f;
#pragma unroll
        for (int s = 0; s < 8; ++s) { const bf16x8 qv = qf[s]; const v4u w = __builtin_bit_cast(v4u, qv);
#pragma unroll
            for (int e = 0; e < 4; ++e) { const unsigned ww = w[e]; const float lo = bf_lo(ww), hi2 = bf_hi(ww); ss += lo * lo + hi2 * hi2; } }
        ss += __shfl_xor(ss, 32);
#pragma unroll
        for (int o = 1; o < 32; o <<= 1) ss = fmaxf(ss, __shfl_xor(ss, o));
        LAS float* red = (LAS float*)(lds + OFF_RED);
        if (lane == 0) red[wave] = ss;
        __syncthreads();
        float qn2 = red[0];
#pragma unroll
        for (int w = 1; w < NWAVES; ++w) qn2 = fmaxf(qn2, red[w]);
        const float* knt = (const float*)(a.ws + WS_KNT) + (size_t)(b * NH + h) * (SEQ / 64);
        float kn = fmaxf(knt[lane], knt[lane + 64]);
#pragma unroll
        for (int o = 1; o < 64; o <<= 1) kn = fmaxf(kn, __shfl_xor(kn, o));
        const float kd = fmaxf(fmaxf(knt[4 * qb], knt[4 * qb + 1]), fmaxf(knt[4 * qb + 2], knt[4 * qb + 3]));
        const float qn = sqrtf(qn2), theta = SKIP_T + qn * (kn + kd) * QK_SCALE;
        const float c0 = cum[qb * 256];
        int jskip = -1; bool found = false;
        for (int base = 4 * qb - 1; base >= 0 && !found; base -= 64) {
            const int Jl = base - lane; const bool skip = Jl < 0 ? true : (c0 - cum[64 * Jl + 63] < -theta);
            const unsigned long long bal = __ballot(skip);
            if (bal) { jskip = base - (__ffsll((long long)bal) - 1); found = true; }
        }
        jskip = __builtin_amdgcn_readfirstlane(jskip);
        ntiles = 4 * qb + 3 - jskip;
    }

    f32x16 O[4];
#pragma unroll
    for (int d = 0; d < 4; ++d)
#pragma unroll
        for (int r = 0; r < 16; ++r) O[d][r] = 0.f;
    float mrun = -1e30f, lsum = 0.f;

    v4u st[4]; float ckreg = 0.f;
    const bool vrole = tid < 256;
    const int kg = tid & 15, dg = (tid >> 4) & 15, t2 = tid & 255;
    const bf16* kbase = P + rowbase * NPROJ + colk + h * HD;
    const bf16* vbase = P + rowbase * NPROJ + colv + h * HD;
#define ATT_LOAD(kt) do { const size_t r0_ = (size_t)(kt) * 64; \
        if (vrole) { _Pragma("unroll") for (int i_ = 0; i_ < 4; ++i_) st[i_] = *(const v4u*)(vbase + (r0_ + 4 * kg + i_) * NPROJ + 8 * dg); } \
        else { _Pragma("unroll") for (int i_ = 0; i_ < 4; ++i_) { const int p_ = t2 + 256 * i_; st[i_] = *(const v4u*)(kbase + (r0_ + (p_ >> 4)) * NPROJ + 8 * (p_ & 15)); } } \
        if (MODE == 1 && tid < 64) ckreg = cum[r0_ + tid] * LOG2E; } while (0)
#define ATT_STORE(buf) do { \
        if (vrole) { LAS unsigned char* vb_ = lds + OFF_V + (buf) * VBUF + kg * 8; \
            _Pragma("unroll") for (int c_ = 0; c_ < 4; ++c_) { const unsigned a0 = st[0][c_], a1 = st[1][c_], a2 = st[2][c_], a3 = st[3][c_]; \
                v2u e_, o_; e_.x = (a0 & 0xffffu) | (a1 << 16); e_.y = (a2 & 0xffffu) | (a3 << 16); o_.x = (a0 >> 16) | (a1 & 0xffff0000u); o_.y = (a2 >> 16) | (a3 & 0xffff0000u); \
                *(LAS v2u*)(vb_ + (8 * dg + 2 * c_) * VROW) = e_; *(LAS v2u*)(vb_ + (8 * dg + 2 * c_ + 1) * VROW) = o_; } } \
        else { _Pragma("unroll") for (int i_ = 0; i_ < 4; ++i_) { const int p_ = t2 + 256 * i_; *(LAS v4u*)(lds + OFF_K + (buf) * KBUF + (p_ >> 4) * KROW + (p_ & 15) * 16) = st[i_]; } } \
        if (MODE == 1 && tid < 64) ckl[(buf) * 64 + tid] = ckreg; } while (0)

    ATT_LOAD(kt_first); ATT_STORE(0);
    __syncthreads();
    for (int it = 0; it < ntiles; ++it) {
        const int kt = kt_first + it * kt_step, buf = it & 1;
        if (it + 1 < ntiles) ATT_LOAD(kt + kt_step);
        const bool active = MODE == 0 ? (kt <= cq && kt >= cq - 8) : (kt <= cq);
        if (active) {
            f32x16 p0, p1;
#pragma unroll
            for (int r = 0; r < 16; ++r) { p0[r] = 0.f; p1[r] = 0.f; }
            const LAS unsigned char* kb = lds + OFF_K + buf * KBUF + q * KROW + 16 * hi;
#pragma unroll
            for (int s = 0; s < 8; ++s) {
                const bf16x8 k0 = *(const LAS bf16x8*)(kb + 32 * s), k1 = *(const LAS bf16x8*)(kb + 32 * KROW + 32 * s);
                p0 = MFMA32(k0, qf[s], p0); p1 = MFMA32(k1, qf[s], p1);
            }
            constexpr float C2 = QK_SCALE * LOG2E;
            const int key0 = kt * 64 + 4 * hi;
            if (MODE == 0) {
                if (cq - kt >= 5) { const float bc = tab[512];
#pragma unroll
                    for (int r = 0; r < 16; ++r) { p0[r] = p0[r] * C2 + bc; p1[r] = p1[r] * C2 + bc; } }
                else { const int d0 = qpos - key0 + 256;
#pragma unroll
                    for (int r = 0; r < 16; ++r) { const int c = (r & 3) + 8 * (r >> 2);
                        int i0 = d0 - c, i1 = d0 - c - 32; i0 = i0 < 0 ? 0 : (i0 > 512 ? 512 : i0); i1 = i1 < 0 ? 0 : (i1 > 512 ? 512 : i1);
                        p0[r] = p0[r] * C2 + tab[i0]; p1[r] = p1[r] * C2 + tab[i1]; } }
            } else {
                const LAS float* ck = ckl + buf * 64 + 4 * hi;
#pragma unroll
                for (int g = 0; g < 4; ++g) { const f32x4 c0 = *(const LAS f32x4*)(ck + 8 * g), c1 = *(const LAS f32x4*)(ck + 32 + 8 * g);
#pragma unroll
                    for (int e = 0; e < 4; ++e) { p0[4 * g + e] = p0[4 * g + e] * C2 + (cqv - c0[e]); p1[4 * g + e] = p1[4 * g + e] * C2 + (cqv - c1[e]); } }
                if (kt == cq) { const float NEG = -__builtin_inff();
#pragma unroll
                    for (int r = 0; r < 16; ++r) { const int key = key0 + (r & 3) + 8 * (r >> 2); if (key > qpos) p0[r] = NEG; if (key + 32 > qpos) p1[r] = NEG; } }
            }
            float mt = p0[0];
#pragma unroll
            for (int r = 1; r < 16; ++r) mt = fmaxf(mt, p0[r]);
#pragma unroll
            for (int r = 0; r < 16; ++r) mt = fmaxf(mt, p1[r]);
            mt = fmaxf(mt, __shfl_xor(mt, 32));
            const float mn = fmaxf(mrun, mt), alpha = __builtin_amdgcn_exp2f(mrun - mn);
            mrun = mn;
            float ps = 0.f;
#pragma unroll
            for (int r = 0; r < 16; ++r) { p0[r] = __builtin_amdgcn_exp2f(p0[r] - mn); p1[r] = __builtin_amdgcn_exp2f(p1[r] - mn); ps += p0[r] + p1[r]; }
            lsum = lsum * alpha + ps;
#pragma unroll
            for (int d = 0; d < 4; ++d)
#pragma unroll
                for (int r = 0; r < 16; ++r) O[d][r] *= alpha;
            bf16x8 pf[4];
            pf[0] = cvt8((f32x8){p0[0], p0[1], p0[2], p0[3], p0[4], p0[5], p0[6], p0[7]});
            pf[1] = cvt8((f32x8){p0[8], p0[9], p0[10], p0[11], p0[12], p0[13], p0[14], p0[15]});
            pf[2] = cvt8((f32x8){p1[0], p1[1], p1[2], p1[3], p1[4], p1[5], p1[6], p1[7]});
            pf[3] = cvt8((f32x8){p1[8], p1[9], p1[10], p1[11], p1[12], p1[13], p1[14], p1[15]});
            const LAS unsigned char* vb = lds + OFF_V + buf * VBUF + q * VROW + 8 * hi;
#pragma unroll
            for (int d = 0; d < 4; ++d)
#pragma unroll
                for (int ks = 0; ks < 4; ++ks) {
                    const v2u lo = *(const LAS v2u*)(vb + d * 32 * VROW + ks * 32), hh = *(const LAS v2u*)(vb + d * 32 * VROW + ks * 32 + 16);
                    const v4u vv = {lo.x, lo.y, hh.x, hh.y};
                    O[d] = MFMA32(__builtin_bit_cast(bf16x8, vv), pf[ks], O[d]);
                }
        }
        if (it + 1 < ntiles) ATT_STORE(buf ^ 1);
        __syncthreads();
    }
#undef ATT_LOAD
#undef ATT_STORE
    const float ltot = lsum + __shfl_xor(lsum, 32), inv = 1.0f / ltot;
    bf16* op = (bf16*)(a.ws + WS_O) + (rowbase + qpos) * D + MODE * 1024 + h * HD + 4 * hi;
#pragma unroll
    for (int d = 0; d < 4; ++d)
#pragma unroll
        for (int g = 0; g < 4; ++g) { const f32x4 v = {O[d][4 * g] * inv, O[d][4 * g + 1] * inv, O[d][4 * g + 2] * inv, O[d][4 * g + 3] * inv};
            *(v2u*)(op + 32 * d + 8 * g) = cvt4(v); }
}
}

namespace s5 {
constexpr int XROW = 272, XIMG = 32 * XROW, OFF_X = 0, OFF_E = 8 * XIMG, LDS_END = OFF_E + 8 * 64 * 8;
static_assert(LDS_END <= RING_BYTES, "s5 LDS");
struct LamC { float lr, li, cr, ci; };
__device__ __forceinline__ LamC lam_coef(const float* are, const float* aim, float dt, int n) {
    const float ar = fminf(are[n], -1e-4f), ai = aim[n];
    const float zr = ar * dt, zi = ai * dt;
    float sn, cs; sincosf(zi, &sn, &cs);
    const float er = expf(zr);
    LamC o; o.lr = er * cs; o.li = er * sn;
    const float sh = sinf(0.5f * zi);
    const float nr = expm1f(zr) * cs - 2.0f * sh * sh, ni = o.li;
    const float den = 1.0f / (ar * ar + ai * ai);
    o.cr = (nr * ar + ni * ai) * den; o.ci = (ni * ar - nr * ai) * den;
    return o;
}
__device__ __forceinline__ float gelu_tanh(float y) {
    const float z = 0.7978845608028654f * (y + 0.044715f * y * y * y);
    return y * __builtin_amdgcn_rcpf(1.0f + __builtin_amdgcn_exp2f(-2.0f * LOG2E * z));
}
__device__ __forceinline__ void s5_unit(CArgs& a, LAS unsigned char* lds, int l, int b, int g, int wave, int lane) {
    const int c32 = lane & 31, hi = lane >> 5;
    const float* are = a.in[8] + (size_t)(l * NG + g) * NS; const float* aim = a.in[9] + (size_t)(l * NG + g) * NS;
    const float dt = expf(a.in[10][l * NG + g]);
    const LamC me = lam_coef(are, aim, dt, lane);
    bf16x8 bb[4];
#pragma unroll
    for (int st = 0; st < 2; ++st) { const int ns = 32 * st + c32; const LamC cc = lam_coef(are, aim, dt, ns);
        const float* br = a.in[11] + ((size_t)(l * NG + g) * NS + ns) * 16 + 8 * hi; const float* bi = a.in[12] + ((size_t)(l * NG + g) * NS + ns) * 16 + 8 * hi;
        f32x8 vr, vi;
#pragma unroll
        for (int j = 0; j < 8; ++j) { const float xr = br[j], xi = bi[j]; vr[j] = cc.cr * xr - cc.ci * xi; vi[j] = cc.cr * xi + cc.ci * xr; }
        bb[st] = cvt8(vr); bb[2 + st] = cvt8(vi); }
    bf16x8 cf[8];
    { const float msk = c32 < 16 ? 1.f : 0.f; const int ii = c32 & 15;
        const float* cr = a.in[13] + ((size_t)(l * NG + g) * 16 + ii) * NS + 4 * hi; const float* ci = a.in[14] + ((size_t)(l * NG + g) * 16 + ii) * NS + 4 * hi;
#pragma unroll
        for (int s = 0; s < 8; ++s) { const f32x4 r4 = *(const f32x4*)(cr + 8 * s), i4 = *(const f32x4*)(ci + 8 * s);
            cf[s] = cvt8((f32x8){r4.x * msk, -i4.x * msk, r4.y * msk, -i4.y * msk, r4.z * msk, -i4.z * msk, r4.w * msk, -i4.w * msk}); } }
    bf16x8 df;
    { const float dv = c32 < 16 ? a.in[15][(size_t)l * SSMW + g * 16 + (c32 & 15)] : 0.f; f32x8 v;
#pragma unroll
        for (int j = 0; j < 8; ++j) v[j] = (8 * hi + j == c32) ? dv : 0.f;
        df = cvt8(v); }

    const bf16* up = (const bf16*)(a.ws + WS_PROJ) + ((size_t)b * SEQ + wave * 1024 + c32) * NPROJ + COL_U + g * 16 + 8 * hi;
    bf16* yg = (bf16*)(a.ws + WS_YG) + ((size_t)b * SEQ + wave * 1024 + c32) * SSMW + g * 16 + 4 * hi;
    LAS unsigned char* ximg = lds + OFF_X + wave * XIMG;
    LAS float* ebuf = (LAS float*)(lds + OFF_E);

    float xr = 0.f, xi = 0.f;
    for (int pass = 0; pass < 2; ++pass) {
        bf16x8 un = *(const bf16x8*)up;
        for (int sc = 0; sc < 32; ++sc) {
            const bf16x8 uf = un;
            if (sc + 1 < 32) un = *(const bf16x8*)(up + (size_t)(sc + 1) * 32 * NPROJ);
            f32x16 z;
#pragma unroll
            for (int r = 0; r < 16; ++r) z[r] = 0.f;
            f32x16 c0 = MFMA32(uf, bb[0], z), c1 = MFMA32(uf, bb[1], z), c2 = MFMA32(uf, bb[2], z), c3 = MFMA32(uf, bb[3], z);
            f32x16 re0, re1, im0, im1;
#pragma unroll
            for (int r = 0; r < 16; ++r) {
                const float f0 = c0[r], f1 = c1[r], f2 = c2[r], f3 = c3[r];
                const auto s0 = __builtin_amdgcn_permlane32_swap(__float_as_uint(f0), __float_as_uint(f1), false, false);
                const auto s1 = __builtin_amdgcn_permlane32_swap(__float_as_uint(f2), __float_as_uint(f3), false, false);
                const unsigned u00 = s0[0], u01 = s0[1], u10 = s1[0], u11 = s1[1];
                re0[r] = __uint_as_float(u00); re1[r] = __uint_as_float(u01); im0[r] = __uint_as_float(u10); im1[r] = __uint_as_float(u11);
            }
#pragma unroll
            for (int q4 = 0; q4 < 4; ++q4) {
#pragma unroll
                for (int i = 0; i < 4; ++i) { const int r = 4 * q4 + i; const float nr = me.lr * xr - me.li * xi + re0[r], ni = me.lr * xi + me.li * xr + im0[r]; xr = nr; xi = ni; re0[r] = nr; im0[r] = ni; }
#pragma unroll
                for (int i = 0; i < 4; ++i) { const int r = 4 * q4 + i; const float nr = me.lr * xr - me.li * xi + re1[r], ni = me.lr * xi + me.li * xr + im1[r]; xr = nr; xi = ni; re1[r] = nr; im1[r] = ni; }
            }
#ifdef SELFTEST
            const bool dbg = (b == 0 && g == 0 && wave == 0 && sc == 0 && pass == 1); float* dbgp = (float*)(a.ws + WS_KNT + 65536);
            if (dbg) {
#pragma unroll
                for (int r = 0; r < 16; ++r) { dbgp[4096 + (crow(r, 0) * 64 + lane) * 2] = re0[r]; dbgp[4096 + (crow(r, 0) * 64 + lane) * 2 + 1] = im0[r]; dbgp[4096 + (crow(r, 1) * 64 + lane) * 2] = re1[r]; dbgp[4096 + (crow(r, 1) * 64 + lane) * 2 + 1] = im1[r]; } }
#endif
            if (pass == 1) {
#pragma unroll
                for (int r = 0; r < 16; ++r) {
                    *(LAS unsigned*)(ximg + crow(r, 0) * XROW + 4 * lane) = cvt2(re0[r], im0[r]);
                    *(LAS unsigned*)(ximg + crow(r, 1) * XROW + 4 * lane) = cvt2(re1[r], im1[r]);
                }
                f32x16 y;
#pragma unroll
                for (int r = 0; r < 16; ++r) y[r] = 0.f;
#pragma unroll
                for (int s = 0; s < 8; ++s) { const bf16x8 xf = *(const LAS bf16x8*)(ximg + c32 * XROW + 32 * s + 16 * hi); y = MFMA32(cf[s], xf, y); }
                y = MFMA32(df, uf, y);
#ifdef SELFTEST
                if (dbg) {
#pragma unroll
                    for (int r = 0; r < 8; ++r) dbgp[8192 + c32 * 16 + crow(r, hi)] = y[r]; }
#endif
                bf16* yo = yg + (size_t)sc * 32 * SSMW;
                *(v2u*)yo = cvt4((f32x4){gelu_tanh(y[0]), gelu_tanh(y[1]), gelu_tanh(y[2]), gelu_tanh(y[3])});
                *(v2u*)(yo + 8) = cvt4((f32x4){gelu_tanh(y[4]), gelu_tanh(y[5]), gelu_tanh(y[6]), gelu_tanh(y[7])});
            }
        }
        if (pass == 0) {
            ebuf[(wave * 64 + lane) * 2] = xr; ebuf[(wave * 64 + lane) * 2 + 1] = xi;
            __syncthreads();
            float pr = me.lr, pi = me.li;
#pragma unroll
            for (int i = 0; i < 10; ++i) { const float nr = pr * pr - pi * pi, ni = 2.f * pr * pi; pr = nr; pi = ni; }
            xr = 0.f; xi = 0.f;
            for (int w2 = 0; w2 < wave; ++w2) { const float er = ebuf[(w2 * 64 + lane) * 2], ei = ebuf[(w2 * 64 + lane) * 2 + 1];
                const float nr = pr * xr - pi * xi + er, ni = pr * xi + pi * xr + ei; xr = nr; xi = ni; }
        }
    }
    __syncthreads();
}
}
#ifdef SELFTEST
namespace st {
constexpr int CW_DIAG = 2048;
__device__ __forceinline__ unsigned hash32(unsigned x) { x ^= x >> 16; x *= 0x7feb352du; x ^= x >> 15; x *= 0x846ca68bu; x ^= x >> 16; return x; }
__device__ __forceinline__ float bf2f(bf16 v) { return __builtin_bit_cast(float, (unsigned)v << 16); }
__device__ __forceinline__ void fail(unsigned* diag, int bit) { atomicOr(diag, 1u << bit); }
__device__ __forceinline__ bool close(float got, float ref, float atol, float rtol) { return fabsf(got - ref) <= atol + rtol * fabsf(ref); }
__device__ __forceinline__ float dot_bf16(const bf16* x, const bf16* y, int K, int lane) { float s = 0.f; for (int k = lane; k < K; k += 64) s += bf2f(x[k]) * bf2f(y[k]); return wave_sum(s); }
__device__ __forceinline__ float sigmoidf(float z) { return 1.0f / (1.0f + expf(-z)); }

__device__ __forceinline__ void check_weights(CArgs& a, unsigned* diag, int wave, int lane) {
    for (int l = 0; l < LAYERS; ++l) {
        const unsigned char* wl = a.ws + WS_W + (size_t)l * W_LAYER;
        for (int it = 0; it < 4; ++it) {
            const unsigned hsh = hash32((unsigned)(l * 1000 + wave * 64 + lane + it * 7919));
            bool ok = true;
            { const int n = hsh % NPROJ, k = (hsh >> 13) % D; const float ref = a.in[1][(size_t)l * D * INCOLS + (size_t)k * INCOLS + (n < COL_U ? n : n + 8)] * a.in[3][l * D + k];
              ok = ok && close(bf2f(((const bf16*)(wl + W_IN))[(size_t)n * D + k]), ref, 1e-6f, 0.01f); }
            { const int n = hsh % SSMW, k = (hsh >> 13) % SSMW; const float ref = a.in[16][(size_t)l * SSMW * SSMW + (size_t)k * SSMW + n];
              ok = ok && close(bf2f(((const bf16*)(wl + W_GLU))[(size_t)n * SSMW + k]), ref, 1e-6f, 0.01f); }
            { const int n = hsh % D, k = (hsh >> 13) % D; const float ref = a.in[2][(size_t)l * D * D + (size_t)k * D + n] * a.in[5][l * D + k];
              ok = ok && close(bf2f(((const bf16*)(wl + W_OUT))[(size_t)n * D + k]), ref, 1e-6f, 0.01f); }
            { const int r = hsh % NGU, k = (hsh >> 13) % D; const int tile = r >> 8, within = r & 255; const float* src = within < 128 ? a.in[20] : a.in[21];
              const float ref = src[(size_t)l * D * DFF + (size_t)k * DFF + 128 * tile + (within & 127)] * a.in[18][l * D + k];
              ok = ok && close(bf2f(((const bf16*)(wl + W_GU))[(size_t)r * D + k]), ref, 1e-6f, 0.01f); }
            { const int n = hsh % D, k = (hsh >> 13) % DFF; const float ref = a.in[22][(size_t)l * DFF * D + (size_t)k * D + n];
              ok = ok && close(bf2f(((const bf16*)(wl + W_D))[(size_t)n * DFF + k]), ref, 1e-6f, 0.01f); }
            if (!ok) fail(diag, 6);
        }
    }
}
__device__ __forceinline__ void check_norm_fb(CArgs& a, unsigned* diag, int l, const float* xsrc, int wave, int lane) {
    const int m = hash32(77u + wave) % M; const float* x = xsrc + (size_t)m * D;
    float ss = 0.f; for (int k = lane; k < D; k += 64) ss += x[k] * x[k];
    ss = wave_sum(ss); const float rstd = 1.0f / sqrtf(ss / D + RMS_EPS);
    const bf16* H = (const bf16*)(a.ws + WS_H) + (size_t)m * D; bool ok = true;
    for (int k = lane; k < D; k += 64) ok = ok && close(bf2f(H[k]), x[k] * rstd, 1e-3f, 0.01f);
    for (int hh = 0; hh < NH; ++hh) { float s = 0.f;
        for (int k = lane; k < D; k += 64) s += x[k] * rstd * a.in[3][l * D + k] * a.in[1][(size_t)l * D * INCOLS + (size_t)k * INCOLS + COL_U + hh];
        s = wave_sum(s) + a.in[7][l * NH + hh]; const float ls = fminf(s, 0.f) - log1pf(expf(-fabsf(s)));
        const int b = m / SEQ, sq = m % SEQ; ok = ok && close(((const float*)(a.ws + WS_LS))[(size_t)(b * NH + hh) * SEQ + sq], ls, 2e-3f, 2e-3f); }
    if (!__all(ok)) { if (lane == 0) fail(diag, 8); }
}
__device__ __forceinline__ void check_cum(CArgs& a, unsigned* diag, int wave, int lane) {
    const int seq = hash32(5u + wave) % (BATCH * NH), s = hash32(99u + wave) % SEQ; const float* ls = (const float*)(a.ws + WS_LS) + (size_t)seq * SEQ;
    float t = 0.f; for (int i = lane; i <= s; i += 64) t += ls[i];
    t = wave_sum(t); const float got = ((const float*)(a.ws + WS_CUM))[(size_t)seq * SEQ + s];
    if (!close(got, t, 0.05f, 1e-3f)) { if (lane == 0) fail(diag, 8); }
}
template <bool F32OUT>
__device__ __forceinline__ void check_gemm(unsigned* diag, int bit, const bf16* A, int lda, const bf16* Bt, int K, const void* Out, int ldo, int Mr, int N, unsigned seed, int wave, int lane) {
    for (int it = 0; it < 4; ++it) { const unsigned hsh = hash32(seed + wave * 16 + it); const int m = hsh % Mr, n = (hsh >> 11) % N;
        const float ref = dot_bf16(A + (size_t)m * lda, Bt + (size_t)n * K, K, lane);
        const float got = F32OUT ? ((const float*)Out)[(size_t)m * ldo + n] : bf2f(((const bf16*)Out)[(size_t)m * ldo + n]);
        if (!close(got, ref, 0.02f, 0.02f)) { if (lane == 0) fail(diag, bit); } }
}
template <int MODE>
__device__ __forceinline__ void check_attn(CArgs& a, unsigned* diag, int l, int wave, int lane) {
    const unsigned hsh = hash32(1234u + MODE * 100 + wave);
    const int b = hsh & 1, h = (hsh >> 1) & 7; int qpos = (hsh >> 4) % SEQ; if (MODE == 1 && wave >= 2) qpos %= 1500;
    if (wave == 0) qpos = 17; if (wave == 1) qpos = MODE == 0 ? 8191 : 700;
    const bf16* P = (const bf16*)(a.ws + WS_PROJ); const int colq = MODE == 0 ? COL_QA : COL_QB, colk = MODE == 0 ? COL_KA : COL_KB, colv = MODE == 0 ? COL_VA : COL_VB;
    const bf16* qrow = P + ((size_t)b * SEQ + qpos) * NPROJ + colq + h * HD;
    const float q0 = bf2f(qrow[lane]), q1 = bf2f(qrow[lane + 64]);
    const float* cum = (const float*)(a.ws + WS_CUM) + (size_t)(b * NH + h) * SEQ;
    const float* rb = a.in[6] + (size_t)(l * NH + h) * 513;
    int klo, khi;
    if (MODE == 0) { const int c = qpos / 64; klo = (c - 8) * 64; if (klo < 0) klo = 0; khi = c * 64 + 63; } else { klo = 0; khi = qpos; }
    float mx = -1e30f, lsum = 0.f, o0 = 0.f, o1 = 0.f;
    for (int j = klo; j <= khi; ++j) {
        const bf16* krow = P + ((size_t)b * SEQ + j) * NPROJ + colk + h * HD; const bf16* vrow = P + ((size_t)b * SEQ + j) * NPROJ + colv + h * HD;
        float s = wave_sum(q0 * bf2f(krow[lane]) + q1 * bf2f(krow[lane + 64])) * QK_SCALE;
        if (MODE == 0) { int dd = qpos - j; dd = dd < -256 ? -256 : (dd > 256 ? 256 : dd); s += rb[dd + 256]; } else s += cum[qpos] - cum[j];
        const float mn = fmaxf(mx, s), al = expf(mx - mn), p = expf(s - mn);
        lsum = lsum * al + p; o0 = o0 * al + p * bf2f(vrow[lane]); o1 = o1 * al + p * bf2f(vrow[lane + 64]); mx = mn;
    }
    const bf16* orow = (const bf16*)(a.ws + WS_O) + ((size_t)b * SEQ + qpos) * D + MODE * 1024 + h * HD;
    const bool ok = close(bf2f(orow[lane]), o0 / lsum, 0.02f, 0.03f) && close(bf2f(orow[lane + 64]), o1 / lsum, 0.02f, 0.03f);
    if (!__all(ok)) { if (lane == 0) fail(diag, 1 + MODE); }
}
__device__ __forceinline__ void check_s5(CArgs& a, unsigned* diag, int l, int wave, int lane) {
    const unsigned hsh = hash32(4321u + wave); const int b = hsh & 1, g = (hsh >> 1) % NG, t = wave == 0 ? 3 : wave == 1 ? 31 : wave == 2 ? 33 : wave == 3 ? 100 : wave == 4 ? 1023 : wave == 5 ? 1024 : wave == 6 ? 1100 : 3000;
    const float ar = fminf(a.in[8][(size_t)(l * NG + g) * NS + lane], -1e-4f), ai = a.in[9][(size_t)(l * NG + g) * NS + lane], dt = expf(a.in[10][l * NG + g]);
    const float er = expf(ar * dt), lr = er * cosf(ai * dt), li = er * sinf(ai * dt);
    const float nr = lr - 1.f, ni = li, den = ar * ar + ai * ai, cr = (nr * ar + ni * ai) / den, ci = (ni * ar - nr * ai) / den;
    float bbr[16], bbi[16];
#pragma unroll
    for (int j = 0; j < 16; ++j) { const float xr = a.in[11][((size_t)(l * NG + g) * NS + lane) * 16 + j], xi = a.in[12][((size_t)(l * NG + g) * NS + lane) * 16 + j]; bbr[j] = cr * xr - ci * xi; bbi[j] = cr * xi + ci * xr; }
    const bf16* P = (const bf16*)(a.ws + WS_PROJ);
    float xr = 0.f, xi = 0.f;
    for (int s = 0; s <= t; ++s) { const bf16* u = P + ((size_t)b * SEQ + s) * NPROJ + COL_U + g * 16; float br = 0.f, bi = 0.f;
#pragma unroll
        for (int j = 0; j < 16; ++j) { const float uv = bf2f(u[j]); br += bbr[j] * uv; bi += bbi[j] * uv; }
        const float tr = lr * xr - li * xi + br, ti = lr * xi + li * xr + bi; xr = tr; xi = ti; }
    const bf16* u = P + ((size_t)b * SEQ + t) * NPROJ + COL_U + g * 16; const bf16* yg = (const bf16*)(a.ws + WS_YG) + ((size_t)b * SEQ + t) * SSMW + g * 16;
    bool ok = true;
    for (int i = 0; i < 16; ++i) { const float c_r = a.in[13][((size_t)(l * NG + g) * 16 + i) * NS + lane], c_i = a.in[14][((size_t)(l * NG + g) * 16 + i) * NS + lane];
        float y = wave_sum(c_r * xr - c_i * xi) + a.in[15][(size_t)l * SSMW + g * 16 + i] * bf2f(u[i]);
        const float z = 0.7978845608028654f * (y + 0.044715f * y * y * y); y = y / (1.0f + expf(-2.0f * z));
        ok = ok && close(bf2f(yg[i]), y, 0.01f, 0.03f); }
    if (!ok) { if (lane == 0) fail(diag, 3); }
}
__device__ __forceinline__ void check_glu(CArgs& a, unsigned* diag, int l, int wave, int lane) {
    for (int it = 0; it < 4; ++it) { const unsigned hsh = hash32(555u + wave * 16 + it); const int m = hsh % M, n = (hsh >> 11) % SSMW;
        const bf16* Y = (const bf16*)(a.ws + WS_YG) + (size_t)m * SSMW;
        const float z = dot_bf16(Y, (const bf16*)(a.ws + WS_W + (size_t)l * W_LAYER + W_GLU) + (size_t)n * SSMW, SSMW, lane) + a.in[17][(size_t)l * SSMW + n];
        const float ref = bf2f(Y[n]) * sigmoidf(z), got = bf2f(((const bf16*)(a.ws + WS_O))[(size_t)m * D + 2048 + n]);
        if (!close(got, ref, 0.01f, 0.02f)) { if (lane == 0) fail(diag, 4); } }
}
__device__ __forceinline__ void check_act(CArgs& a, unsigned* diag, int l, int wave, int lane) {
    for (int it = 0; it < 4; ++it) { const unsigned hsh = hash32(777u + wave * 16 + it); const int m = hsh % M, n = (hsh >> 11) % DFF;
        const bf16* H = (const bf16*)(a.ws + WS_H) + (size_t)m * D; const bf16* W = (const bf16*)(a.ws + WS_W + (size_t)l * W_LAYER + W_GU);
        const int tile = n >> 7, within = n & 127;
        const float gt = dot_bf16(H, W + (size_t)(256 * tile + within) * D, D, lane), up = dot_bf16(H, W + (size_t)(256 * tile + 128 + within) * D, D, lane);
        const float ref = gt * sigmoidf(gt) * up, got = bf2f(((const bf16*)(a.ws + WS_ACT))[(size_t)m * DFF + n]);
        if (!close(got, ref, 0.02f, 0.03f)) { if (lane == 0) fail(diag, 5); } }
}
__device__ __forceinline__ void check_mix(CArgs& a, unsigned* diag, int wave, int lane) {
    const int m = hash32(31u + wave) % M; const bf16* X = (const bf16*)(a.ws + WS_O) + (size_t)m * D; float sa = 0.f, sb = 0.f, sc = 0.f;
    for (int k = lane; k < 1024; k += 64) { const float x = bf2f(X[k]), y = bf2f(X[1024 + k]); sa += x * x; sb += y * y; }
    for (int k = lane; k < 2048; k += 64) { const float x = bf2f(X[2048 + k]); sc += x * x; }
    sa = wave_sum(sa) / 1024.f; sb = wave_sum(sb) / 1024.f; sc = wave_sum(sc) / 2048.f;
    if (!(close(sa, 1.f, 0.f, 0.02f) && close(sb, 1.f, 0.f, 0.02f) && close(sc, 1.f, 0.f, 0.02f))) { if (lane == 0) fail(diag, 8); }
}
__device__ __forceinline__ void check_post(CArgs& a, unsigned* diag, const float* xsrc_old_is_gone, const float* gpost, bool check_h, int wave, int lane) {
    const int m = hash32(911u + wave) % M; const float* y = (const float*)(a.ws + WS_Y32) + (size_t)m * D; const float* xn = a.out + (size_t)m * D;
    bool ok = true;
    if (xsrc_old_is_gone) { float ss = 0.f; for (int k = lane; k < D; k += 64) ss += y[k] * y[k];
        ss = wave_sum(ss); const float ry = 1.0f / sqrtf(ss / D + RMS_EPS);
        for (int k = lane; k < D; k += 64) ok = ok && close(xn[k], xsrc_old_is_gone[(size_t)m * D + k] + y[k] * ry * gpost[k], 1e-4f, 1e-4f); }
    if (check_h) { float ss = 0.f; for (int k = lane; k < D; k += 64) ss += xn[k] * xn[k];
        ss = wave_sum(ss); const float r = 1.0f / sqrtf(ss / D + RMS_EPS); const bf16* H = (const bf16*)(a.ws + WS_H) + (size_t)m * D;
        for (int k = lane; k < D; k += 64) ok = ok && close(bf2f(H[k]), xn[k] * r, 1e-3f, 0.01f); }
    if (!__all(ok)) { if (lane == 0) fail(diag, 8); }
}
__device__ __forceinline__ void check_s5_dump(CArgs& a, unsigned* diag2, int l, int lane) {
    const int b = 0, g = 0; const float* dbgp = (const float*)(a.ws + WS_KNT + 65536);
    const float ar = fminf(a.in[8][(size_t)(l * NG + g) * NS + lane], -1e-4f), ai = a.in[9][(size_t)(l * NG + g) * NS + lane], dt = expf(a.in[10][l * NG + g]);
    const float er = expf(ar * dt), lr = er * cosf(ai * dt), li = er * sinf(ai * dt);
    const float nr = lr - 1.f, ni = li, den = ar * ar + ai * ai, cr = (nr * ar + ni * ai) / den, ci = (ni * ar - nr * ai) / den;
    float bbr[16], bbi[16];
#pragma unroll
    for (int j = 0; j < 16; ++j) { const float xr = a.in[11][((size_t)(l * NG + g) * NS + lane) * 16 + j], xi = a.in[12][((size_t)(l * NG + g) * NS + lane) * 16 + j]; bbr[j] = cr * xr - ci * xi; bbi[j] = cr * xi + ci * xr; }
    const bf16* P = (const bf16*)(a.ws + WS_PROJ);
    float xr = 0.f, xi = 0.f; bool okbu = true, okx = true, oky = true, oky2 = true;
    for (int s = 0; s < 32; ++s) { const bf16* u = P + ((size_t)b * SEQ + s) * NPROJ + COL_U + g * 16; float br = 0.f, bi = 0.f;
#pragma unroll
        for (int j = 0; j < 16; ++j) { const float uv = bf2f(u[j]); br += bbr[j] * uv; bi += bbi[j] * uv; }
        { const float pxr = s ? dbgp[4096 + ((s - 1) * 64 + lane) * 2] : 0.f, pxi = s ? dbgp[4096 + ((s - 1) * 64 + lane) * 2 + 1] : 0.f;
          const float gbr = dbgp[4096 + (s * 64 + lane) * 2] - (lr * pxr - li * pxi), gbi = dbgp[4096 + (s * 64 + lane) * 2 + 1] - (lr * pxi + li * pxr);
          okbu = okbu && close(gbr, br, 3e-4f, 0.02f) && close(gbi, bi, 3e-4f, 0.02f); }
        const float tr = lr * xr - li * xi + br, ti = lr * xi + li * xr + bi; xr = tr; xi = ti;
        okx = okx && close(dbgp[4096 + (s * 64 + lane) * 2], xr, 5e-4f, 0.02f) && close(dbgp[4096 + (s * 64 + lane) * 2 + 1], xi, 5e-4f, 0.02f);
        const float dxr = dbgp[4096 + (s * 64 + lane) * 2], dxi = dbgp[4096 + (s * 64 + lane) * 2 + 1];
        for (int i = 0; i < 16; ++i) { const float c_r = a.in[13][((size_t)(l * NG + g) * 16 + i) * NS + lane], c_i = a.in[14][((size_t)(l * NG + g) * 16 + i) * NS + lane];
            const float du = a.in[15][(size_t)l * SSMW + g * 16 + i] * bf2f(u[i]);
            const float y1 = wave_sum(c_r * xr - c_i * xi) + du, y2 = wave_sum(c_r * dxr - c_i * dxi) + du, got = dbgp[8192 + s * 16 + i];
            oky = oky && close(got, y1, 0.01f, 0.02f); oky2 = oky2 && close(got, y2, 0.01f, 0.02f); }
    }
    if (!__all(okbu)) { if (lane == 0) fail(diag2, 0); }
    if (!__all(okx)) { if (lane == 0) fail(diag2, 1); }
    if (!oky) { if (lane == 0) fail(diag2, 2); }
    if (!oky2) { if (lane == 0) fail(diag2, 3); }
}
}
#endif
#ifndef ST_SEL
#define ST_SEL 0xFFFF
#endif
#define ST_ON(k) ((ST_SEL >> (k)) & 1)
#ifndef ST_LAYER
#define ST_LAYER 0
#endif
#ifndef PH_ENABLE
#define PH_ENABLE 0xFFFFFF
#endif
#define PH(b) ((PH_ENABLE >> (b)) & 1)
#define argp() (*({ CArgs* p_ = (CArgs*)__builtin_amdgcn_kernarg_segment_ptr(); asm volatile("" : "+s"(p_)); p_; }))
#define GRID_BAR() do { XcdBarrier b_ = bar; asm volatile("" : "+s"(b_.bar), "+s"(b_.x)); xcd_barrier(b_); } while (0)
#define tidp() ({ int t_ = (int)threadIdx.x; asm volatile("" : "+v"(t_)); t_; })
__global__ void __launch_bounds__(NWAVES * 64, 2) hybrid_fwd(Args args) {
    extern __shared__ __attribute__((aligned(16))) unsigned char lds_raw[];
    LAS unsigned char* lds = (LAS unsigned char*)lds_raw;
    const int tid = threadIdx.x, lane = tid & 63, wave = __builtin_amdgcn_readfirstlane(tid >> 6);
    const int G = gridDim.x, bx = blockIdx.x;
    const int vcu = (G % 8 == 0) ? (bx % 8) * (G / 8) + bx / 8 : bx;
    const int gw = vcu * NWAVES + wave, NGW = G * NWAVES;
    for (int u = tid; u < (LDS_BYTES - LDSCTL_OFF) / 4; u += NWAVES * 64) ((LAS unsigned*)(lds + LDSCTL_OFF))[u] = 0u;
    __syncthreads();
    volatile LAS unsigned* MISC = (volatile LAS unsigned*)(lds + MISC_OFF);
    XcdBarrier bar = xcd_barrier_post((unsigned*)(argp().ws + WS_CTL) + CW_BAR, MISC + 8);

    if (PH(0)) p0_weights(argp(), lds, gw, NGW, wave, tidp() & 63);
    __syncthreads();
    if (PH(1)) { const int t = tidp(); phase_norm0(argp(), lds, gw, NGW, t, t & 63); }
    GRID_BAR();
#ifdef SELFTEST
    { CArgs& A_ = argp(); unsigned* diag = (unsigned*)(A_.ws + WS_CTL) + st::CW_DIAG; const int ln = tidp() & 63; if (ST_ON(0) && vcu == 0) st::check_weights(A_, diag, wave, ln); if (ST_ON(0) && vcu == 1) st::check_norm_fb(A_, diag, 0, A_.in[0], wave, ln); }
    GRID_BAR();
#define ST(cond, code) do { if (l == ST_LAYER && (cond)) { CArgs& A_ = argp(); unsigned* diag = (unsigned*)(A_.ws + WS_CTL) + st::CW_DIAG; const int ln = tidp() & 63; code; } GRID_BAR(); } while (0)
#else
#define ST(cond, code) do { } while (0)
#endif

    for (int l = 0; l < LAYERS; ++l) {
        if (PH(2)) { unsigned char* ws = argp().ws; unsigned char* wl = ws + WS_W + (size_t)l * W_LAYER; pg8::Gemm g{(const pg8::bf16_t*)(ws + WS_H), (const pg8::bf16_t*)(wl + W_IN), M, NPROJ, D}; pg8::StaticOrder S; S.init(M, NPROJ, G, bx);
          pg8::EpiStoreBf16 E{(pg8::bf16_t*)(ws + WS_PROJ), NPROJ};
          pg8::gemm_phase<pg8::EpiStoreBf16, pg8::StaticOrder, PG8_ALIGN, PG8_SP2>(lds + RING_OFF, g, S, E, tidp()); }
        GRID_BAR();
        ST(ST_ON(1) && vcu == 2, st::check_gemm<false>(diag, 0, (const bf16*)(A_.ws + WS_H), D, (const bf16*)(A_.ws + WS_W + (size_t)l * W_LAYER + W_IN), D, A_.ws + WS_PROJ, NPROJ, M, NPROJ, 101u, wave, ln));
        if (PH(3)) phase_cum_knorm(argp(), l, gw, NGW, tidp() & 63);
        GRID_BAR();
        ST(ST_ON(2) && vcu == 3, st::check_cum(A_, diag, wave, ln));
        if (PH(4)) for (int u = vcu; u < BATCH * NG; u += G) s5::s5_unit(argp(), lds, l, u >> 7, u & 127, wave, tidp() & 63);
        if (PH(5)) for (int u = vcu; u < 256; u += G) { const int bh = u >> 4, x = u & 15;
            for (int k = 0; k < 2; ++k) { const int t = tidp(); att::attn_unit<0>(argp(), lds, l, bh >> 3, bh & 7, k ? x + 16 : x, t, wave, t & 63); } }
        if (PH(6)) for (int u = vcu; u < 256; u += G) { const int bh = u >> 4, x = u & 15;
            for (int k = 0; k < 2; ++k) { const int t = tidp(); att::attn_unit<1>(argp(), lds, l, bh >> 3, bh & 7, k ? 31 - x : x, t, wave, t & 63); } }
        GRID_BAR();
        ST(ST_ON(3) && vcu >= 4 && vcu <= 7, if (vcu == 4) st::check_attn<0>(A_, diag, l, wave, ln); if (vcu == 5) st::check_attn<1>(A_, diag, l, wave, ln); if (vcu == 6) st::check_s5(A_, diag, l, wave, ln); if (vcu == 7 && wave == 0) st::check_s5_dump(A_, diag + 64, l, ln));
        if (PH(7)) { CArgs& A_ = argp(); unsigned char* ws = A_.ws; unsigned char* wl = ws + WS_W + (size_t)l * W_LAYER; pg8::Gemm g{(const pg8::bf16_t*)(ws + WS_YG), (const pg8::bf16_t*)(wl + W_GLU), M, SSMW, SSMW}; pg8::StaticOrder S; S.init(M, SSMW, G, bx);
          pg8::EpiGlu E{(const pg8::bf16_t*)(ws + WS_YG), SSMW, (pg8::bf16_t*)(ws + WS_O) + 2048, D, A_.in[17] + (size_t)l * SSMW};
          pg8::gemm_phase<pg8::EpiGlu, pg8::StaticOrder, PG8_ALIGN, PG8_SP2>(lds + RING_OFF, g, S, E, tidp()); }
        GRID_BAR();
        ST(ST_ON(4) && vcu == 7, st::check_glu(A_, diag, l, wave, ln));
        if (PH(8)) phase_mixnorm(argp(), gw, NGW, tidp() & 63);
        GRID_BAR();
        ST(ST_ON(5) && vcu == 8, st::check_mix(A_, diag, wave, ln));
        if (PH(9)) { unsigned char* ws = argp().ws; unsigned char* wl = ws + WS_W + (size_t)l * W_LAYER; pg8::Gemm g{(const pg8::bf16_t*)(ws + WS_O), (const pg8::bf16_t*)(wl + W_OUT), M, D, D}; pg8::StaticOrder S; S.init(M, D, G, bx);
          pg8::EpiStoreF32 E{(float*)(ws + WS_Y32), D};
          pg8::gemm_phase<pg8::EpiStoreF32, pg8::StaticOrder, PG8_ALIGN, PG8_SP2>(lds + RING_OFF, g, S, E, tidp()); }
        GRID_BAR();
        ST(ST_ON(6) && vcu == 9, st::check_gemm<true>(diag, 7, (const bf16*)(A_.ws + WS_O), D, (const bf16*)(A_.ws + WS_W + (size_t)l * W_LAYER + W_OUT), D, A_.ws + WS_Y32, D, M, D, 202u, wave, ln));
        if (PH(10)) { CArgs& A_ = argp(); phase_post<true, false>(A_, lds, l == 0 ? A_.in[0] : (const float*)A_.out, A_.in[4] + (size_t)l * D, 0, gw, NGW, tidp(), tidp() & 63); }
        GRID_BAR();
        ST(ST_ON(7) && vcu == 10, st::check_post(A_, diag, l == 0 ? A_.in[0] : nullptr, A_.in[4] + (size_t)l * D, true, wave, ln));
        if (PH(11)) { unsigned char* ws = argp().ws; unsigned char* wl = ws + WS_W + (size_t)l * W_LAYER; pg8::Gemm g{(const pg8::bf16_t*)(ws + WS_H), (const pg8::bf16_t*)(wl + W_GU), M, NGU, D}; pg8::StaticOrder S; S.init(M, NGU, G, bx);
          pg8::EpiSwiGlu E{(pg8::bf16_t*)(ws + WS_ACT), DFF};
          pg8::gemm_phase<pg8::EpiSwiGlu, pg8::StaticOrder, PG8_ALIGN, PG8_SP2>(lds + RING_OFF, g, S, E, tidp()); }
        GRID_BAR();
        ST(ST_ON(8) && vcu == 11, st::check_act(A_, diag, l, wave, ln));
        if (PH(12)) { unsigned char* ws = argp().ws; unsigned char* wl = ws + WS_W + (size_t)l * W_LAYER; pg8::Gemm g{(const pg8::bf16_t*)(ws + WS_ACT), (const pg8::bf16_t*)(wl + W_D), M, D, DFF}; pg8::StaticOrder S; S.init(M, D, G, bx);
          pg8::EpiStoreF32 E{(float*)(ws + WS_Y32), D};
          pg8::gemm_phase<pg8::EpiStoreF32, pg8::StaticOrder, PG8_ALIGN, PG8_SP2>(lds + RING_OFF, g, S, E, tidp()); }
        GRID_BAR();
        ST(ST_ON(9) && vcu == 12, st::check_gemm<true>(diag, 9, (const bf16*)(A_.ws + WS_ACT), DFF, (const bf16*)(A_.ws + WS_W + (size_t)l * W_LAYER + W_D), DFF, A_.ws + WS_Y32, D, M, D, 303u, wave, ln));
        if (!PH(13)) {} else if (l + 1 < LAYERS) { CArgs& A_ = argp(); phase_post<true, true>(A_, lds, (const float*)A_.out, A_.in[19] + (size_t)l * D, l + 1, gw, NGW, tidp(), tidp() & 63); GRID_BAR(); }
        else { CArgs& A_ = argp(); phase_post<false, false>(A_, lds, (const float*)A_.out, A_.in[19] + (size_t)l * D, 0, gw, NGW, tidp(), tidp() & 63); }
    }
#ifdef SELFTEST
    GRID_BAR();
    if (bx == 0 && tid == 0) { unsigned* diag = (unsigned*)(argp().ws + WS_CTL) + st::CW_DIAG; const unsigned mask = __hip_atomic_load(diag, RLX_AGENT);
        const unsigned mask2 = __hip_atomic_load(diag + 64, RLX_AGENT);
        if (mask2) argp().out[1] = (float)(10u + mask2) * 1.0e6f;
        else if (mask) { float v = (float)(10u + (mask & 63u)) * 1000.0f; for (unsigned e = 0; e < (mask >> 6); ++e) v *= 10.0f; argp().out[0] = v; } }
#endif
}

extern "C" void kernel_launch(void* const* d_in, const int* in_sizes, int n_in, void* d_out, int out_size, void* d_ws, size_t ws_size, hipStream_t stream) {
    static int grid = 0;
    if (grid == 0) {
        if (n_in != 23 || in_sizes[0] != M * D || out_size != M * D || ws_size < WS_END) {
            fprintf(stderr, "kernel_launch: unexpected shapes: n_in %d in0 %d out %d ws %zu (need %zu)\n", n_in, n_in > 0 ? in_sizes[0] : -1, out_size, ws_size, (size_t)WS_END); grid = -1; return; }
        int dev = 0, cus = 0, per_cu = 0;
        if (hipGetDevice(&dev) != hipSuccess || hipDeviceGetAttribute(&cus, hipDeviceAttributeMultiprocessorCount, dev) != hipSuccess) { grid = -1; return; }
        if (hipFuncSetAttribute((const void*)hybrid_fwd, hipFuncAttributeMaxDynamicSharedMemorySize, LDS_BYTES) != hipSuccess) { fprintf(stderr, "kernel_launch: hipFuncSetAttribute failed\n"); grid = -1; return; }
        if (hipOccupancyMaxActiveBlocksPerMultiprocessor(&per_cu, (const void*)hybrid_fwd, NWAVES * 64, LDS_BYTES) != hipSuccess || per_cu < 1)
            fprintf(stderr, "kernel_launch: occupancy query reports %d workgroups per CU\n", per_cu);
        (void)hipGetLastError();
        grid = cus;
    }
    if (grid < 0) return;
    if (hipMemsetAsync((char*)d_ws + WS_CTL, 0, CTL_ZERO_BYTES, stream) != hipSuccess) return;
    Args a{};
    for (int i = 0; i < 23; ++i) a.in[i] = (const float*)d_in[i];
    a.out = (float*)d_out; a.ws = (unsigned char*)d_ws;
    hipLaunchKernelGGL(hybrid_fwd, dim3(grid), dim3(NWAVES * 64), LDS_BYTES, stream, a);
    const hipError_t le = hipPeekAtLastError();
    if (le != hipSuccess) fprintf(stderr, "kernel_launch: launch failed: %s\n", hipGetErrorName(le));
}
```

```cpp
#include <hip/hip_runtime.h>
#include <cstdio>
#include <cstdint>
namespace pg8 {
#define PG8_LAS __attribute__((address_space(3)))
typedef unsigned short bf16_t;
typedef short bf16x8 __attribute__((ext_vector_type(8)));
typedef float f32x4 __attribute__((ext_vector_type(4)));
typedef unsigned u32x4 __attribute__((ext_vector_type(4)));
constexpr int BM = 256, BK = 64, HALF = 128, HTB = HALF * BK * 2  , STAGE_BYTES = 8 * HTB, NXCD = 8, WGM = 8;

__host__ __device__ __forceinline__ int lds_byte(int r, int c) { const int st = (r >> 4) * 2 + (c >> 5), rr = r & 15, cc = c & 31, ob = rr * 64 + cc * 2; return st * 1024 + (ob ^ (((ob >> 9) & 1) << 5)); }
__host__ __device__ __forceinline__ void stage_rc(int b, int& R, int& C) { const int st = b / 1024, sb = b % 1024, swz = sb ^ (((sb >> 9) & 1) << 5); R = (st >> 1) * 16 + swz / 64; C = (st & 1) * 32 + (swz % 64) / 2; }
__host__ __device__ __forceinline__ int perm32(int rho) { const int n = rho >> 4, i = rho & 15; return 8 * (i >> 2) + 4 * n + (i & 3); }

struct Unit { int pm, pn; };
struct Gemm { const bf16_t* A; const bf16_t* Bt; int M, N, K; };

struct StaticOrder {
    int nM, nN, nwg, G, c;
    __host__ __device__ void init(int M, int N, int G_, int c_) { nM = M / BM; nN = N / BM; nwg = nM * nN; G = G_; c = c_; }
    __host__ __device__ bool next(int i, Unit& u) const {
        const long L = (long)i * G + c; if (L >= nwg) return false;
        int wgid = (int)L; { const int q = nwg / NXCD, r = nwg % NXCD, xcd = wgid % NXCD, off = wgid / NXCD; wgid = (xcd < r ? xcd * (q + 1) : r * (q + 1) + (xcd - r) * q) + off; }
        const int nig = WGM * nN, gid = wgid / nig, fm = gid * WGM, gsz = (nM - fm) < WGM ? (nM - fm) : WGM;
        u.pm = fm + ((wgid % nig) % gsz); u.pn = (wgid % nig) / gsz; return true;
    }
    __device__ __forceinline__ void a_ready(const Unit&) const {}
    __device__ __forceinline__ void done(const Unit&) const {}
};

__device__ __forceinline__ unsigned cvt_pk_bf16(float lo, float hi) { unsigned r; asm volatile("v_cvt_pk_bf16_f32 %0, %1, %2" : "=v"(r) : "v"(lo), "v"(hi)); return r; }
typedef unsigned u32x2 __attribute__((ext_vector_type(2)));
__device__ __forceinline__ float sigm(float z) { return __builtin_amdgcn_rcpf(1.0f + __builtin_amdgcn_exp2f(-1.4426950408889634f * z)); }
__device__ __forceinline__ float bflo(unsigned w) { return __builtin_bit_cast(float, w << 16); }
__device__ __forceinline__ float bfhi(unsigned w) { return __builtin_bit_cast(float, w & 0xffff0000u); }
struct EpiStoreBf16 {
    static constexpr bool PERM = true, AFTER_DRAIN = false;
    bf16_t* O; int ldc; const float* rs;
    __device__ __forceinline__ void operator()(const f32x4 (&acc)[2][2][4][2], const Unit& u, int wr, int wc, int fr, int fq) const {
        const int row0 = u.pm * BM + wr * 64 + fr, col0 = u.pn * BM + wc * 32 + 8 * fq;
#pragma unroll
        for (int ai = 0; ai < 2; ++ai)
#pragma unroll
            for (int m = 0; m < 4; ++m) { bf16_t* rowp = O + (size_t)(row0 + ai * HALF + m * 16) * ldc + col0; const float sc = rs ? rs[row0 + ai * HALF + m * 16] : 1.0f;
#pragma unroll
                for (int bj = 0; bj < 2; ++bj) { const f32x4 v0 = acc[ai][bj][m][0] * sc, v1 = acc[ai][bj][m][1] * sc;
                    u32x4 w; w.x = cvt_pk_bf16(v0[0], v0[1]); w.y = cvt_pk_bf16(v0[2], v0[3]); w.z = cvt_pk_bf16(v1[0], v1[1]); w.w = cvt_pk_bf16(v1[2], v1[3]);
                    *(u32x4*)(rowp + bj * HALF) = w; } }
    }
};
struct EpiStoreF32 {
    static constexpr bool PERM = false, AFTER_DRAIN = false;
    float* C; int ldc;
    __device__ __forceinline__ void operator()(const f32x4 (&acc)[2][2][4][2], const Unit& u, int wr, int wc, int fr, int fq) const {
        const int row0 = u.pm * BM + wr * 64 + fr, col0 = u.pn * BM + wc * 32 + 4 * fq;
#pragma unroll
        for (int ai = 0; ai < 2; ++ai)
#pragma unroll
            for (int m = 0; m < 4; ++m) { float* rowp = C + (size_t)(row0 + ai * HALF + m * 16) * ldc + col0;
#pragma unroll
                for (int bj = 0; bj < 2; ++bj)
#pragma unroll
                    for (int n = 0; n < 2; ++n) *(f32x4*)(rowp + bj * HALF + n * 16) = acc[ai][bj][m][n]; }
    }
};
struct EpiGlu {
    static constexpr bool PERM = true, AFTER_DRAIN = false;
    const bf16_t* Y; int ldy; bf16_t* O; int ldo; const float* bias;
    __device__ __forceinline__ void operator()(const f32x4 (&acc)[2][2][4][2], const Unit& u, int wr, int wc, int fr, int fq) const {
        const int row0 = u.pm * BM + wr * 64 + fr, col0 = u.pn * BM + wc * 32 + 8 * fq;
        f32x4 bv[2][2];
#pragma unroll
        for (int bj = 0; bj < 2; ++bj)
#pragma unroll
            for (int n = 0; n < 2; ++n) bv[bj][n] = *(const f32x4*)(bias + col0 + bj * HALF + 4 * n);
#pragma unroll
        for (int ai = 0; ai < 2; ++ai)
#pragma unroll
            for (int m = 0; m < 4; ++m) { const size_t r = (size_t)(row0 + ai * HALF + m * 16);
#pragma unroll
                for (int bj = 0; bj < 2; ++bj) { const u32x4 yv = *(const u32x4*)(Y + r * ldy + col0 + bj * HALF);
                    const f32x4 z0 = acc[ai][bj][m][0] + bv[bj][0], z1 = acc[ai][bj][m][1] + bv[bj][1];
                    u32x4 w;
                    w.x = cvt_pk_bf16(bflo(yv.x) * sigm(z0[0]), bfhi(yv.x) * sigm(z0[1])); w.y = cvt_pk_bf16(bflo(yv.y) * sigm(z0[2]), bfhi(yv.y) * sigm(z0[3]));
                    w.z = cvt_pk_bf16(bflo(yv.z) * sigm(z1[0]), bfhi(yv.z) * sigm(z1[1])); w.w = cvt_pk_bf16(bflo(yv.w) * sigm(z1[2]), bfhi(yv.w) * sigm(z1[3]));
                    *(u32x4*)(O + r * ldo + col0 + bj * HALF) = w; } }
    }
};
struct EpiSwiGlu {
    static constexpr bool PERM = true, AFTER_DRAIN = false;
    bf16_t* O; int ldc; const float* rs;
    __device__ __forceinline__ void operator()(const f32x4 (&acc)[2][2][4][2], const Unit& u, int wr, int wc, int fr, int fq) const {
        const int row0 = u.pm * BM + wr * 64 + fr, col0 = u.pn * HALF + wc * 32 + 8 * fq;
#pragma unroll
        for (int ai = 0; ai < 2; ++ai)
#pragma unroll
            for (int m = 0; m < 4; ++m) { bf16_t* rowp = O + (size_t)(row0 + ai * HALF + m * 16) * ldc + col0; const float sc = rs[row0 + ai * HALF + m * 16];
                const f32x4 g0 = acc[ai][0][m][0] * sc, g1 = acc[ai][0][m][1] * sc, u0 = acc[ai][1][m][0] * sc, u1 = acc[ai][1][m][1] * sc;
                u32x4 w;
                w.x = cvt_pk_bf16(g0[0] * sigm(g0[0]) * u0[0], g0[1] * sigm(g0[1]) * u0[1]); w.y = cvt_pk_bf16(g0[2] * sigm(g0[2]) * u0[2], g0[3] * sigm(g0[3]) * u0[3]);
                w.z = cvt_pk_bf16(g1[0] * sigm(g1[0]) * u1[0], g1[1] * sigm(g1[1]) * u1[1]); w.w = cvt_pk_bf16(g1[2] * sigm(g1[2]) * u1[2], g1[3] * sigm(g1[3]) * u1[3]);
                *(u32x4*)rowp = w; }
    }
};
template <class Epi, class Sched, bool ALIGN_EPI = false, bool SP2 = false>
__device__ __forceinline__ void gemm_phase(PG8_LAS unsigned char* lds, const Gemm g, const Sched& S, const Epi& E, const int tid) {
    const int wid = __builtin_amdgcn_readfirstlane(tid >> 6), lane = tid & 63, wr = wid >> 2, wc = wid & 3, fr = lane & 15, fq = lane >> 4;
    const int K = g.K, nt = K / BK;
    unsigned voffA[2], voffB[2];
#pragma unroll
    for (int i = 0; i < 2; ++i) { int R, C; stage_rc(tid * 16 + i * 8192, R, C); const int Rb = Epi::PERM ? ((R & ~31) + perm32(R & 31)) : R;
        voffA[i] = (unsigned)(R * K + C) * 2u; voffB[i] = (unsigned)(Rb * K + C) * 2u; }
    const size_t kstep = (size_t)(BK * 2);
    const size_t hstep = (size_t)HALF * K * 2;
    const size_t tstep = 2 * hstep;
    const unsigned ldsw = (unsigned)wid * 1024u;
    const int aoff = lds_byte(wr * 64 + fr, fq * 8), boff = lds_byte(wc * 32 + fr, fq * 8);
#define PG8_SA(b, h) (((b) * 2 + (h)) * HTB)
#define PG8_SB(b, h) ((4 + (b) * 2 + (h)) * HTB)
#define PG8_STAGE(bufoff, gbase, voff) do { _Pragma("unroll") for (int _i = 0; _i < 2; ++_i) \
        __builtin_amdgcn_global_load_lds((const unsigned*)((const char*)(gbase) + (voff)[_i]), (PG8_LAS unsigned*)(lds + (bufoff) + ldsw + _i * 8192), 16, 0, 0); } while (0)
#define PG8_LDA(dst, b, h) do { _Pragma("unroll") for (int m = 0; m < 4; ++m) _Pragma("unroll") for (int k = 0; k < 2; ++k) dst[m][k] = *(const PG8_LAS bf16x8*)(lds + PG8_SA(b, h) + aoff + m * 2048 + k * 1024); } while (0)
#define PG8_LDB(dst, b, h) do { _Pragma("unroll") for (int n = 0; n < 2; ++n) _Pragma("unroll") for (int k = 0; k < 2; ++k) dst[n][k] = *(const PG8_LAS bf16x8*)(lds + PG8_SB(b, h) + boff + n * 2048 + k * 1024); } while (0)
#define PG8_MMA(ai, bj, At, Bt) do { __builtin_amdgcn_s_setprio(1); _Pragma("unroll") for (int m = 0; m < 4; ++m) _Pragma("unroll") for (int n = 0; n < 2; ++n) _Pragma("unroll") for (int k = 0; k < 2; ++k) \
        acc[ai][bj][m][n] = __builtin_amdgcn_mfma_f32_16x16x32_bf16(Bt[n][k], At[m][k], acc[ai][bj][m][n], 0, 0, 0); __builtin_amdgcn_s_setprio(0); } while (0)
#define PG8_WAIT_V(n) asm volatile("s_waitcnt vmcnt(" #n ")" ::: "memory")
#define PG8_WAIT_L(n) asm volatile("s_waitcnt lgkmcnt(" #n ")" ::: "memory")
#define PG8_BAR __builtin_amdgcn_s_barrier()
#define PG8_SCHED __builtin_amdgcn_sched_barrier(0)
    Unit cur, nxt; int ui = 0;
    if (!S.next(0, cur)) return;
    f32x4 acc[2][2][4][2];
#pragma unroll
    for (int a = 0; a < 2; ++a)
#pragma unroll
        for (int b = 0; b < 2; ++b)
#pragma unroll
            for (int m = 0; m < 4; ++m)
#pragma unroll
                for (int n = 0; n < 2; ++n) acc[a][b][m][n] = (f32x4){0.f, 0.f, 0.f, 0.f};
    bf16x8 At[4][2], B0[2][2], B1[2][2];
    const char* cA = (const char*)g.A + (size_t)cur.pm * tstep; const char* cB = (const char*)g.Bt + (size_t)cur.pn * tstep;
    S.a_ready(cur);
    if constexpr (SP2) {
        PG8_STAGE(PG8_SB(0, 0), cB, voffB); PG8_STAGE(PG8_SB(0, 1), cB + hstep, voffB); PG8_STAGE(PG8_SA(0, 0), cA, voffA); PG8_STAGE(PG8_SA(0, 1), cA + hstep, voffA);
        if (wr == 1) PG8_BAR;
        PG8_WAIT_V(2); PG8_BAR;
        PG8_STAGE(PG8_SB(1, 0), cB + kstep, voffB); PG8_STAGE(PG8_SA(1, 0), cA + kstep, voffA); PG8_STAGE(PG8_SB(1, 1), cB + hstep + kstep, voffB);
        PG8_WAIT_V(6); PG8_BAR;
    } else {
        PG8_STAGE(PG8_SB(0, 0), cB, voffB); PG8_STAGE(PG8_SA(0, 0), cA, voffA); PG8_STAGE(PG8_SB(0, 1), cB + hstep, voffB); PG8_STAGE(PG8_SA(0, 1), cA + hstep, voffA);
        if (wr == 1) PG8_BAR;
        PG8_WAIT_V(4); PG8_BAR;
        PG8_STAGE(PG8_SB(1, 0), cB + kstep, voffB); PG8_STAGE(PG8_SA(1, 0), cA + kstep, voffA); PG8_STAGE(PG8_SB(1, 1), cB + hstep + kstep, voffB);
        PG8_WAIT_V(6); PG8_BAR;
    }
    for (;;) {
        const bool has_next = S.next(ui + 1, nxt);
        const char* nA = has_next ? (const char*)g.A + (size_t)nxt.pm * tstep : cA; const char* nB = has_next ? (const char*)g.Bt + (size_t)nxt.pn * tstep : cB;
        for (int t = 0; t < nt; t += 2) {
            const bool last = (t == nt - 2);
            const char* a1 = cA + (size_t)(t + 1) * kstep;
            const char* a2 = last ? nA : cA + (size_t)(t + 2) * kstep; const char* b2 = last ? nB : cB + (size_t)(t + 2) * kstep;
            const char* a3 = a2 + kstep; const char* b3 = b2 + kstep;
            if (last && has_next) S.a_ready(nxt);
            if constexpr (SP2) {
            PG8_LDB(B0, 0, 0); PG8_LDB(B1, 0, 1); PG8_SCHED; PG8_LDA(At, 0, 0); PG8_STAGE(PG8_SA(1, 1), a1 + hstep, voffA);
            PG8_WAIT_V(8); PG8_WAIT_L(0); PG8_BAR; PG8_MMA(0, 0, At, B0); PG8_MMA(0, 1, At, B1); PG8_BAR; PG8_SCHED;
            PG8_LDA(At, 0, 1); PG8_STAGE(PG8_SB(0, 0), b2, voffB); PG8_STAGE(PG8_SB(0, 1), b2 + hstep, voffB); PG8_STAGE(PG8_SA(0, 0), a2, voffA);
            PG8_WAIT_V(8); PG8_WAIT_L(0); PG8_BAR; PG8_MMA(1, 0, At, B0); PG8_MMA(1, 1, At, B1); PG8_BAR; PG8_SCHED;
            PG8_LDB(B0, 1, 0); PG8_LDB(B1, 1, 1); PG8_SCHED; PG8_LDA(At, 1, 0); PG8_STAGE(PG8_SA(0, 1), a2 + hstep, voffA);
            PG8_WAIT_V(8); PG8_WAIT_L(0); PG8_BAR; PG8_MMA(0, 0, At, B0); PG8_MMA(0, 1, At, B1); PG8_BAR; PG8_SCHED;
            PG8_LDA(At, 1, 1); PG8_STAGE(PG8_SB(1, 0), b3, voffB); PG8_STAGE(PG8_SB(1, 1), b3 + hstep, voffB); PG8_STAGE(PG8_SA(1, 0), a3, voffA);
            PG8_WAIT_V(8); PG8_WAIT_L(0); PG8_BAR; PG8_MMA(1, 0, At, B0); PG8_MMA(1, 1, At, B1); PG8_BAR; PG8_SCHED;
            } else {
            PG8_LDB(B0, 0, 0); PG8_SCHED; PG8_LDA(At, 0, 0); PG8_STAGE(PG8_SA(1, 1), a1 + hstep, voffA);
            PG8_WAIT_L(8); PG8_BAR; PG8_WAIT_L(0); PG8_MMA(0, 0, At, B0); PG8_BAR; PG8_SCHED;
            PG8_LDB(B1, 0, 1); PG8_STAGE(PG8_SB(0, 0), b2, voffB);
            PG8_BAR; PG8_WAIT_L(0); PG8_MMA(0, 1, At, B1); PG8_BAR;
            PG8_LDA(At, 0, 1); PG8_STAGE(PG8_SA(0, 0), a2, voffA);
            PG8_BAR; PG8_WAIT_L(0); PG8_MMA(1, 0, At, B0); PG8_BAR; PG8_SCHED;
            PG8_STAGE(PG8_SB(0, 1), b2 + hstep, voffB);
            PG8_WAIT_V(6); PG8_BAR; PG8_MMA(1, 1, At, B1); PG8_BAR;
            PG8_LDB(B0, 1, 0); PG8_SCHED; PG8_LDA(At, 1, 0); PG8_STAGE(PG8_SA(0, 1), a2 + hstep, voffA);
            PG8_WAIT_L(8); PG8_BAR; PG8_WAIT_L(0); PG8_MMA(0, 0, At, B0); PG8_BAR; PG8_SCHED;
            PG8_LDB(B1, 1, 1); PG8_STAGE(PG8_SB(1, 0), b3, voffB);
            PG8_BAR; PG8_WAIT_L(0); PG8_MMA(0, 1, At, B1); PG8_BAR;
            PG8_LDA(At, 1, 1); PG8_STAGE(PG8_SA(1, 0), a3, voffA);
            PG8_BAR; PG8_WAIT_L(0); PG8_MMA(1, 0, At, B0); PG8_BAR; PG8_SCHED;
            PG8_STAGE(PG8_SB(1, 1), b3 + hstep, voffB);
            PG8_WAIT_V(6); PG8_BAR; PG8_MMA(1, 1, At, B1); PG8_BAR;
            }
        }
        if constexpr (ALIGN_EPI) { if (wr == 0) PG8_BAR; }
        if constexpr (!Epi::AFTER_DRAIN) { E(acc, cur, wr, wc, fr, fq); S.done(cur); }
        if (!has_next) break;
#pragma unroll
        for (int a = 0; a < 2; ++a)
#pragma unroll
            for (int b = 0; b < 2; ++b)
#pragma unroll
                for (int m = 0; m < 4; ++m)
#pragma unroll
                    for (int n = 0; n < 2; ++n) acc[a][b][m][n] = (f32x4){0.f, 0.f, 0.f, 0.f};
        cur = nxt; cA = nA; cB = nB; ++ui;
        if constexpr (ALIGN_EPI) { if (wr == 1) PG8_BAR; }
    }
    PG8_WAIT_V(0);
    if constexpr (!ALIGN_EPI) { if (wr == 0) PG8_BAR; }
    PG8_BAR;
    if constexpr (Epi::AFTER_DRAIN) { E.fused(acc, cur, wr, wc, fr, fq, lds, wid, lane); S.done(cur); }
#undef PG8_SA
#undef PG8_SB
#undef PG8_STAGE
#undef PG8_LDA
#undef PG8_LDB
#undef PG8_MMA
#undef PG8_WAIT_V
#undef PG8_WAIT_L
#undef PG8_BAR
#undef PG8_SCHED
}
}
#ifndef PG8_SP2
#define PG8_SP2 true
#endif
#ifndef PG8_ALIGN
#define PG8_ALIGN true
#endif

constexpr int NWAVES = 8;
constexpr int BATCH = 2, SEQ = 8192, M = BATCH * SEQ, D = 4096, INCOLS = 8200, NPROJ = 8192, DFF = 11008, NGU = 2 * DFF;
constexpr int HD = 128, NH = 8, SSMW = 2048, NG = 128, NS = 64, LAYERS = 2;
constexpr int COL_QA = 0, COL_KA = 1024, COL_VA = 2048, COL_QB = 3072, COL_KB = 4096, COL_VB = 5120, COL_U = 6144;
constexpr float RMS_EPS = 1e-6f;
constexpr float LOG2E = 1.4426950408889634f;
constexpr float QK_SCALE = 0.08838834764831845f;

constexpr size_t MiB = 1u << 20;
constexpr size_t WS_CTL = 0, CTL_ZERO_BYTES = 1 * MiB;
constexpr size_t WS_LS = 3 * MiB;
constexpr size_t WS_CUM = 4 * MiB;
constexpr size_t WS_RS = 6 * MiB;
constexpr size_t WS_KNT = 5 * MiB;
constexpr size_t WS_W = 16 * MiB;
constexpr size_t W_IN = 0, W_GLU = 64 * MiB, W_OUT = 72 * MiB, W_GU = 104 * MiB, W_D = 276 * MiB, W_LAYER = 362 * MiB;
constexpr size_t WS_X16 = WS_W + 2 * W_LAYER;
constexpr size_t WS_PROJ = WS_X16 + 128 * MiB;
constexpr size_t WS_YG = WS_PROJ + 256 * MiB;
constexpr size_t WS_O = WS_YG + 64 * MiB;
constexpr size_t WS_Y16 = WS_O + 128 * MiB;
constexpr size_t WS_ACT = WS_PROJ;
constexpr size_t WS_END = WS_Y16 + 256 * MiB;
static_assert(WS_ACT + (size_t)M * DFF * 2 <= WS_Y16, "ACT overlay");
constexpr int CW_TMO = 0, CW_BAR = 4096;

constexpr int RING_OFF = 0, RING_BYTES = 131072;
constexpr int LDSCTL_OFF = RING_BYTES, MISC_OFF = LDSCTL_OFF + 320;
constexpr int LDS_BYTES = 147456;

#define GAS __attribute__((address_space(1)))
#define LAS __attribute__((address_space(3)))
typedef unsigned short bf16;
typedef unsigned v4u __attribute__((ext_vector_type(4)));
typedef unsigned v2u __attribute__((ext_vector_type(2)));
typedef float f32x4 __attribute__((ext_vector_type(4)));
typedef float f32x8 __attribute__((ext_vector_type(8)));
typedef float f32x16 __attribute__((ext_vector_type(16)));
typedef short bf16x8 __attribute__((ext_vector_type(8)));
typedef __bf16 bfv8 __attribute__((ext_vector_type(8)));
typedef __bf16 bfv4 __attribute__((ext_vector_type(4)));
typedef __bf16 bfv2 __attribute__((ext_vector_type(2)));
typedef GAS unsigned gu32;
#define RLX_AGENT __ATOMIC_RELAXED, __HIP_MEMORY_SCOPE_AGENT
#define MFMA32(a, b, c) __builtin_amdgcn_mfma_f32_32x32x16_bf16((a), (b), (c), 0, 0, 0)

__device__ __forceinline__ bf16x8 cvt8(f32x8 v) { return __builtin_bit_cast(bf16x8, __builtin_convertvector(v, bfv8)); }
__device__ __forceinline__ v2u cvt4(f32x4 v) { return __builtin_bit_cast(v2u, __builtin_convertvector(v, bfv4)); }
__device__ __forceinline__ unsigned cvt2(float a, float b) { typedef float f2 __attribute__((ext_vector_type(2))); f2 v = {a, b}; return __builtin_bit_cast(unsigned, __builtin_convertvector(v, bfv2)); }
__device__ __forceinline__ float bf_lo(unsigned w) { return __builtin_bit_cast(float, w << 16); }
__device__ __forceinline__ float bf_hi(unsigned w) { return __builtin_bit_cast(float, w & 0xffff0000u); }
__device__ __forceinline__ float wave_sum(float v) {
#pragma unroll
    for (int o = 1; o < 64; o <<= 1) v += __shfl_xor(v, o);
    return v;
}
__device__ __forceinline__ int crow(int r, int hi) { return (r & 3) + 8 * (r >> 2) + 4 * hi; }

#define XB_TMO      128
#define XB_XCNT(j)  (256  + 64 * (j))
#define XB_XSUB(j)  (1280 + 64 * (j))
#define XB_XGEN(j)  (2304 + 64 * (j))
#define XB_TOP      3328
#define XB_TOPGEN   3392
#define XCD_BAR_WORDS 3456
#define XB_SPIN_CAP (1u << 18)

__device__ __forceinline__ unsigned xb_ld(unsigned* p)              { return __hip_atomic_load(p, __ATOMIC_RELAXED, __HIP_MEMORY_SCOPE_AGENT); }
__device__ __forceinline__ unsigned xb_add(unsigned* p, unsigned v) { return __hip_atomic_fetch_add(p, v, __ATOMIC_RELAXED, __HIP_MEMORY_SCOPE_AGENT); }
__device__ __forceinline__ unsigned xb_xcc_id() { return (unsigned)__builtin_amdgcn_s_getreg((3 << 11) | 20) & 0xFu; }
#define XB_SPIN(cond, bar) do { unsigned _sp = 0; while (cond) { __builtin_amdgcn_s_sleep(1); \
    if ((++_sp & 255u) == 0u) { if (xb_ld(&(bar)[XB_TMO])) break; if (_sp > XB_SPIN_CAP) { atomicAdd(&(bar)[XB_TMO], 1u); break; } } } } while (0)

struct XcdBarrier {
    unsigned* bar; unsigned x;
    volatile LAS unsigned* st;
};

__device__ __forceinline__ XcdBarrier xcd_barrier_post(unsigned* bar, volatile LAS unsigned* st) {
    XcdBarrier b; b.bar = bar; b.x = xb_xcc_id(); b.st = st;
    if (threadIdx.x == 0) (void)xb_add(&bar[XB_XCNT(b.x)], 1u);
    return b;
}
__device__ __forceinline__ void xcd_barrier_complete(unsigned* bar, unsigned x, unsigned& nloc, unsigned& nx) {
    const unsigned G = gridDim.x * gridDim.y * gridDim.z;
    unsigned sum, cnt, mine, sp = 0u;
    for (;;) {
        sum = 0u; cnt = 0u; mine = 0u;
#pragma unroll
        for (unsigned j = 0; j < 16; ++j) { const unsigned c = xb_ld(&bar[XB_XCNT(j)]); sum += c; cnt += (c > 0u) ? 1u : 0u; mine = (j == x) ? c : mine; }
        if (sum == G) break;
        __builtin_amdgcn_s_sleep(1);
        if ((++sp & 255u) == 0u) { if (xb_ld(&bar[XB_TMO])) break; if (sp > XB_SPIN_CAP) { atomicAdd(&bar[XB_TMO], 1u); break; } }
    }
    nloc = mine > 0u ? mine : 1u; nx = cnt > 0u ? cnt : 1u;
}

__device__ __forceinline__ void xcd_barrier(const XcdBarrier& b, const int tid_) {
    asm volatile("s_waitcnt vmcnt(0)" ::: "memory");
    __syncthreads();
    if (tid_ == 0) {
        unsigned* bar = b.bar;
        __builtin_amdgcn_s_waitcnt(0);
        unsigned nloc = b.st[0], nx = b.st[1];
        if (nloc == 0u) { xcd_barrier_complete(bar, b.x, nloc, nx); b.st[0] = nloc; b.st[1] = nx; }
        const unsigned old = xb_add(&bar[XB_XSUB(b.x)], 1u);
        const unsigned gen = old / nloc;
        if (old + 1u == (gen + 1u) * nloc) {
            __builtin_amdgcn_fence(__ATOMIC_RELEASE, "agent");
            asm volatile("s_waitcnt vmcnt(0)" ::: "memory");
            const unsigned og = xb_add(&bar[XB_TOP], 1u);
            const unsigned tg = og / nx;
            if (og + 1u == (tg + 1u) * nx) xb_add(&bar[XB_TOPGEN], 1u);
            else XB_SPIN(xb_ld(&bar[XB_TOPGEN]) == tg, bar);
            __builtin_amdgcn_fence(__ATOMIC_ACQUIRE, "agent");
            xb_add(&bar[XB_XGEN(b.x)], 1u);
            asm volatile("s_waitcnt vmcnt(0)" ::: "memory");
        } else {
            XB_SPIN(xb_ld(&bar[XB_XGEN(b.x)]) == gen, bar);
            __builtin_amdgcn_fence(__ATOMIC_ACQUIRE, "agent");
            asm volatile("s_waitcnt vmcnt(0)" ::: "memory");
        }
    }
    __syncthreads();
}


__device__ __forceinline__ void p0_item(const float* W, int ld, int col0, int k0, const float* gain, bf16* dst, int dstK, LAS float* scr, int lane) {
    const int kr = lane >> 3, nq = lane & 7;
    f32x4 w[8]; float gn[8];
#pragma unroll
    for (int i = 0; i < 8; ++i) { w[i] = *(const f32x4*)(W + (size_t)(k0 + 8 * i + kr) * ld + col0 + 4 * nq); gn[i] = gain ? gain[k0 + 8 * i + kr] : 1.0f; }
#pragma unroll
    for (int i = 0; i < 8; ++i) { LAS float* d = scr + (8 * i + kr) * 33 + 4 * nq; const f32x4 v = w[i] * gn[i]; d[0] = v.x; d[1] = v.y; d[2] = v.z; d[3] = v.w; }
    asm volatile("s_waitcnt lgkmcnt(0)" ::: "memory");
    const int c = lane & 7;
#pragma unroll
    for (int j = 0; j < 4; ++j) { const int n = (lane >> 3) + 8 * j; const LAS float* s = scr + (8 * c) * 33 + n;
        f32x8 v = {s[0 * 33], s[1 * 33], s[2 * 33], s[3 * 33], s[4 * 33], s[5 * 33], s[6 * 33], s[7 * 33]};
        *(bf16x8*)(dst + (size_t)n * dstK + 8 * c) = cvt8(v); }
    asm volatile("s_waitcnt lgkmcnt(0)" ::: "memory");
}
constexpr int I_IN = (D / 64) * (NPROJ / 32), I_GLU = (SSMW / 64) * (SSMW / 32), I_OUT = (D / 64) * (D / 32), I_GU = (D / 64) * (NGU / 32), I_D = (DFF / 64) * (D / 32);
constexpr int I_LAYER = I_IN + I_GLU + I_OUT + I_GU + I_D;

struct Args { const float* in[23]; float* out; unsigned char* ws; };
typedef const __attribute__((address_space(4))) Args CArgs;

__device__ __forceinline__ void p0_weights(CArgs& a, LAS unsigned char* lds, int gw, int NGW, int wave, int lane) {
    LAS float* scr = (LAS float*)(lds + RING_OFF + wave * 16384);
    for (int it = gw; it < LAYERS * I_LAYER; it += NGW) {
        const int l = it / I_LAYER; int r = it - l * I_LAYER;
        unsigned char* wl = a.ws + WS_W + (size_t)l * W_LAYER;
        if (r < I_IN) { const int kb = r / (NPROJ / 32), nb = r % (NPROJ / 32); const int n0 = 32 * nb;
            p0_item(a.in[1] + (size_t)l * D * INCOLS, INCOLS, n0 + (n0 >= COL_U ? 8 : 0), 64 * kb, a.in[3] + l * D, (bf16*)(wl + W_IN) + (size_t)n0 * D + 64 * kb, D, scr, lane); continue; }
        r -= I_IN;
        if (r < I_GLU) { const int kb = r / (SSMW / 32), nb = r % (SSMW / 32);
            p0_item(a.in[16] + (size_t)l * SSMW * SSMW, SSMW, 32 * nb, 64 * kb, nullptr, (bf16*)(wl + W_GLU) + (size_t)(32 * nb) * SSMW + 64 * kb, SSMW, scr, lane); continue; }
        r -= I_GLU;
        if (r < I_OUT) { const int kb = r / (D / 32), nb = r % (D / 32);
            p0_item(a.in[2] + (size_t)l * D * D, D, 32 * nb, 64 * kb, a.in[5] + l * D, (bf16*)(wl + W_OUT) + (size_t)(32 * nb) * D + 64 * kb, D, scr, lane); continue; }
        r -= I_OUT;
        if (r < I_GU) { const int kb = r / (NGU / 32), nb = r % (NGU / 32); const int n0 = 32 * nb, tile = n0 >> 8, within = n0 & 255;
            const float* src = (within < 128 ? a.in[20] : a.in[21]) + (size_t)l * D * DFF;
            p0_item(src, DFF, 128 * tile + (within & 127), 64 * kb, a.in[18] + l * D, (bf16*)(wl + W_GU) + (size_t)n0 * D + 64 * kb, D, scr, lane); continue; }
        r -= I_GU;
        { const int kb = r / (D / 32), nb = r % (D / 32);
            p0_item(a.in[22] + (size_t)l * DFF * D, D, 32 * nb, 64 * kb, nullptr, (bf16*)(wl + W_D) + (size_t)(32 * nb) * DFF + 64 * kb, DFF, scr, lane); }
    }
}

__device__ __forceinline__ void load_row(const float* p, int lane, f32x4 (&v)[16]) {
    const f32x4* q = (const f32x4*)p + lane;
#pragma unroll
    for (int j = 0; j < 16; ++j) v[j] = q[64 * j];
}
__device__ __forceinline__ float row_sumsq(const f32x4 (&v)[16]) {
    float s = 0.f;
#pragma unroll
    for (int j = 0; j < 16; ++j) s += (v[j].x * v[j].x + v[j].y * v[j].y) + (v[j].z * v[j].z + v[j].w * v[j].w);
    return wave_sum(s);
}
__device__ __forceinline__ void store_h(bf16* hrow, int lane, const f32x4 (&v)[16], float rstd) {
    v2u* o = (v2u*)hrow + lane;
#pragma unroll
    for (int j = 0; j < 16; ++j) o[64 * j] = cvt4(v[j] * rstd);
}
__device__ __forceinline__ void build_wfb(LAS float* wfb, const float* w_in_l, const float* g, int tid) {
#pragma unroll 1
    for (int base = tid; base < 8 * D; base += 16 * NWAVES * 64) {
        float w[16], gg[16];
#pragma unroll
        for (int i = 0; i < 16; ++i) { const int idx = base + i * NWAVES * 64, k = idx >> 3, hh = idx & 7; w[i] = w_in_l[(size_t)k * INCOLS + COL_U + hh]; gg[i] = g[k]; }
#pragma unroll
        for (int i = 0; i < 16; ++i) { const int idx = base + i * NWAVES * 64, k = idx >> 3, hh = idx & 7; wfb[hh * D + k] = gg[i] * w[i]; }
    }
}
__device__ __forceinline__ void fb_accum(const f32x4 vj, int j, const LAS float* wfb, int lane, float (&acc)[8]) {
#pragma unroll
    for (int hh = 0; hh < 8; ++hh) { const LAS float* base = wfb + 4 * lane + (hh < 4 ? 0 : 4 * D);
        const f32x4 w = *(const LAS f32x4*)(base + (hh & 3) * D + 256 * j); acc[hh] += (vj.x * w.x + vj.y * w.y) + (vj.z * w.z + vj.w * w.w); }
}
__device__ __forceinline__ void fb_finish(const float (&acc)[8], float rstd, const float* bfg, float* LS, int m, int lane) {
    float mine = 0.f;
#pragma unroll
    for (int hh = 0; hh < 8; ++hh) { const float s = wave_sum(acc[hh]); mine = (lane == hh) ? s : mine; }
    if (lane < 8) { const float z = mine * rstd + bfg[lane];
        const float ls = fminf(z, 0.f) - 0.6931471805599453f * __builtin_amdgcn_logf(1.0f + __builtin_amdgcn_exp2f(-fabsf(z) * LOG2E));
        const int b = m / SEQ, s = m - b * SEQ; LS[(size_t)(b * NH + lane) * SEQ + s] = ls; }
}
__device__ __forceinline__ void fb_emit(const f32x4 (&v)[16], float rstd, const LAS float* wfb, const float* bfg, float* LS, int m, int lane) {
    float acc[8];
#pragma unroll
    for (int hh = 0; hh < 8; ++hh) acc[hh] = 0.f;
#pragma unroll
    for (int j = 0; j < 16; ++j) { fb_accum(v[j], j, wfb, lane, acc);
        asm volatile("" ::: "memory"); }
    fb_finish(acc, rstd, bfg, LS, m, lane);
}
__device__ __forceinline__ void phase_norm0(CArgs& a, LAS unsigned char* lds, int gw, int NGW, int tid, int lane) {
    LAS float* wfb = (LAS float*)(lds + RING_OFF);
    build_wfb(wfb, a.in[1], a.in[3], tid);
    __syncthreads();
    bf16* X = (bf16*)(a.ws + WS_X16); float* LS = (float*)(a.ws + WS_LS); float* RS = (float*)(a.ws + WS_RS);
    f32x4 v[16], vn[16];
    int m = gw;
    if (m < M) load_row(a.in[0] + (size_t)m * D, lane, v);
    while (m < M) {
        const int mn = m + NGW;
        if (mn < M) load_row(a.in[0] + (size_t)mn * D, lane, vn);
        const float rstd = 1.0f / sqrtf(row_sumsq(v) * (1.0f / D) + RMS_EPS);
        store_h(X + (size_t)m * D, lane, v, 1.0f);
        if (lane == 0) RS[m] = rstd;
        fb_emit(v, rstd, wfb, a.in[7], LS, m, lane);
#pragma unroll
        for (int j = 0; j < 16; ++j) v[j] = vn[j];
        m = mn;
    }
    __syncthreads();
}
__device__ __forceinline__ void load_row_bf16(const bf16* p, int lane, f32x4 (&y)[16]) {
    const v2u* yq = (const v2u*)p + lane; v2u yw[16];
#pragma unroll
    for (int j = 0; j < 16; ++j) yw[j] = yq[64 * j];
#pragma unroll
    for (int j = 0; j < 16; ++j) { const unsigned w0 = yw[j].x, w1 = yw[j].y; y[j] = (f32x4){bf_lo(w0), bf_hi(w0), bf_lo(w1), bf_hi(w1)}; }
}
template <bool XF32> struct XRow;
template <> struct XRow<true> { typedef f32x4 T;
    static __device__ __forceinline__ void load(const float* xin, const bf16*, int m, int lane, f32x4 (&w)[16]) { const f32x4* q = (const f32x4*)(xin + (size_t)m * D) + lane;
#pragma unroll
        for (int j = 0; j < 16; ++j) w[j] = q[64 * j]; }
    static __device__ __forceinline__ f32x4 get(const f32x4& w) { return w; } };
template <> struct XRow<false> { typedef v2u T;
    static __device__ __forceinline__ void load(const float*, const bf16* X, int m, int lane, v2u (&w)[16]) { const v2u* q = (const v2u*)(X + (size_t)m * D) + lane;
#pragma unroll
        for (int j = 0; j < 16; ++j) w[j] = q[64 * j]; }
    static __device__ __forceinline__ f32x4 get(const v2u& w) { const unsigned w0 = w.x, w1 = w.y; return (f32x4){bf_lo(w0), bf_hi(w0), bf_lo(w1), bf_hi(w1)}; } };
template <bool XF32, bool LAST, bool DO_FB>
__device__ __forceinline__ void phase_post(CArgs& a, LAS unsigned char* lds, const float* gpost, int lnext, int gw, int NGW, int tid, int lane) {
    LAS float* wfb = (LAS float*)(lds + RING_OFF);
    if (DO_FB) { build_wfb(wfb, a.in[1] + (size_t)lnext * D * INCOLS, a.in[3] + lnext * D, tid); __syncthreads(); }
    const bf16* Y = (const bf16*)(a.ws + WS_Y16); bf16* X = (bf16*)(a.ws + WS_X16); float* LS = (float*)(a.ws + WS_LS); float* RS = (float*)(a.ws + WS_RS);
    const f32x4* gq = (const f32x4*)gpost + lane;
    typedef typename XRow<XF32>::T XT;
    v2u yw[16], ywn[16]; XT xw[16], xwn[16];
    int m = gw;
    if (m < M) { const v2u* yq = (const v2u*)(Y + (size_t)m * D) + lane;
#pragma unroll
        for (int j = 0; j < 16; ++j) yw[j] = yq[64 * j];
        XRow<XF32>::load(a.in[0], X, m, lane, xw); }
#pragma clang loop unroll(disable)
    while (m < M) {
        const int mn = m + NGW;
        if (!XF32 && mn < M) { const v2u* yq = (const v2u*)(Y + (size_t)mn * D) + lane;
#pragma unroll
            for (int j = 0; j < 16; ++j) ywn[j] = yq[64 * j];
            XRow<XF32>::load(a.in[0], X, mn, lane, xwn); }
        float ssy = 0.f;
#pragma unroll
        for (int j = 0; j < 16; ++j) { const unsigned w0 = yw[j].x, w1 = yw[j].y; const float a0 = bf_lo(w0), a1 = bf_hi(w0), a2 = bf_lo(w1), a3 = bf_hi(w1); ssy += (a0 * a0 + a1 * a1) + (a2 * a2 + a3 * a3); }
        const float ry = 1.0f / sqrtf(wave_sum(ssy) * (1.0f / D) + RMS_EPS);
        float ssv = 0.f; float acc[8];
#pragma unroll
        for (int hh = 0; hh < 8; ++hh) acc[hh] = 0.f;
        f32x4* o = (f32x4*)(a.out + (size_t)m * D) + lane; v2u* xo = (v2u*)(X + (size_t)m * D) + lane;
#pragma unroll
        for (int j = 0; j < 16; ++j) { const unsigned w0 = yw[j].x, w1 = yw[j].y; const f32x4 yv = {bf_lo(w0), bf_hi(w0), bf_lo(w1), bf_hi(w1)};
            const f32x4 vj = XRow<XF32>::get(xw[j]) + (yv * ry) * gq[64 * j];
            if (LAST) o[64 * j] = vj;
            else { xo[64 * j] = cvt4(vj); ssv += (vj.x * vj.x + vj.y * vj.y) + (vj.z * vj.z + vj.w * vj.w); if (DO_FB) fb_accum(vj, j, wfb, lane, acc); }
            if (DO_FB) asm volatile("" : "+v"(acc[0]), "+v"(acc[1]), "+v"(acc[2]), "+v"(acc[3]), "+v"(acc[4]), "+v"(acc[5]), "+v"(acc[6]), "+v"(acc[7]) :: "memory");
            else if ((j & 3) == 3) asm volatile("" ::: "memory"); }
        if (!LAST) { const float rstd = 1.0f / sqrtf(wave_sum(ssv) * (1.0f / D) + RMS_EPS);
            if (lane == 0) RS[m] = rstd;
            if (DO_FB) fb_finish(acc, rstd, a.in[7] + lnext * NH, LS, m, lane); }
        if (XF32) { if (mn < M) { const v2u* yq = (const v2u*)(Y + (size_t)mn * D) + lane;
#pragma unroll
                for (int j = 0; j < 16; ++j) yw[j] = yq[64 * j];
                XRow<XF32>::load(a.in[0], X, mn, lane, xw); } }
        else {
#pragma unroll
            for (int j = 0; j < 16; ++j) { yw[j] = ywn[j]; xw[j] = xwn[j]; } }
        m = mn;
    }
    if (DO_FB) __syncthreads();
}
__device__ __forceinline__ void phase_mixnorm(CArgs& a, int gw, int NGW, int lane) {
    bf16* O = (bf16*)(a.ws + WS_O);
    for (int m = gw; m < M; m += NGW) {
        v4u* p = (v4u*)(O + (size_t)m * D) + lane; v4u w[8]; float ss[8];
#pragma unroll
        for (int j = 0; j < 8; ++j) w[j] = p[64 * j];
#pragma unroll
        for (int j = 0; j < 8; ++j) { float s = 0.f;
#pragma unroll
            for (int e = 0; e < 4; ++e) { const float lo = bf_lo(w[j][e]), hi = bf_hi(w[j][e]); s += lo * lo + hi * hi; }
            ss[j] = s; }
        const float sa = wave_sum(ss[0] + ss[1]), sb = wave_sum(ss[2] + ss[3]), sc = wave_sum((ss[4] + ss[5]) + (ss[6] + ss[7]));
        const float ra = 1.0f / sqrtf(sa * (1.0f / 1024.f) + RMS_EPS), rb = 1.0f / sqrtf(sb * (1.0f / 1024.f) + RMS_EPS), rc = 1.0f / sqrtf(sc * (1.0f / 2048.f) + RMS_EPS);
#pragma unroll
        for (int j = 0; j < 8; ++j) { const float r = j < 2 ? ra : (j < 4 ? rb : rc); v4u o;
#pragma unroll
            for (int e = 0; e < 4; ++e) o[e] = cvt2(bf_lo(w[j][e]) * r, bf_hi(w[j][e]) * r);
            p[64 * j] = o; }
    }
}
__device__ __forceinline__ void phase_cum_knorm(CArgs& a, int gw, int NGW, int lane) {
    if (gw < BATCH * NH) {
        const float* ls = (const float*)(a.ws + WS_LS) + (size_t)gw * SEQ; float* cum = (float*)(a.ws + WS_CUM) + (size_t)gw * SEQ; float carry = 0.f;
        f32x4 qa[SEQ / 1024][4];
#pragma unroll
        for (int c = 0; c < SEQ / 1024; ++c)
#pragma unroll
            for (int i = 0; i < 4; ++i) qa[c][i] = *(const f32x4*)(ls + c * 1024 + lane * 16 + 4 * i);
#pragma unroll
        for (int c = 0; c < SEQ / 1024; ++c) {
            f32x4 q[4];
#pragma unroll
            for (int i = 0; i < 4; ++i) q[i] = qa[c][i];
            float run = 0.f;
#pragma unroll
            for (int i = 0; i < 4; ++i) { q[i].x += run; q[i].y += q[i].x; q[i].z += q[i].y; q[i].w += q[i].z; run = q[i].w; }
            float inc = run;
#pragma unroll
            for (int o = 1; o < 64; o <<= 1) { const float t = __builtin_bit_cast(float, __builtin_amdgcn_ds_bpermute(((lane - o) & 63) << 2, __builtin_bit_cast(int, inc))); if (lane >= o) inc += t; }
            const float excl = (inc - run) + carry;
#pragma unroll
            for (int i = 0; i < 4; ++i) *(f32x4*)(cum + c * 1024 + lane * 16 + 4 * i) = q[i] + excl;
            carry += __builtin_bit_cast(float, __builtin_amdgcn_readlane(__builtin_bit_cast(int, inc), 63));
        }
    }
    const bf16* P = (const bf16*)(a.ws + WS_PROJ); float* knt = (float*)(a.ws + WS_KNT);
    for (int t = gw; t < BATCH * NH * (SEQ / 64); t += NGW) {
        const int bh = t / (SEQ / 64), kt = t % (SEQ / 64), b = bh / NH, h = bh % NH; float mx = 0.f;
        const bf16* base = P + (size_t)(b * SEQ + kt * 64) * NPROJ + COL_KB + h * HD + 8 * (lane & 15);
#pragma unroll 4
        for (int it = 0; it < 16; ++it) { const v4u w = *(const v4u*)(base + (size_t)(it * 4 + (lane >> 4)) * NPROJ); float s = 0.f;
#pragma unroll
            for (int e = 0; e < 4; ++e) { const float lo = bf_lo(w[e]), hi = bf_hi(w[e]); s += lo * lo + hi * hi; }
            s += __shfl_xor(s, 1); s += __shfl_xor(s, 2); s += __shfl_xor(s, 4); s += __shfl_xor(s, 8); mx = fmaxf(mx, s); }
        mx = fmaxf(mx, __shfl_xor(mx, 16)); mx = fmaxf(mx, __shfl_xor(mx, 32));
        if (lane == 0) knt[t] = sqrtf(mx);
    }
}
namespace att {
#ifndef B_SKIP
#define B_SKIP 1
#endif
constexpr float SKIP_T = 30.0f;
constexpr int KROW = 272, VROW = 136, KBUF = 64 * KROW, VBUF = 128 * VROW;
constexpr int OFF_K = 0, OFF_V = 2 * KBUF, OFF_TAB = 2 * KBUF + 2 * VBUF, OFF_CK = OFF_TAB + 2304, OFF_RED = OFF_CK + 512, LDS_END = OFF_RED + 64;
static_assert(LDS_END <= RING_BYTES, "attention LDS");

template <int MODE>
__device__ __forceinline__ void attn_unit(CArgs& a, LAS unsigned char* lds, int l, int b, int h, int qb, int tid, int wave, int lane) {
    const bf16* P = (const bf16*)(a.ws + WS_PROJ);
    const int colq = MODE == 0 ? COL_QA : COL_QB, colk = MODE == 0 ? COL_KA : COL_KB, colv = MODE == 0 ? COL_VA : COL_VB;
    const int q = lane & 31, hi = lane >> 5;
    const int qpos = qb * 256 + wave * 32 + q;
    const size_t rowbase = (size_t)b * SEQ;
    const float* cum = (const float*)(a.ws + WS_CUM) + (size_t)(b * NH + h) * SEQ;
    LAS float* tab = (LAS float*)(lds + OFF_TAB);
    LAS float* ckl = (LAS float*)(lds + OFF_CK);

    int kt_first, ntiles, kt_step;
    if (MODE == 0) { kt_first = 4 * qb - 8 < 0 ? 0 : 4 * qb - 8; ntiles = 4 * qb + 3 - kt_first + 1; kt_step = 1; }
    else { kt_first = 4 * qb + 3; ntiles = 4 * qb + 4; kt_step = -1; }
    const int cq = 4 * qb + (wave >> 1);

    if (MODE == 0) { const float* rb = a.in[6] + (size_t)(l * NH + h) * 513; for (int i = tid; i < 513; i += NWAVES * 64) tab[i] = rb[i] * LOG2E; }

    bf16x8 qf[8];
    { const bf16* qp = P + (rowbase + qpos) * NPROJ + colq + h * HD + 8 * hi;
#pragma unroll
        for (int s = 0; s < 8; ++s) qf[s] = *(const bf16x8*)(qp + 16 * s); }
    float cqv = 0.f; if (MODE == 1) cqv = cum[qpos] * LOG2E;
    if (MODE == 1 && B_SKIP) {
        float ss = 0.f;
#pragma unroll
        for (int s = 0; s < 8; ++s) { const bf16x8 qv = qf[s]; const v4u w = __builtin_bit_cast(v4u, qv);
#pragma unroll
            for (int e = 0; e < 4; ++e) { const unsigned ww = w[e]; const float lo = bf_lo(ww), hi2 = bf_hi(ww); ss += lo * lo + hi2 * hi2; } }
        ss += __shfl_xor(ss, 32);
#pragma unroll
        for (int o = 1; o < 32; o <<= 1) ss = fmaxf(ss, __shfl_xor(ss, o));
        LAS float* red = (LAS float*)(lds + OFF_RED);
        if (lane == 0) red[wave] = ss;
        __syncthreads();
        float qn2 = red[0];
#pragma unroll
        for (int w = 1; w < NWAVES; ++w) qn2 = fmaxf(qn2, red[w]);
        const float* knt = (const float*)(a.ws + WS_KNT) + (size_t)(b * NH + h) * (SEQ / 64);
        float kn = fmaxf(knt[lane], knt[lane + 64]);
#pragma unroll
        for (int o = 1; o < 64; o <<= 1) kn = fmaxf(kn, __shfl_xor(kn, o));
        const float kd = fmaxf(fmaxf(knt[4 * qb], knt[4 * qb + 1]), fmaxf(knt[4 * qb + 2], knt[4 * qb + 3]));
        const float qn = sqrtf(qn2), theta = SKIP_T + qn * (kn + kd) * QK_SCALE;
        const float c0 = cum[qb * 256];
        int jskip = -1; bool found = false;
        for (int base = 4 * qb - 1; base >= 0 && !found; base -= 64) {
            const int Jl = base - lane; const bool skip = Jl < 0 ? true : (c0 - cum[64 * Jl + 63] < -theta);
            const unsigned long long bal = __ballot(skip);
            if (bal) { jskip = base - (__ffsll((long long)bal) - 1); found = true; }
        }
        jskip = __builtin_amdgcn_readfirstlane(jskip);
        ntiles = 4 * qb + 3 - jskip;
    }

    f32x16 O[4];
#pragma unroll
    for (int d = 0; d < 4; ++d)
#pragma unroll
        for (int r = 0; r < 16; ++r) O[d][r] = 0.f;
    float mrun = -1e30f, lsum = 0.f;

    v4u st[4]; float ckreg = 0.f;
    const bool vrole = tid < 256;
    const int kg = tid & 15, dg = (tid >> 4) & 15, t2 = tid & 255;
    const bf16* kbase = P + rowbase * NPROJ + colk + h * HD;
    const bf16* vbase = P + rowbase * NPROJ + colv + h * HD;
#define ATT_LOAD(kt) do { const size_t r0_ = (size_t)(kt) * 64; \
        if (vrole) { _Pragma("unroll") for (int i_ = 0; i_ < 4; ++i_) st[i_] = *(const v4u*)(vbase + (r0_ + 4 * kg + i_) * NPROJ + 8 * dg); } \
        else { _Pragma("unroll") for (int i_ = 0; i_ < 4; ++i_) { const int p_ = t2 + 256 * i_; st[i_] = *(const v4u*)(kbase + (r0_ + (p_ >> 4)) * NPROJ + 8 * (p_ & 15)); } } \
        if (MODE == 1 && tid < 64) ckreg = cum[r0_ + tid] * LOG2E; } while (0)
#define ATT_STORE(buf) do { \
        if (vrole) { LAS unsigned char* vb_ = lds + OFF_V + (buf) * VBUF + kg * 8; \
            _Pragma("unroll") for (int c_ = 0; c_ < 4; ++c_) { const unsigned a0 = st[0][c_], a1 = st[1][c_], a2 = st[2][c_], a3 = st[3][c_]; \
                v2u e_, o_; e_.x = (a0 & 0xffffu) | (a1 << 16); e_.y = (a2 & 0xffffu) | (a3 << 16); o_.x = (a0 >> 16) | (a1 & 0xffff0000u); o_.y = (a2 >> 16) | (a3 & 0xffff0000u); \
                *(LAS v2u*)(vb_ + (8 * dg + 2 * c_) * VROW) = e_; *(LAS v2u*)(vb_ + (8 * dg + 2 * c_ + 1) * VROW) = o_; } } \
        else { _Pragma("unroll") for (int i_ = 0; i_ < 4; ++i_) { const int p_ = t2 + 256 * i_; *(LAS v4u*)(lds + OFF_K + (buf) * KBUF + (p_ >> 4) * KROW + (p_ & 15) * 16) = st[i_]; } } \
        if (MODE == 1 && tid < 64) ckl[(buf) * 64 + tid] = ckreg; } while (0)

    ATT_LOAD(kt_first); ATT_STORE(0);
    __syncthreads();
    for (int it = 0; it < ntiles; ++it) {
        const int kt = kt_first + it * kt_step, buf = it & 1;
        if (it + 1 < ntiles) ATT_LOAD(kt + kt_step);
        const bool active = MODE == 0 ? (kt <= cq && kt >= cq - 8) : (kt <= cq);
        if (active) {
            f32x16 p0, p1;
#pragma unroll
            for (int r = 0; r < 16; ++r) { p0[r] = 0.f; p1[r] = 0.f; }
            const LAS unsigned char* kb = lds + OFF_K + buf * KBUF + q * KROW + 16 * hi;
#pragma unroll
            for (int s = 0; s < 8; ++s) {
                const bf16x8 k0 = *(const LAS bf16x8*)(kb + 32 * s), k1 = *(const LAS bf16x8*)(kb + 32 * KROW + 32 * s);
                p0 = MFMA32(k0, qf[s], p0); p1 = MFMA32(k1, qf[s], p1);
            }
            constexpr float C2 = QK_SCALE * LOG2E;
            const int key0 = kt * 64 + 4 * hi;
            if (MODE == 0) {
                if (cq - kt >= 5) { const float bc = tab[512];
#pragma unroll
                    for (int r = 0; r < 16; ++r) { p0[r] = p0[r] * C2 + bc; p1[r] = p1[r] * C2 + bc; } }
                else { const int d0 = qpos - key0 + 256;
#pragma unroll
                    for (int r = 0; r < 16; ++r) { const int c = (r & 3) + 8 * (r >> 2);
                        int i0 = d0 - c, i1 = d0 - c - 32; i0 = i0 < 0 ? 0 : (i0 > 512 ? 512 : i0); i1 = i1 < 0 ? 0 : (i1 > 512 ? 512 : i1);
                        p0[r] = p0[r] * C2 + tab[i0]; p1[r] = p1[r] * C2 + tab[i1]; } }
            } else {
                const LAS float* ck = ckl + buf * 64 + 4 * hi;
#pragma unroll
                for (int g = 0; g < 4; ++g) { const f32x4 c0 = *(const LAS f32x4*)(ck + 8 * g), c1 = *(const LAS f32x4*)(ck + 32 + 8 * g);
#pragma unroll
                    for (int e = 0; e < 4; ++e) { p0[4 * g + e] = p0[4 * g + e] * C2 + (cqv - c0[e]); p1[4 * g + e] = p1[4 * g + e] * C2 + (cqv - c1[e]); } }
                if (kt == cq) { const float NEG = -__builtin_inff();
#pragma unroll
                    for (int r = 0; r < 16; ++r) { const int key = key0 + (r & 3) + 8 * (r >> 2); if (key > qpos) p0[r] = NEG; if (key + 32 > qpos) p1[r] = NEG; } }
            }
            float mt = p0[0];
#pragma unroll
            for (int r = 1; r < 16; ++r) mt = fmaxf(mt, p0[r]);
#pragma unroll
            for (int r = 0; r < 16; ++r) mt = fmaxf(mt, p1[r]);
            mt = fmaxf(mt, __shfl_xor(mt, 32));
            const float mn = fmaxf(mrun, mt), alpha = __builtin_amdgcn_exp2f(mrun - mn);
            mrun = mn;
            float ps = 0.f;
#pragma unroll
            for (int r = 0; r < 16; ++r) { p0[r] = __builtin_amdgcn_exp2f(p0[r] - mn); p1[r] = __builtin_amdgcn_exp2f(p1[r] - mn); ps += p0[r] + p1[r]; }
            lsum = lsum * alpha + ps;
            if (!__all(alpha == 1.0f)) {
#pragma unroll
                for (int d = 0; d < 4; ++d)
#pragma unroll
                    for (int r = 0; r < 16; ++r) O[d][r] *= alpha;
            }
            bf16x8 pf[4];
            pf[0] = cvt8((f32x8){p0[0], p0[1], p0[2], p0[3], p0[4], p0[5], p0[6], p0[7]});
            pf[1] = cvt8((f32x8){p0[8], p0[9], p0[10], p0[11], p0[12], p0[13], p0[14], p0[15]});
            pf[2] = cvt8((f32x8){p1[0], p1[1], p1[2], p1[3], p1[4], p1[5], p1[6], p1[7]});
            pf[3] = cvt8((f32x8){p1[8], p1[9], p1[10], p1[11], p1[12], p1[13], p1[14], p1[15]});
            const LAS unsigned char* vb = lds + OFF_V + buf * VBUF + q * VROW + 8 * hi;
#pragma unroll
            for (int d = 0; d < 4; ++d)
#pragma unroll
                for (int ks = 0; ks < 4; ++ks) {
                    const v2u lo = *(const LAS v2u*)(vb + d * 32 * VROW + ks * 32), hh = *(const LAS v2u*)(vb + d * 32 * VROW + ks * 32 + 16);
                    const v4u vv = {lo.x, lo.y, hh.x, hh.y};
                    O[d] = MFMA32(__builtin_bit_cast(bf16x8, vv), pf[ks], O[d]);
                }
        }
        if (it + 1 < ntiles) ATT_STORE(buf ^ 1);
        __syncthreads();
    }
#undef ATT_LOAD
#undef ATT_STORE
    const float ltot = lsum + __shfl_xor(lsum, 32), inv = 1.0f / ltot;
    bf16* op = (bf16*)(a.ws + WS_O) + (rowbase + qpos) * D + MODE * 1024 + h * HD + 4 * hi;
#pragma unroll
    for (int d = 0; d < 4; ++d)
#pragma unroll
        for (int g = 0; g < 4; ++g) { const f32x4 v = {O[d][4 * g] * inv, O[d][4 * g + 1] * inv, O[d][4 * g + 2] * inv, O[d][4 * g + 3] * inv};
            *(v2u*)(op + 32 * d + 8 * g) = cvt4(v); }
}
}

namespace s5 {
constexpr int XROW = 272, XIMG = 32 * XROW, OFF_X = 0, OFF_E = 8 * XIMG, LDS_END = OFF_E + 8 * 64 * 8;
static_assert(LDS_END <= RING_BYTES, "s5 LDS");
struct LamC { float lr, li, cr, ci; };
__device__ __forceinline__ LamC lam_coef(const float* are, const float* aim, float dt, int n) {
    const float ar = fminf(are[n], -1e-4f), ai = aim[n];
    const float zr = ar * dt, zi = ai * dt;
    float sn, cs; sincosf(zi, &sn, &cs);
    const float er = expf(zr);
    LamC o; o.lr = er * cs; o.li = er * sn;
    const float sh = sinf(0.5f * zi);
    const float nr = expm1f(zr) * cs - 2.0f * sh * sh, ni = o.li;
    const float den = 1.0f / (ar * ar + ai * ai);
    o.cr = (nr * ar + ni * ai) * den; o.ci = (ni * ar - nr * ai) * den;
    return o;
}
__device__ __forceinline__ float gelu_tanh(float y) {
    const float z = 0.7978845608028654f * (y + 0.044715f * y * y * y);
    return y * __builtin_amdgcn_rcpf(1.0f + __builtin_amdgcn_exp2f(-2.0f * LOG2E * z));
}
__device__ __forceinline__ void s5_unit(CArgs& a, LAS unsigned char* lds, int l, int b, int g, int wave, int lane) {
    const int c32 = lane & 31, hi = lane >> 5;
    const float* are = a.in[8] + (size_t)(l * NG + g) * NS; const float* aim = a.in[9] + (size_t)(l * NG + g) * NS;
    const float dt = expf(a.in[10][l * NG + g]);
    const LamC me = lam_coef(are, aim, dt, lane);
    bf16x8 bb[4];
#pragma unroll
    for (int st = 0; st < 2; ++st) { const int ns = 32 * st + c32; const LamC cc = lam_coef(are, aim, dt, ns);
        const float* br = a.in[11] + ((size_t)(l * NG + g) * NS + ns) * 16 + 8 * hi; const float* bi = a.in[12] + ((size_t)(l * NG + g) * NS + ns) * 16 + 8 * hi;
        f32x8 vr, vi;
#pragma unroll
        for (int j = 0; j < 8; ++j) { const float xr = br[j], xi = bi[j]; vr[j] = cc.cr * xr - cc.ci * xi; vi[j] = cc.cr * xi + cc.ci * xr; }
        bb[st] = cvt8(vr); bb[2 + st] = cvt8(vi); }
    bf16x8 cf[8];
    { const float msk = c32 < 16 ? 1.f : 0.f; const int ii = c32 & 15;
        const float* cr = a.in[13] + ((size_t)(l * NG + g) * 16 + ii) * NS + 4 * hi; const float* ci = a.in[14] + ((size_t)(l * NG + g) * 16 + ii) * NS + 4 * hi;
#pragma unroll
        for (int s = 0; s < 8; ++s) { const f32x4 r4 = *(const f32x4*)(cr + 8 * s), i4 = *(const f32x4*)(ci + 8 * s);
            cf[s] = cvt8((f32x8){r4.x * msk, -i4.x * msk, r4.y * msk, -i4.y * msk, r4.z * msk, -i4.z * msk, r4.w * msk, -i4.w * msk}); } }
    bf16x8 df;
    { const float dv = c32 < 16 ? a.in[15][(size_t)l * SSMW + g * 16 + (c32 & 15)] : 0.f; f32x8 v;
#pragma unroll
        for (int j = 0; j < 8; ++j) v[j] = (8 * hi + j == c32) ? dv : 0.f;
        df = cvt8(v); }

    const bf16* up = (const bf16*)(a.ws + WS_PROJ) + ((size_t)b * SEQ + wave * 1024 + c32) * NPROJ + COL_U + g * 16 + 8 * hi;
    bf16* yg = (bf16*)(a.ws + WS_YG) + ((size_t)b * SEQ + wave * 1024 + c32) * SSMW + g * 16 + 4 * hi;
    LAS unsigned char* ximg = lds + OFF_X + wave * XIMG;
    LAS float* ebuf = (LAS float*)(lds + OFF_E);

    float xr = 0.f, xi = 0.f;
    for (int pass = 0; pass < 2; ++pass) {
        bf16x8 ub[8];
#pragma unroll
        for (int i = 0; i < 8; ++i) ub[i] = *(const bf16x8*)(up + (size_t)i * 32 * NPROJ);
        for (int sg = 0; sg < 4; ++sg)
#pragma unroll
        for (int si = 0; si < 8; ++si) {
            const int sc = sg * 8 + si;
            const bf16x8 uf = ub[si];
            if (sg < 3) ub[si] = *(const bf16x8*)(up + (size_t)(sc + 8) * 32 * NPROJ);
            f32x16 z;
#pragma unroll
            for (int r = 0; r < 16; ++r) z[r] = 0.f;
            f32x16 c0 = MFMA32(uf, bb[0], z), c1 = MFMA32(uf, bb[1], z), c2 = MFMA32(uf, bb[2], z), c3 = MFMA32(uf, bb[3], z);
            f32x16 re0, re1, im0, im1;
#pragma unroll
            for (int r = 0; r < 16; ++r) {
                const float f0 = c0[r], f1 = c1[r], f2 = c2[r], f3 = c3[r];
                const auto s0 = __builtin_amdgcn_permlane32_swap(__float_as_uint(f0), __float_as_uint(f1), false, false);
                const auto s1 = __builtin_amdgcn_permlane32_swap(__float_as_uint(f2), __float_as_uint(f3), false, false);
                const unsigned u00 = s0[0], u01 = s0[1], u10 = s1[0], u11 = s1[1];
                re0[r] = __uint_as_float(u00); re1[r] = __uint_as_float(u01); im0[r] = __uint_as_float(u10); im1[r] = __uint_as_float(u11);
            }
#pragma unroll
            for (int q4 = 0; q4 < 4; ++q4) {
#pragma unroll
                for (int i = 0; i < 4; ++i) { const int r = 4 * q4 + i; const float nr = me.lr * xr - me.li * xi + re0[r], ni = me.lr * xi + me.li * xr + im0[r]; xr = nr; xi = ni; re0[r] = nr; im0[r] = ni; }
#pragma unroll
                for (int i = 0; i < 4; ++i) { const int r = 4 * q4 + i; const float nr = me.lr * xr - me.li * xi + re1[r], ni = me.lr * xi + me.li * xr + im1[r]; xr = nr; xi = ni; re1[r] = nr; im1[r] = ni; }
            }
            if (pass == 1) {
#pragma unroll
                for (int r = 0; r < 16; ++r) {
                    *(LAS unsigned*)(ximg + crow(r, 0) * XROW + 4 * lane) = cvt2(re0[r], im0[r]);
                    *(LAS unsigned*)(ximg + crow(r, 1) * XROW + 4 * lane) = cvt2(re1[r], im1[r]);
                }
                f32x16 y;
#pragma unroll
                for (int r = 0; r < 16; ++r) y[r] = 0.f;
#pragma unroll
                for (int s = 0; s < 8; ++s) { const bf16x8 xf = *(const LAS bf16x8*)(ximg + c32 * XROW + 32 * s + 16 * hi); y = MFMA32(cf[s], xf, y); }
                y = MFMA32(df, uf, y);
                bf16* yo = yg + (size_t)sc * 32 * SSMW;
                *(v2u*)yo = cvt4((f32x4){gelu_tanh(y[0]), gelu_tanh(y[1]), gelu_tanh(y[2]), gelu_tanh(y[3])});
                *(v2u*)(yo + 8) = cvt4((f32x4){gelu_tanh(y[4]), gelu_tanh(y[5]), gelu_tanh(y[6]), gelu_tanh(y[7])});
            }
        }
        if (pass == 0) {
            ebuf[(wave * 64 + lane) * 2] = xr; ebuf[(wave * 64 + lane) * 2 + 1] = xi;
            __syncthreads();
            float pr = me.lr, pi = me.li;
#pragma unroll
            for (int i = 0; i < 10; ++i) { const float nr = pr * pr - pi * pi, ni = 2.f * pr * pi; pr = nr; pi = ni; }
            xr = 0.f; xi = 0.f;
            for (int w2 = 0; w2 < wave; ++w2) { const float er = ebuf[(w2 * 64 + lane) * 2], ei = ebuf[(w2 * 64 + lane) * 2 + 1];
                const float nr = pr * xr - pi * xi + er, ni = pr * xi + pi * xr + ei; xr = nr; xi = ni; }
        }
    }
    __syncthreads();
}
}
#define argp() (*({ CArgs* p_ = (CArgs*)__builtin_amdgcn_kernarg_segment_ptr(); asm volatile("" : "+s"(p_)); p_; }))
#define tidp() ({ int t_ = (wave << 6) + (int)__builtin_amdgcn_mbcnt_hi(~0u, __builtin_amdgcn_mbcnt_lo(~0u, 0u)); asm volatile("" : "+v"(t_)); t_; })
#define GRID_BAR() do { XcdBarrier b_ = bar; asm volatile("" : "+s"(b_.bar), "+s"(b_.x)); xcd_barrier(b_, tidp()); } while (0)
#define GEMM_PHASE(EPI, g, S, E) pg8::gemm_phase<EPI, pg8::StaticOrder, PG8_ALIGN, PG8_SP2>(lds + RING_OFF, g, S, E, tidp())

__global__ void __launch_bounds__(NWAVES * 64, 2) hybrid_fwd(Args args) {
    extern __shared__ __attribute__((aligned(16))) unsigned char lds_raw[];
    LAS unsigned char* lds = (LAS unsigned char*)lds_raw;
    const int wave = __builtin_amdgcn_readfirstlane((int)threadIdx.x >> 6);
    const int G = gridDim.x, bx = blockIdx.x;
    const int vcu = (G % 8 == 0) ? (bx % 8) * (G / 8) + bx / 8 : bx;
    const int gw = vcu * NWAVES + wave, NGW = G * NWAVES;
    for (int u = threadIdx.x; u < (LDS_BYTES - LDSCTL_OFF) / 4; u += NWAVES * 64) ((LAS unsigned*)(lds + LDSCTL_OFF))[u] = 0u;
    __syncthreads();
    volatile LAS unsigned* MISC = (volatile LAS unsigned*)(lds + MISC_OFF);
    XcdBarrier bar = xcd_barrier_post((unsigned*)(argp().ws + WS_CTL) + CW_BAR, MISC + 8);

    p0_weights(argp(), lds, gw, NGW, wave, tidp() & 63);
    __syncthreads();
    { const int t = tidp(); phase_norm0(argp(), lds, gw, NGW, t, t & 63); }
    GRID_BAR();

    for (int l = 0; l < LAYERS; ++l) {
        { unsigned char* ws = argp().ws; unsigned char* wl = ws + WS_W + (size_t)l * W_LAYER;
          pg8::Gemm g{(const pg8::bf16_t*)(ws + WS_X16), (const pg8::bf16_t*)(wl + W_IN), M, NPROJ, D}; pg8::StaticOrder S; S.init(M, NPROJ, G, bx);
          pg8::EpiStoreBf16 E{(pg8::bf16_t*)(ws + WS_PROJ), NPROJ, (const float*)(ws + WS_RS)};
          GEMM_PHASE(pg8::EpiStoreBf16, g, S, E); }
        GRID_BAR();
        phase_cum_knorm(argp(), gw, NGW, tidp() & 63);
        for (int u = vcu; u < BATCH * NG; u += G) s5::s5_unit(argp(), lds, l, u >> 7, u & 127, wave, tidp() & 63);
        for (int u = vcu; u < 256; u += G) { const int bh = u >> 4, x = u & 15;
            for (int k = 0; k < 2; ++k) { const int t = tidp(); att::attn_unit<0>(argp(), lds, l, bh >> 3, bh & 7, k ? x + 16 : x, t, wave, t & 63); } }
        GRID_BAR();
        for (int u = vcu; u < 256; u += G) { const int bh = u >> 4, x = u & 15;
            for (int k = 0; k < 2; ++k) { const int t = tidp(); att::attn_unit<1>(argp(), lds, l, bh >> 3, bh & 7, k ? 31 - x : x, t, wave, t & 63); } }
        GRID_BAR();
        { CArgs& A_ = argp(); unsigned char* ws = A_.ws; unsigned char* wl = ws + WS_W + (size_t)l * W_LAYER;
          pg8::Gemm g{(const pg8::bf16_t*)(ws + WS_YG), (const pg8::bf16_t*)(wl + W_GLU), M, SSMW, SSMW}; pg8::StaticOrder S; S.init(M, SSMW, G, bx);
          pg8::EpiGlu E{(const pg8::bf16_t*)(ws + WS_YG), SSMW, (pg8::bf16_t*)(ws + WS_O) + 2048, D, A_.in[17] + (size_t)l * SSMW};
          GEMM_PHASE(pg8::EpiGlu, g, S, E); }
        GRID_BAR();
        phase_mixnorm(argp(), gw, NGW, tidp() & 63);
        GRID_BAR();
        { unsigned char* ws = argp().ws; unsigned char* wl = ws + WS_W + (size_t)l * W_LAYER;
          pg8::Gemm g{(const pg8::bf16_t*)(ws + WS_O), (const pg8::bf16_t*)(wl + W_OUT), M, D, D}; pg8::StaticOrder S; S.init(M, D, G, bx);
          pg8::EpiStoreBf16 E{(pg8::bf16_t*)(ws + WS_Y16), D, nullptr};
          GEMM_PHASE(pg8::EpiStoreBf16, g, S, E); }
        GRID_BAR();
        { CArgs& A_ = argp(); phase_post<false, false, false>(A_, lds, A_.in[4] + (size_t)l * D, 0, gw, NGW, tidp(), tidp() & 63); }
        GRID_BAR();
        { unsigned char* ws = argp().ws; unsigned char* wl = ws + WS_W + (size_t)l * W_LAYER;
          pg8::Gemm g{(const pg8::bf16_t*)(ws + WS_X16), (const pg8::bf16_t*)(wl + W_GU), M, NGU, D}; pg8::StaticOrder S; S.init(M, NGU, G, bx);
          pg8::EpiSwiGlu E{(pg8::bf16_t*)(ws + WS_ACT), DFF, (const float*)(ws + WS_RS)};
          GEMM_PHASE(pg8::EpiSwiGlu, g, S, E); }
        GRID_BAR();
        { unsigned char* ws = argp().ws; unsigned char* wl = ws + WS_W + (size_t)l * W_LAYER;
          pg8::Gemm g{(const pg8::bf16_t*)(ws + WS_ACT), (const pg8::bf16_t*)(wl + W_D), M, D, DFF}; pg8::StaticOrder S; S.init(M, D, G, bx);
          pg8::EpiStoreBf16 E{(pg8::bf16_t*)(ws + WS_Y16), D, nullptr};
          GEMM_PHASE(pg8::EpiStoreBf16, g, S, E); }
        GRID_BAR();
        if (l + 1 < LAYERS) { CArgs& A_ = argp(); phase_post<false, false, true>(A_, lds, A_.in[19] + (size_t)l * D, l + 1, gw, NGW, tidp(), tidp() & 63); GRID_BAR(); }
        else { CArgs& A_ = argp(); phase_post<false, true, false>(A_, lds, A_.in[19] + (size_t)l * D, 0, gw, NGW, tidp(), tidp() & 63); }
    }
}

extern "C" void kernel_launch(void* const* d_in, const int* in_sizes, int n_in, void* d_out, int out_size, void* d_ws, size_t ws_size, hipStream_t stream) {
    static int grid = 0;
    if (grid == 0) {
        if (n_in != 23 || in_sizes[0] != M * D || out_size != M * D || ws_size < WS_END) {
            fprintf(stderr, "kernel_launch: unexpected shapes: n_in %d in0 %d out %d ws %zu (need %zu)\n", n_in, n_in > 0 ? in_sizes[0] : -1, out_size, ws_size, (size_t)WS_END); grid = -1; return; }
        int dev = 0, cus = 0, per_cu = 0;
        if (hipGetDevice(&dev) != hipSuccess || hipDeviceGetAttribute(&cus, hipDeviceAttributeMultiprocessorCount, dev) != hipSuccess) { grid = -1; return; }
        if (hipFuncSetAttribute((const void*)hybrid_fwd, hipFuncAttributeMaxDynamicSharedMemorySize, LDS_BYTES) != hipSuccess) { fprintf(stderr, "kernel_launch: hipFuncSetAttribute failed\n"); grid = -1; return; }
        if (hipOccupancyMaxActiveBlocksPerMultiprocessor(&per_cu, (const void*)hybrid_fwd, NWAVES * 64, LDS_BYTES) != hipSuccess || per_cu < 1)
            fprintf(stderr, "kernel_launch: occupancy query reports %d workgroups per CU\n", per_cu);
        (void)hipGetLastError();
        grid = cus;
    }
    if (grid < 0) return;
    if (hipMemsetAsync((char*)d_ws + WS_CTL, 0, CTL_ZERO_BYTES, stream) != hipSuccess) return;
    Args a{};
    for (int i = 0; i < 23; ++i) a.in[i] = (const float*)d_in[i];
    a.out = (float*)d_out; a.ws = (unsigned char*)d_ws;
    hipLaunchKernelGGL(hybrid_fwd, dim3(grid), dim3(NWAVES * 64), LDS_BYTES, stream, a);
    const hipError_t le = hipPeekAtLastError();
    if (le != hipSuccess) fprintf(stderr, "kernel_launch: launch failed: %s\n", hipGetErrorName(le));
}
```

```cpp
#include <hip/hip_runtime.h>
#include <cstdio>
#include <cstdint>
namespace pg8 {
#define PG8_LAS __attribute__((address_space(3)))
typedef unsigned short bf16_t;
typedef short bf16x8 __attribute__((ext_vector_type(8)));
typedef float f32x4 __attribute__((ext_vector_type(4)));
typedef unsigned u32x4 __attribute__((ext_vector_type(4)));
constexpr int BM = 256, BK = 64, HALF = 128, HTB = HALF * BK * 2  , STAGE_BYTES = 8 * HTB, NXCD = 8, WGM = 8;

__host__ __device__ __forceinline__ int lds_byte(int r, int c) { const int st = (r >> 4) * 2 + (c >> 5), rr = r & 15, cc = c & 31, ob = rr * 64 + cc * 2; return st * 1024 + (ob ^ (((ob >> 9) & 1) << 5)); }
__host__ __device__ __forceinline__ void stage_rc(int b, int& R, int& C) { const int st = b / 1024, sb = b % 1024, swz = sb ^ (((sb >> 9) & 1) << 5); R = (st >> 1) * 16 + swz / 64; C = (st & 1) * 32 + (swz % 64) / 2; }
__host__ __device__ __forceinline__ int perm32(int rho) { const int n = rho >> 4, i = rho & 15; return 8 * (i >> 2) + 4 * n + (i & 3); }

struct Unit { int pm, pn; };
struct Gemm { const bf16_t* A; const bf16_t* Bt; int M, N, K; };

struct StaticOrder {
    int nM, nN, nwg, G, c;
    __host__ __device__ void init(int M, int N, int G_, int c_) { nM = M / BM; nN = N / BM; nwg = nM * nN; G = G_; c = c_; }
    __host__ __device__ bool next(int i, Unit& u) const {
        const long L = (long)i * G + c; if (L >= nwg) return false;
        int wgid = (int)L; { const int q = nwg / NXCD, r = nwg % NXCD, xcd = wgid % NXCD, off = wgid / NXCD; wgid = (xcd < r ? xcd * (q + 1) : r * (q + 1) + (xcd - r) * q) + off; }
        const int nig = WGM * nN, gid = wgid / nig, fm = gid * WGM, gsz = (nM - fm) < WGM ? (nM - fm) : WGM;
        u.pm = fm + ((wgid % nig) % gsz); u.pn = (wgid % nig) / gsz; return true;
    }
    __device__ __forceinline__ void a_ready(const Unit&) const {}
    __device__ __forceinline__ void done(const Unit&) const {}
};

__device__ __forceinline__ unsigned cvt_pk_bf16(float lo, float hi) { unsigned r; asm volatile("v_cvt_pk_bf16_f32 %0, %1, %2" : "=v"(r) : "v"(lo), "v"(hi)); return r; }
typedef unsigned u32x2 __attribute__((ext_vector_type(2)));
__device__ __forceinline__ float sigm(float z) { return __builtin_amdgcn_rcpf(1.0f + __builtin_amdgcn_exp2f(-1.4426950408889634f * z)); }
__device__ __forceinline__ float bflo(unsigned w) { return __builtin_bit_cast(float, w << 16); }
__device__ __forceinline__ float bfhi(unsigned w) { return __builtin_bit_cast(float, w & 0xffff0000u); }
struct EpiStoreBf16 {
    static constexpr bool PERM = true, AFTER_DRAIN = false;
    bf16_t* O; int ldc; const float* rs;
    __device__ __forceinline__ void operator()(const f32x4 (&acc)[2][2][4][2], const Unit& u, int wr, int wc, int fr, int fq) const {
        const int row0 = u.pm * BM + wr * 64 + fr, col0 = u.pn * BM + wc * 32 + 8 * fq;
#pragma unroll
        for (int ai = 0; ai < 2; ++ai)
#pragma unroll
            for (int m = 0; m < 4; ++m) { bf16_t* rowp = O + (size_t)(row0 + ai * HALF + m * 16) * ldc + col0; const float sc = rs ? rs[row0 + ai * HALF + m * 16] : 1.0f;
#pragma unroll
                for (int bj = 0; bj < 2; ++bj) { const f32x4 v0 = acc[ai][bj][m][0] * sc, v1 = acc[ai][bj][m][1] * sc;
                    u32x4 w; w.x = cvt_pk_bf16(v0[0], v0[1]); w.y = cvt_pk_bf16(v0[2], v0[3]); w.z = cvt_pk_bf16(v1[0], v1[1]); w.w = cvt_pk_bf16(v1[2], v1[3]);
                    *(u32x4*)(rowp + bj * HALF) = w; } }
    }
};
struct EpiStoreF32 {
    static constexpr bool PERM = false, AFTER_DRAIN = false;
    float* C; int ldc;
    __device__ __forceinline__ void operator()(const f32x4 (&acc)[2][2][4][2], const Unit& u, int wr, int wc, int fr, int fq) const {
        const int row0 = u.pm * BM + wr * 64 + fr, col0 = u.pn * BM + wc * 32 + 4 * fq;
#pragma unroll
        for (int ai = 0; ai < 2; ++ai)
#pragma unroll
            for (int m = 0; m < 4; ++m) { float* rowp = C + (size_t)(row0 + ai * HALF + m * 16) * ldc + col0;
#pragma unroll
                for (int bj = 0; bj < 2; ++bj)
#pragma unroll
                    for (int n = 0; n < 2; ++n) *(f32x4*)(rowp + bj * HALF + n * 16) = acc[ai][bj][m][n]; }
    }
};
struct EpiGlu {
    static constexpr bool PERM = true, AFTER_DRAIN = false;
    const bf16_t* Y; int ldy; bf16_t* O; int ldo; const float* bias;
    __device__ __forceinline__ void operator()(const f32x4 (&acc)[2][2][4][2], const Unit& u, int wr, int wc, int fr, int fq) const {
        const int row0 = u.pm * BM + wr * 64 + fr, col0 = u.pn * BM + wc * 32 + 8 * fq;
        f32x4 bv[2][2];
#pragma unroll
        for (int bj = 0; bj < 2; ++bj)
#pragma unroll
            for (int n = 0; n < 2; ++n) bv[bj][n] = *(const f32x4*)(bias + col0 + bj * HALF + 4 * n);
#pragma unroll
        for (int ai = 0; ai < 2; ++ai)
#pragma unroll
            for (int m = 0; m < 4; ++m) { const size_t r = (size_t)(row0 + ai * HALF + m * 16);
#pragma unroll
                for (int bj = 0; bj < 2; ++bj) { const u32x4 yv = *(const u32x4*)(Y + r * ldy + col0 + bj * HALF);
                    const f32x4 z0 = acc[ai][bj][m][0] + bv[bj][0], z1 = acc[ai][bj][m][1] + bv[bj][1];
                    u32x4 w;
                    w.x = cvt_pk_bf16(bflo(yv.x) * sigm(z0[0]), bfhi(yv.x) * sigm(z0[1])); w.y = cvt_pk_bf16(bflo(yv.y) * sigm(z0[2]), bfhi(yv.y) * sigm(z0[3]));
                    w.z = cvt_pk_bf16(bflo(yv.z) * sigm(z1[0]), bfhi(yv.z) * sigm(z1[1])); w.w = cvt_pk_bf16(bflo(yv.w) * sigm(z1[2]), bfhi(yv.w) * sigm(z1[3]));
                    *(u32x4*)(O + r * ldo + col0 + bj * HALF) = w; } }
    }
};
struct EpiSwiGlu {
    static constexpr bool PERM = true, AFTER_DRAIN = false;
    bf16_t* O; int ldc; const float* rs;
    __device__ __forceinline__ void operator()(const f32x4 (&acc)[2][2][4][2], const Unit& u, int wr, int wc, int fr, int fq) const {
        const int row0 = u.pm * BM + wr * 64 + fr, col0 = u.pn * HALF + wc * 32 + 8 * fq;
#pragma unroll
        for (int ai = 0; ai < 2; ++ai)
#pragma unroll
            for (int m = 0; m < 4; ++m) { bf16_t* rowp = O + (size_t)(row0 + ai * HALF + m * 16) * ldc + col0; const float sc = rs[row0 + ai * HALF + m * 16];
                const f32x4 g0 = acc[ai][0][m][0] * sc, g1 = acc[ai][0][m][1] * sc, u0 = acc[ai][1][m][0] * sc, u1 = acc[ai][1][m][1] * sc;
                u32x4 w;
                w.x = cvt_pk_bf16(g0[0] * sigm(g0[0]) * u0[0], g0[1] * sigm(g0[1]) * u0[1]); w.y = cvt_pk_bf16(g0[2] * sigm(g0[2]) * u0[2], g0[3] * sigm(g0[3]) * u0[3]);
                w.z = cvt_pk_bf16(g1[0] * sigm(g1[0]) * u1[0], g1[1] * sigm(g1[1]) * u1[1]); w.w = cvt_pk_bf16(g1[2] * sigm(g1[2]) * u1[2], g1[3] * sigm(g1[3]) * u1[3]);
                *(u32x4*)rowp = w; }
    }
};
template <class Epi, class Sched, bool ALIGN_EPI = false, bool SP2 = false>
__device__ __forceinline__ void gemm_phase(PG8_LAS unsigned char* lds, const Gemm g, const Sched& S, const Epi& E, const int tid) {
    const int wid = __builtin_amdgcn_readfirstlane(tid >> 6), lane = tid & 63, wr = wid >> 2, wc = wid & 3, fr = lane & 15, fq = lane >> 4;
    const int K = g.K, nt = K / BK;
    unsigned voffA[2], voffB[2];
#pragma unroll
    for (int i = 0; i < 2; ++i) { int R, C; stage_rc(tid * 16 + i * 8192, R, C); const int Rb = Epi::PERM ? ((R & ~31) + perm32(R & 31)) : R;
        voffA[i] = (unsigned)(R * K + C) * 2u; voffB[i] = (unsigned)(Rb * K + C) * 2u; }
    const size_t kstep = (size_t)(BK * 2);
    const size_t hstep = (size_t)HALF * K * 2;
    const size_t tstep = 2 * hstep;
    const unsigned ldsw = (unsigned)wid * 1024u;
    const int aoff = lds_byte(wr * 64 + fr, fq * 8), boff = lds_byte(wc * 32 + fr, fq * 8);
#define PG8_SA(b, h) (((b) * 2 + (h)) * HTB)
#define PG8_SB(b, h) ((4 + (b) * 2 + (h)) * HTB)
#define PG8_STAGE(bufoff, gbase, voff) do { _Pragma("unroll") for (int _i = 0; _i < 2; ++_i) \
        __builtin_amdgcn_global_load_lds((const unsigned*)((const char*)(gbase) + (voff)[_i]), (PG8_LAS unsigned*)(lds + (bufoff) + ldsw + _i * 8192), 16, 0, 0); } while (0)
#define PG8_LDA(dst, b, h) do { _Pragma("unroll") for (int m = 0; m < 4; ++m) _Pragma("unroll") for (int k = 0; k < 2; ++k) dst[m][k] = *(const PG8_LAS bf16x8*)(lds + PG8_SA(b, h) + aoff + m * 2048 + k * 1024); } while (0)
#define PG8_LDB(dst, b, h) do { _Pragma("unroll") for (int n = 0; n < 2; ++n) _Pragma("unroll") for (int k = 0; k < 2; ++k) dst[n][k] = *(const PG8_LAS bf16x8*)(lds + PG8_SB(b, h) + boff + n * 2048 + k * 1024); } while (0)
#define PG8_MMA(ai, bj, At, Bt) do { __builtin_amdgcn_s_setprio(1); _Pragma("unroll") for (int m = 0; m < 4; ++m) _Pragma("unroll") for (int n = 0; n < 2; ++n) _Pragma("unroll") for (int k = 0; k < 2; ++k) \
        acc[ai][bj][m][n] = __builtin_amdgcn_mfma_f32_16x16x32_bf16(Bt[n][k], At[m][k], acc[ai][bj][m][n], 0, 0, 0); __builtin_amdgcn_s_setprio(0); } while (0)
#define PG8_WAIT_V(n) asm volatile("s_waitcnt vmcnt(" #n ")" ::: "memory")
#define PG8_WAIT_L(n) asm volatile("s_waitcnt lgkmcnt(" #n ")" ::: "memory")
#define PG8_BAR __builtin_amdgcn_s_barrier()
#define PG8_SCHED __builtin_amdgcn_sched_barrier(0)
    Unit cur, nxt; int ui = 0;
    if (!S.next(0, cur)) return;
    f32x4 acc[2][2][4][2];
#pragma unroll
    for (int a = 0; a < 2; ++a)
#pragma unroll
        for (int b = 0; b < 2; ++b)
#pragma unroll
            for (int m = 0; m < 4; ++m)
#pragma unroll
                for (int n = 0; n < 2; ++n) acc[a][b][m][n] = (f32x4){0.f, 0.f, 0.f, 0.f};
    bf16x8 At[4][2], B0[2][2], B1[2][2];
    const char* cA = (const char*)g.A + (size_t)cur.pm * tstep; const char* cB = (const char*)g.Bt + (size_t)cur.pn * tstep;
    S.a_ready(cur);
    if constexpr (SP2) {
        PG8_STAGE(PG8_SB(0, 0), cB, voffB); PG8_STAGE(PG8_SB(0, 1), cB + hstep, voffB); PG8_STAGE(PG8_SA(0, 0), cA, voffA); PG8_STAGE(PG8_SA(0, 1), cA + hstep, voffA);
        if (wr == 1) PG8_BAR;
        PG8_WAIT_V(2); PG8_BAR;
        PG8_STAGE(PG8_SB(1, 0), cB + kstep, voffB); PG8_STAGE(PG8_SA(1, 0), cA + kstep, voffA); PG8_STAGE(PG8_SB(1, 1), cB + hstep + kstep, voffB);
        PG8_WAIT_V(6); PG8_BAR;
    } else {
        PG8_STAGE(PG8_SB(0, 0), cB, voffB); PG8_STAGE(PG8_SA(0, 0), cA, voffA); PG8_STAGE(PG8_SB(0, 1), cB + hstep, voffB); PG8_STAGE(PG8_SA(0, 1), cA + hstep, voffA);
        if (wr == 1) PG8_BAR;
        PG8_WAIT_V(4); PG8_BAR;
        PG8_STAGE(PG8_SB(1, 0), cB + kstep, voffB); PG8_STAGE(PG8_SA(1, 0), cA + kstep, voffA); PG8_STAGE(PG8_SB(1, 1), cB + hstep + kstep, voffB);
        PG8_WAIT_V(6); PG8_BAR;
    }
    for (;;) {
        const bool has_next = S.next(ui + 1, nxt);
        const char* nA = has_next ? (const char*)g.A + (size_t)nxt.pm * tstep : cA; const char* nB = has_next ? (const char*)g.Bt + (size_t)nxt.pn * tstep : cB;
        for (int t = 0; t < nt; t += 2) {
            const bool last = (t == nt - 2);
            const char* a1 = cA + (size_t)(t + 1) * kstep;
            const char* a2 = last ? nA : cA + (size_t)(t + 2) * kstep; const char* b2 = last ? nB : cB + (size_t)(t + 2) * kstep;
            const char* a3 = a2 + kstep; const char* b3 = b2 + kstep;
            if (last && has_next) S.a_ready(nxt);
            if constexpr (SP2) {
            PG8_LDB(B0, 0, 0); PG8_LDB(B1, 0, 1); PG8_SCHED; PG8_LDA(At, 0, 0); PG8_STAGE(PG8_SA(1, 1), a1 + hstep, voffA);
            PG8_WAIT_V(8); PG8_WAIT_L(0); PG8_BAR; PG8_MMA(0, 0, At, B0); PG8_MMA(0, 1, At, B1); PG8_BAR; PG8_SCHED;
            PG8_LDA(At, 0, 1); PG8_STAGE(PG8_SB(0, 0), b2, voffB); PG8_STAGE(PG8_SB(0, 1), b2 + hstep, voffB); PG8_STAGE(PG8_SA(0, 0), a2, voffA);
            PG8_WAIT_V(8); PG8_WAIT_L(0); PG8_BAR; PG8_MMA(1, 0, At, B0); PG8_MMA(1, 1, At, B1); PG8_BAR; PG8_SCHED;
            PG8_LDB(B0, 1, 0); PG8_LDB(B1, 1, 1); PG8_SCHED; PG8_LDA(At, 1, 0); PG8_STAGE(PG8_SA(0, 1), a2 + hstep, voffA);
            PG8_WAIT_V(8); PG8_WAIT_L(0); PG8_BAR; PG8_MMA(0, 0, At, B0); PG8_MMA(0, 1, At, B1); PG8_BAR; PG8_SCHED;
            PG8_LDA(At, 1, 1); PG8_STAGE(PG8_SB(1, 0), b3, voffB); PG8_STAGE(PG8_SB(1, 1), b3 + hstep, voffB); PG8_STAGE(PG8_SA(1, 0), a3, voffA);
            PG8_WAIT_V(8); PG8_WAIT_L(0); PG8_BAR; PG8_MMA(1, 0, At, B0); PG8_MMA(1, 1, At, B1); PG8_BAR; PG8_SCHED;
            } else {
            PG8_LDB(B0, 0, 0); PG8_SCHED; PG8_LDA(At, 0, 0); PG8_STAGE(PG8_SA(1, 1), a1 + hstep, voffA);
            PG8_WAIT_L(8); PG8_BAR; PG8_WAIT_L(0); PG8_MMA(0, 0, At, B0); PG8_BAR; PG8_SCHED;
            PG8_LDB(B1, 0, 1); PG8_STAGE(PG8_SB(0, 0), b2, voffB);
            PG8_BAR; PG8_WAIT_L(0); PG8_MMA(0, 1, At, B1); PG8_BAR;
            PG8_LDA(At, 0, 1); PG8_STAGE(PG8_SA(0, 0), a2, voffA);
            PG8_BAR; PG8_WAIT_L(0); PG8_MMA(1, 0, At, B0); PG8_BAR; PG8_SCHED;
            PG8_STAGE(PG8_SB(0, 1), b2 + hstep, voffB);
            PG8_WAIT_V(6); PG8_BAR; PG8_MMA(1, 1, At, B1); PG8_BAR;
            PG8_LDB(B0, 1, 0); PG8_SCHED; PG8_LDA(At, 1, 0); PG8_STAGE(PG8_SA(0, 1), a2 + hstep, voffA);
            PG8_WAIT_L(8); PG8_BAR; PG8_WAIT_L(0); PG8_MMA(0, 0, At, B0); PG8_BAR; PG8_SCHED;
            PG8_LDB(B1, 1, 1); PG8_STAGE(PG8_SB(1, 0), b3, voffB);
            PG8_BAR; PG8_WAIT_L(0); PG8_MMA(0, 1, At, B1); PG8_BAR;
            PG8_LDA(At, 1, 1); PG8_STAGE(PG8_SA(1, 0), a3, voffA);
            PG8_BAR; PG8_WAIT_L(0); PG8_MMA(1, 0, At, B0); PG8_BAR; PG8_SCHED;
            PG8_STAGE(PG8_SB(1, 1), b3 + hstep, voffB);
            PG8_WAIT_V(6); PG8_BAR; PG8_MMA(1, 1, At, B1); PG8_BAR;
            }
        }
        if constexpr (ALIGN_EPI) { if (wr == 0) PG8_BAR; }
        if constexpr (!Epi::AFTER_DRAIN) { E(acc, cur, wr, wc, fr, fq); S.done(cur); }
        if (!has_next) break;
#pragma unroll
        for (int a = 0; a < 2; ++a)
#pragma unroll
            for (int b = 0; b < 2; ++b)
#pragma unroll
                for (int m = 0; m < 4; ++m)
#pragma unroll
                    for (int n = 0; n < 2; ++n) acc[a][b][m][n] = (f32x4){0.f, 0.f, 0.f, 0.f};
        cur = nxt; cA = nA; cB = nB; ++ui;
        if constexpr (ALIGN_EPI) { if (wr == 1) PG8_BAR; }
    }
    PG8_WAIT_V(0);
    if constexpr (!ALIGN_EPI) { if (wr == 0) PG8_BAR; }
    PG8_BAR;
    if constexpr (Epi::AFTER_DRAIN) { E.fused(acc, cur, wr, wc, fr, fq, lds, wid, lane); S.done(cur); }
#undef PG8_SA
#undef PG8_SB
#undef PG8_STAGE
#undef PG8_LDA
#undef PG8_LDB
#undef PG8_MMA
#undef PG8_WAIT_V
#undef PG8_WAIT_L
#undef PG8_BAR
#undef PG8_SCHED
}
}
#ifndef PG8_SP2
#define PG8_SP2 true
#endif
#ifndef PG8_ALIGN
#define PG8_ALIGN true
#endif

constexpr int NWAVES = 8;
constexpr int BATCH = 2, SEQ = 8192, M = BATCH * SEQ, D = 4096, INCOLS = 8200, NPROJ = 8192, DFF = 11008, NGU = 2 * DFF;
constexpr int HD = 128, NH = 8, SSMW = 2048, NG = 128, NS = 64, LAYERS = 2;
constexpr int COL_QA = 0, COL_KA = 1024, COL_VA = 2048, COL_QB = 3072, COL_KB = 4096, COL_VB = 5120, COL_U = 6144;
constexpr float RMS_EPS = 1e-6f;
constexpr float LOG2E = 1.4426950408889634f;
constexpr float QK_SCALE = 0.08838834764831845f;

constexpr size_t MiB = 1u << 20;
constexpr size_t WS_CTL = 0, CTL_ZERO_BYTES = 1 * MiB;
constexpr size_t WS_LS = 3 * MiB;
constexpr size_t WS_CUM = 4 * MiB;
constexpr size_t WS_RS = 6 * MiB;
constexpr size_t WS_KNT = 5 * MiB;
constexpr size_t WS_W = 16 * MiB;
constexpr size_t W_IN = 0, W_GLU = 64 * MiB, W_OUT = 72 * MiB, W_GU = 104 * MiB, W_D = 276 * MiB, W_LAYER = 362 * MiB;
constexpr size_t WS_X16 = WS_W + 2 * W_LAYER;
constexpr size_t WS_PROJ = WS_X16 + 128 * MiB;
constexpr size_t WS_YG = WS_PROJ + 256 * MiB;
constexpr size_t WS_O = WS_YG + 64 * MiB;
constexpr size_t WS_Y16 = WS_O + 128 * MiB;
constexpr size_t WS_ACT = WS_PROJ;
constexpr size_t WS_END = WS_Y16 + 256 * MiB;
static_assert(WS_ACT + (size_t)M * DFF * 2 <= WS_Y16, "ACT overlay");
constexpr int CW_TMO = 0, CW_BAR = 4096;

constexpr int RING_OFF = 0, RING_BYTES = 131072;
constexpr int LDSCTL_OFF = RING_BYTES, MISC_OFF = LDSCTL_OFF + 320;
constexpr int LDS_BYTES = 147456;

#define GAS __attribute__((address_space(1)))
#define LAS __attribute__((address_space(3)))
typedef unsigned short bf16;
typedef unsigned v4u __attribute__((ext_vector_type(4)));
typedef unsigned v2u __attribute__((ext_vector_type(2)));
typedef float f32x4 __attribute__((ext_vector_type(4)));
typedef float f32x8 __attribute__((ext_vector_type(8)));
typedef float f32x16 __attribute__((ext_vector_type(16)));
typedef short bf16x8 __attribute__((ext_vector_type(8)));
typedef __bf16 bfv8 __attribute__((ext_vector_type(8)));
typedef __bf16 bfv4 __attribute__((ext_vector_type(4)));
typedef __bf16 bfv2 __attribute__((ext_vector_type(2)));
typedef GAS unsigned gu32;
#define RLX_AGENT __ATOMIC_RELAXED, __HIP_MEMORY_SCOPE_AGENT
#define MFMA32(a, b, c) __builtin_amdgcn_mfma_f32_32x32x16_bf16((a), (b), (c), 0, 0, 0)

__device__ __forceinline__ bf16x8 cvt8(f32x8 v) { return __builtin_bit_cast(bf16x8, __builtin_convertvector(v, bfv8)); }
__device__ __forceinline__ v2u cvt4(f32x4 v) { return __builtin_bit_cast(v2u, __builtin_convertvector(v, bfv4)); }
__device__ __forceinline__ unsigned cvt2(float a, float b) { typedef float f2 __attribute__((ext_vector_type(2))); f2 v = {a, b}; return __builtin_bit_cast(unsigned, __builtin_convertvector(v, bfv2)); }
__device__ __forceinline__ float bf_lo(unsigned w) { return __builtin_bit_cast(float, w << 16); }
__device__ __forceinline__ float bf_hi(unsigned w) { return __builtin_bit_cast(float, w & 0xffff0000u); }
__device__ __forceinline__ float wave_sum(float v) {
#pragma unroll
    for (int o = 1; o < 64; o <<= 1) v += __shfl_xor(v, o);
    return v;
}
__device__ __forceinline__ int crow(int r, int hi) { return (r & 3) + 8 * (r >> 2) + 4 * hi; }

#define XB_TMO      128
#define XB_XCNT(j)  (256  + 64 * (j))
#define XB_XSUB(j)  (1280 + 64 * (j))
#define XB_XGEN(j)  (2304 + 64 * (j))
#define XB_TOP      3328
#define XB_TOPGEN   3392
#define XCD_BAR_WORDS 3456
#define XB_SPIN_CAP (1u << 18)

__device__ __forceinline__ unsigned xb_ld(unsigned* p)              { return __hip_atomic_load(p, __ATOMIC_RELAXED, __HIP_MEMORY_SCOPE_AGENT); }
__device__ __forceinline__ unsigned xb_add(unsigned* p, unsigned v) { return __hip_atomic_fetch_add(p, v, __ATOMIC_RELAXED, __HIP_MEMORY_SCOPE_AGENT); }
__device__ __forceinline__ unsigned xb_xcc_id() { return (unsigned)__builtin_amdgcn_s_getreg((3 << 11) | 20) & 0xFu; }
#define XB_SPIN(cond, bar) do { unsigned _sp = 0; while (cond) { __builtin_amdgcn_s_sleep(1); \
    if ((++_sp & 255u) == 0u) { if (xb_ld(&(bar)[XB_TMO])) break; if (_sp > XB_SPIN_CAP) { atomicAdd(&(bar)[XB_TMO], 1u); break; } } } } while (0)

struct XcdBarrier {
    unsigned* bar; unsigned x;
    volatile LAS unsigned* st;
};

__device__ __forceinline__ XcdBarrier xcd_barrier_post(unsigned* bar, volatile LAS unsigned* st) {
    XcdBarrier b; b.bar = bar; b.x = xb_xcc_id(); b.st = st;
    if (threadIdx.x == 0) (void)xb_add(&bar[XB_XCNT(b.x)], 1u);
    return b;
}
__device__ __forceinline__ void xcd_barrier_complete(unsigned* bar, unsigned x, unsigned& nloc, unsigned& nx) {
    const unsigned G = gridDim.x * gridDim.y * gridDim.z;
    unsigned sum, cnt, mine, sp = 0u;
    for (;;) {
        sum = 0u; cnt = 0u; mine = 0u;
#pragma unroll
        for (unsigned j = 0; j < 16; ++j) { const unsigned c = xb_ld(&bar[XB_XCNT(j)]); sum += c; cnt += (c > 0u) ? 1u : 0u; mine = (j == x) ? c : mine; }
        if (sum == G) break;
        __builtin_amdgcn_s_sleep(1);
        if ((++sp & 255u) == 0u) { if (xb_ld(&bar[XB_TMO])) break; if (sp > XB_SPIN_CAP) { atomicAdd(&bar[XB_TMO], 1u); break; } }
    }
    nloc = mine > 0u ? mine : 1u; nx = cnt > 0u ? cnt : 1u;
}

__device__ __forceinline__ void xcd_barrier(const XcdBarrier& b, const int tid_) {
    asm volatile("s_waitcnt vmcnt(0)" ::: "memory");
    __syncthreads();
    if (tid_ == 0) {
        unsigned* bar = b.bar;
        __builtin_amdgcn_s_waitcnt(0);
        unsigned nloc = b.st[0], nx = b.st[1];
        if (nloc == 0u) { xcd_barrier_complete(bar, b.x, nloc, nx); b.st[0] = nloc; b.st[1] = nx; }
        const unsigned old = xb_add(&bar[XB_XSUB(b.x)], 1u);
        const unsigned gen = old / nloc;
        if (old + 1u == (gen + 1u) * nloc) {
            __builtin_amdgcn_fence(__ATOMIC_RELEASE, "agent");
            asm volatile("s_waitcnt vmcnt(0)" ::: "memory");
            const unsigned og = xb_add(&bar[XB_TOP], 1u);
            const unsigned tg = og / nx;
            if (og + 1u == (tg + 1u) * nx) xb_add(&bar[XB_TOPGEN], 1u);
            else XB_SPIN(xb_ld(&bar[XB_TOPGEN]) == tg, bar);
            __builtin_amdgcn_fence(__ATOMIC_ACQUIRE, "agent");
            xb_add(&bar[XB_XGEN(b.x)], 1u);
            asm volatile("s_waitcnt vmcnt(0)" ::: "memory");
        } else {
            XB_SPIN(xb_ld(&bar[XB_XGEN(b.x)]) == gen, bar);
            __builtin_amdgcn_fence(__ATOMIC_ACQUIRE, "agent");
            asm volatile("s_waitcnt vmcnt(0)" ::: "memory");
        }
    }
    __syncthreads();
}


__device__ __forceinline__ void p0_item(const float* W, int ld, int col0, int k0, const float* gain, bf16* dst, int dstK, LAS float* scr, int lane) {
    const int kr = lane >> 3, nq = lane & 7;
    f32x4 w[8]; float gn[8];
#pragma unroll
    for (int i = 0; i < 8; ++i) { w[i] = *(const f32x4*)(W + (size_t)(k0 + 8 * i + kr) * ld + col0 + 4 * nq); gn[i] = gain ? gain[k0 + 8 * i + kr] : 1.0f; }
#pragma unroll
    for (int i = 0; i < 8; ++i) { LAS float* d = scr + (8 * i + kr) * 33 + 4 * nq; const f32x4 v = w[i] * gn[i]; d[0] = v.x; d[1] = v.y; d[2] = v.z; d[3] = v.w; }
    asm volatile("s_waitcnt lgkmcnt(0)" ::: "memory");
    const int c = lane & 7;
#pragma unroll
    for (int j = 0; j < 4; ++j) { const int n = (lane >> 3) + 8 * j; const LAS float* s = scr + (8 * c) * 33 + n;
        f32x8 v = {s[0 * 33], s[1 * 33], s[2 * 33], s[3 * 33], s[4 * 33], s[5 * 33], s[6 * 33], s[7 * 33]};
        *(bf16x8*)(dst + (size_t)n * dstK + 8 * c) = cvt8(v); }
    asm volatile("s_waitcnt lgkmcnt(0)" ::: "memory");
}
constexpr int I_IN = (D / 64) * (NPROJ / 32), I_GLU = (SSMW / 64) * (SSMW / 32), I_OUT = (D / 64) * (D / 32), I_GU = (D / 64) * (NGU / 32), I_D = (DFF / 64) * (D / 32);
constexpr int I_LAYER = I_IN + I_GLU + I_OUT + I_GU + I_D;

struct Args { const float* in[23]; float* out; unsigned char* ws; };
typedef const __attribute__((address_space(4))) Args CArgs;

__device__ __forceinline__ void p0_weights(CArgs& a, LAS unsigned char* lds, int gw, int NGW, int wave, int lane) {
    LAS float* scr = (LAS float*)(lds + RING_OFF + wave * 16384);
    for (int it = gw; it < LAYERS * I_LAYER; it += NGW) {
        const int l = it / I_LAYER; int r = it - l * I_LAYER;
        unsigned char* wl = a.ws + WS_W + (size_t)l * W_LAYER;
        if (r < I_IN) { const int kb = r / (NPROJ / 32), nb = r % (NPROJ / 32); const int n0 = 32 * nb;
            p0_item(a.in[1] + (size_t)l * D * INCOLS, INCOLS, n0 + (n0 >= COL_U ? 8 : 0), 64 * kb, a.in[3] + l * D, (bf16*)(wl + W_IN) + (size_t)n0 * D + 64 * kb, D, scr, lane); continue; }
        r -= I_IN;
        if (r < I_GLU) { const int kb = r / (SSMW / 32), nb = r % (SSMW / 32);
            p0_item(a.in[16] + (size_t)l * SSMW * SSMW, SSMW, 32 * nb, 64 * kb, nullptr, (bf16*)(wl + W_GLU) + (size_t)(32 * nb) * SSMW + 64 * kb, SSMW, scr, lane); continue; }
        r -= I_GLU;
        if (r < I_OUT) { const int kb = r / (D / 32), nb = r % (D / 32);
            p0_item(a.in[2] + (size_t)l * D * D, D, 32 * nb, 64 * kb, a.in[5] + l * D, (bf16*)(wl + W_OUT) + (size_t)(32 * nb) * D + 64 * kb, D, scr, lane); continue; }
        r -= I_OUT;
        if (r < I_GU) { const int kb = r / (NGU / 32), nb = r % (NGU / 32); const int n0 = 32 * nb, tile = n0 >> 8, within = n0 & 255;
            const float* src = (within < 128 ? a.in[20] : a.in[21]) + (size_t)l * D * DFF;
            p0_item(src, DFF, 128 * tile + (within & 127), 64 * kb, a.in[18] + l * D, (bf16*)(wl + W_GU) + (size_t)n0 * D + 64 * kb, D, scr, lane); continue; }
        r -= I_GU;
        { const int kb = r / (D / 32), nb = r % (D / 32);
            p0_item(a.in[22] + (size_t)l * DFF * D, D, 32 * nb, 64 * kb, nullptr, (bf16*)(wl + W_D) + (size_t)(32 * nb) * DFF + 64 * kb, DFF, scr, lane); }
    }
}

__device__ __forceinline__ void load_row(const float* p, int lane, f32x4 (&v)[16]) {
    const f32x4* q = (const f32x4*)p + lane;
#pragma unroll
    for (int j = 0; j < 16; ++j) v[j] = q[64 * j];
}
__device__ __forceinline__ float row_sumsq(const f32x4 (&v)[16]) {
    float s = 0.f;
#pragma unroll
    for (int j = 0; j < 16; ++j) s += (v[j].x * v[j].x + v[j].y * v[j].y) + (v[j].z * v[j].z + v[j].w * v[j].w);
    return wave_sum(s);
}
__device__ __forceinline__ void store_h(bf16* hrow, int lane, const f32x4 (&v)[16], float rstd) {
    v2u* o = (v2u*)hrow + lane;
#pragma unroll
    for (int j = 0; j < 16; ++j) o[64 * j] = cvt4(v[j] * rstd);
}
__device__ __forceinline__ void build_wfb(LAS float* wfb, const float* w_in_l, const float* g, int tid) {
#pragma unroll 1
    for (int base = tid; base < 8 * D; base += 16 * NWAVES * 64) {
        float w[16], gg[16];
#pragma unroll
        for (int i = 0; i < 16; ++i) { const int idx = base + i * NWAVES * 64, k = idx >> 3, hh = idx & 7; w[i] = w_in_l[(size_t)k * INCOLS + COL_U + hh]; gg[i] = g[k]; }
#pragma unroll
        for (int i = 0; i < 16; ++i) { const int idx = base + i * NWAVES * 64, k = idx >> 3, hh = idx & 7; wfb[hh * D + k] = gg[i] * w[i]; }
    }
}
__device__ __forceinline__ void fb_accum(const f32x4 vj, int j, const LAS float* wfb, int lane, float (&acc)[8]) {
#pragma unroll
    for (int hh = 0; hh < 8; ++hh) { const LAS float* base = wfb + 4 * lane + (hh < 4 ? 0 : 4 * D);
        const f32x4 w = *(const LAS f32x4*)(base + (hh & 3) * D + 256 * j); acc[hh] += (vj.x * w.x + vj.y * w.y) + (vj.z * w.z + vj.w * w.w); }
}
__device__ __forceinline__ void fb_finish(const float (&acc)[8], float rstd, const float* bfg, float* LS, int m, int lane) {
    float mine = 0.f;
#pragma unroll
    for (int hh = 0; hh < 8; ++hh) { const float s = wave_sum(acc[hh]); mine = (lane == hh) ? s : mine; }
    if (lane < 8) { const float z = mine * rstd + bfg[lane];
        const float ls = fminf(z, 0.f) - 0.6931471805599453f * __builtin_amdgcn_logf(1.0f + __builtin_amdgcn_exp2f(-fabsf(z) * LOG2E));
        const int b = m / SEQ, s = m - b * SEQ; LS[(size_t)(b * NH + lane) * SEQ + s] = ls; }
}
__device__ __forceinline__ void fb_emit(const f32x4 (&v)[16], float rstd, const LAS float* wfb, const float* bfg, float* LS, int m, int lane) {
    float acc[8];
#pragma unroll
    for (int hh = 0; hh < 8; ++hh) acc[hh] = 0.f;
#pragma unroll
    for (int j = 0; j < 16; ++j) { fb_accum(v[j], j, wfb, lane, acc);
        asm volatile("" ::: "memory"); }
    fb_finish(acc, rstd, bfg, LS, m, lane);
}
__device__ __forceinline__ void phase_norm0(CArgs& a, LAS unsigned char* lds, int gw, int NGW, int tid, int lane) {
    LAS float* wfb = (LAS float*)(lds + RING_OFF);
    build_wfb(wfb, a.in[1], a.in[3], tid);
    __syncthreads();
    bf16* X = (bf16*)(a.ws + WS_X16); float* LS = (float*)(a.ws + WS_LS); float* RS = (float*)(a.ws + WS_RS);
    f32x4 v[16], vn[16];
    int m = gw;
    if (m < M) load_row(a.in[0] + (size_t)m * D, lane, v);
    while (m < M) {
        const int mn = m + NGW;
        if (mn < M) load_row(a.in[0] + (size_t)mn * D, lane, vn);
        const float rstd = 1.0f / sqrtf(row_sumsq(v) * (1.0f / D) + RMS_EPS);
        store_h(X + (size_t)m * D, lane, v, 1.0f);
        if (lane == 0) RS[m] = rstd;
        fb_emit(v, rstd, wfb, a.in[7], LS, m, lane);
#pragma unroll
        for (int j = 0; j < 16; ++j) v[j] = vn[j];
        m = mn;
    }
    __syncthreads();
}
__device__ __forceinline__ void load_row_bf16(const bf16* p, int lane, f32x4 (&y)[16]) {
    const v2u* yq = (const v2u*)p + lane; v2u yw[16];
#pragma unroll
    for (int j = 0; j < 16; ++j) yw[j] = yq[64 * j];
#pragma unroll
    for (int j = 0; j < 16; ++j) { const unsigned w0 = yw[j].x, w1 = yw[j].y; y[j] = (f32x4){bf_lo(w0), bf_hi(w0), bf_lo(w1), bf_hi(w1)}; }
}
template <bool XF32> struct XRow;
template <> struct XRow<true> { typedef f32x4 T;
    static __device__ __forceinline__ void load(const float* xin, const bf16*, int m, int lane, f32x4 (&w)[16]) { const f32x4* q = (const f32x4*)(xin + (size_t)m * D) + lane;
#pragma unroll
        for (int j = 0; j < 16; ++j) w[j] = q[64 * j]; }
    static __device__ __forceinline__ f32x4 get(const f32x4& w) { return w; } };
template <> struct XRow<false> { typedef v2u T;
    static __device__ __forceinline__ void load(const float*, const bf16* X, int m, int lane, v2u (&w)[16]) { const v2u* q = (const v2u*)(X + (size_t)m * D) + lane;
#pragma unroll
        for (int j = 0; j < 16; ++j) w[j] = q[64 * j]; }
    static __device__ __forceinline__ f32x4 get(const v2u& w) { const unsigned w0 = w.x, w1 = w.y; return (f32x4){bf_lo(w0), bf_hi(w0), bf_lo(w1), bf_hi(w1)}; } };
template <bool XF32, bool LAST, bool DO_FB>
__device__ __forceinline__ void phase_post(CArgs& a, LAS unsigned char* lds, const float* gpost, int lnext, int gw, int NGW, int tid, int lane) {
    LAS float* wfb = (LAS float*)(lds + RING_OFF);
    if (DO_FB) { build_wfb(wfb, a.in[1] + (size_t)lnext * D * INCOLS, a.in[3] + lnext * D, tid); __syncthreads(); }
    const bf16* Y = (const bf16*)(a.ws + WS_Y16); bf16* X = (bf16*)(a.ws + WS_X16); float* LS = (float*)(a.ws + WS_LS); float* RS = (float*)(a.ws + WS_RS);
    const f32x4* gq = (const f32x4*)gpost + lane;
    typedef typename XRow<XF32>::T XT;
    v2u yw[16], ywn[16]; XT xw[16], xwn[16];
    int m = gw;
    if (m < M) { const v2u* yq = (const v2u*)(Y + (size_t)m * D) + lane;
#pragma unroll
        for (int j = 0; j < 16; ++j) yw[j] = yq[64 * j];
        XRow<XF32>::load(a.in[0], X, m, lane, xw); }
#pragma clang loop unroll(disable)
    while (m < M) {
        const int mn = m + NGW;
        if (!XF32 && mn < M) { const v2u* yq = (const v2u*)(Y + (size_t)mn * D) + lane;
#pragma unroll
            for (int j = 0; j < 16; ++j) ywn[j] = yq[64 * j];
            XRow<XF32>::load(a.in[0], X, mn, lane, xwn); }
        float ssy = 0.f;
#pragma unroll
        for (int j = 0; j < 16; ++j) { const unsigned w0 = yw[j].x, w1 = yw[j].y; const float a0 = bf_lo(w0), a1 = bf_hi(w0), a2 = bf_lo(w1), a3 = bf_hi(w1); ssy += (a0 * a0 + a1 * a1) + (a2 * a2 + a3 * a3); }
        const float ry = 1.0f / sqrtf(wave_sum(ssy) * (1.0f / D) + RMS_EPS);
        float ssv = 0.f; float acc[8];
#pragma unroll
        for (int hh = 0; hh < 8; ++hh) acc[hh] = 0.f;
        f32x4* o = (f32x4*)(a.out + (size_t)m * D) + lane; v2u* xo = (v2u*)(X + (size_t)m * D) + lane;
#pragma unroll
        for (int j = 0; j < 16; ++j) { const unsigned w0 = yw[j].x, w1 = yw[j].y; const f32x4 yv = {bf_lo(w0), bf_hi(w0), bf_lo(w1), bf_hi(w1)};
            const f32x4 vj = XRow<XF32>::get(xw[j]) + (yv * ry) * gq[64 * j];
            if (LAST) o[64 * j] = vj;
            else { xo[64 * j] = cvt4(vj); ssv += (vj.x * vj.x + vj.y * vj.y) + (vj.z * vj.z + vj.w * vj.w); if (DO_FB) fb_accum(vj, j, wfb, lane, acc); }
            if (DO_FB) asm volatile("" : "+v"(acc[0]), "+v"(acc[1]), "+v"(acc[2]), "+v"(acc[3]), "+v"(acc[4]), "+v"(acc[5]), "+v"(acc[6]), "+v"(acc[7]) :: "memory");
            else if ((j & 3) == 3) asm volatile("" ::: "memory"); }
        if (!LAST) { const float rstd = 1.0f / sqrtf(wave_sum(ssv) * (1.0f / D) + RMS_EPS);
            if (lane == 0) RS[m] = rstd;
            if (DO_FB) fb_finish(acc, rstd, a.in[7] + lnext * NH, LS, m, lane); }
        if (XF32) { if (mn < M) { const v2u* yq = (const v2u*)(Y + (size_t)mn * D) + lane;
#pragma unroll
                for (int j = 0; j < 16; ++j) yw[j] = yq[64 * j];
                XRow<XF32>::load(a.in[0], X, mn, lane, xw); } }
        else {
#pragma unroll
            for (int j = 0; j < 16; ++j) { yw[j] = ywn[j]; xw[j] = xwn[j]; } }
        m = mn;
    }
    if (DO_FB) __syncthreads();
}
__device__ __forceinline__ void phase_mixnorm(CArgs& a, int gw, int NGW, int lane) {
    bf16* O = (bf16*)(a.ws + WS_O);
    for (int m = gw; m < M; m += NGW) {
        v4u* p = (v4u*)(O + (size_t)m * D) + lane; v4u w[8]; float ss[8];
#pragma unroll
        for (int j = 0; j < 8; ++j) w[j] = p[64 * j];
#pragma unroll
        for (int j = 0; j < 8; ++j) { float s = 0.f;
#pragma unroll
            for (int e = 0; e < 4; ++e) { const float lo = bf_lo(w[j][e]), hi = bf_hi(w[j][e]); s += lo * lo + hi * hi; }
            ss[j] = s; }
        const float sa = wave_sum(ss[0] + ss[1]), sb = wave_sum(ss[2] + ss[3]), sc = wave_sum((ss[4] + ss[5]) + (ss[6] + ss[7]));
        const float ra = 1.0f / sqrtf(sa * (1.0f / 1024.f) + RMS_EPS), rb = 1.0f / sqrtf(sb * (1.0f / 1024.f) + RMS_EPS), rc = 1.0f / sqrtf(sc * (1.0f / 2048.f) + RMS_EPS);
#pragma unroll
        for (int j = 0; j < 8; ++j) { const float r = j < 2 ? ra : (j < 4 ? rb : rc); v4u o;
#pragma unroll
            for (int e = 0; e < 4; ++e) o[e] = cvt2(bf_lo(w[j][e]) * r, bf_hi(w[j][e]) * r);
            p[64 * j] = o; }
    }
}
__device__ __forceinline__ void phase_cum_knorm(CArgs& a, int gw, int NGW, int lane) {
    if (gw < BATCH * NH) {
        const float* ls = (const float*)(a.ws + WS_LS) + (size_t)gw * SEQ; float* cum = (float*)(a.ws + WS_CUM) + (size_t)gw * SEQ; float carry = 0.f;
        f32x4 qa[SEQ / 1024][4];
#pragma unroll
        for (int c = 0; c < SEQ / 1024; ++c)
#pragma unroll
            for (int i = 0; i < 4; ++i) qa[c][i] = *(const f32x4*)(ls + c * 1024 + lane * 16 + 4 * i);
#pragma unroll
        for (int c = 0; c < SEQ / 1024; ++c) {
            f32x4 q[4];
#pragma unroll
            for (int i = 0; i < 4; ++i) q[i] = qa[c][i];
            float run = 0.f;
#pragma unroll
            for (int i = 0; i < 4; ++i) { q[i].x += run; q[i].y += q[i].x; q[i].z += q[i].y; q[i].w += q[i].z; run = q[i].w; }
            float inc = run;
#pragma unroll
            for (int o = 1; o < 64; o <<= 1) { const float t = __builtin_bit_cast(float, __builtin_amdgcn_ds_bpermute(((lane - o) & 63) << 2, __builtin_bit_cast(int, inc))); if (lane >= o) inc += t; }
            const float excl = (inc - run) + carry;
#pragma unroll
            for (int i = 0; i < 4; ++i) *(f32x4*)(cum + c * 1024 + lane * 16 + 4 * i) = q[i] + excl;
            carry += __builtin_bit_cast(float, __builtin_amdgcn_readlane(__builtin_bit_cast(int, inc), 63));
        }
    }
    const bf16* P = (const bf16*)(a.ws + WS_PROJ); float* knt = (float*)(a.ws + WS_KNT);
    for (int t = gw; t < BATCH * NH * (SEQ / 64); t += NGW) {
        const int bh = t / (SEQ / 64), kt = t % (SEQ / 64), b = bh / NH, h = bh % NH; float mx = 0.f;
        const bf16* base = P + (size_t)(b * SEQ + kt * 64) * NPROJ + COL_KB + h * HD + 8 * (lane & 15);
#pragma unroll 4
        for (int it = 0; it < 16; ++it) { const v4u w = *(const v4u*)(base + (size_t)(it * 4 + (lane >> 4)) * NPROJ); float s = 0.f;
#pragma unroll
            for (int e = 0; e < 4; ++e) { const float lo = bf_lo(w[e]), hi = bf_hi(w[e]); s += lo * lo + hi * hi; }
            s += __shfl_xor(s, 1); s += __shfl_xor(s, 2); s += __shfl_xor(s, 4); s += __shfl_xor(s, 8); mx = fmaxf(mx, s); }
        mx = fmaxf(mx, __shfl_xor(mx, 16)); mx = fmaxf(mx, __shfl_xor(mx, 32));
        if (lane == 0) knt[t] = sqrtf(mx);
    }
}
namespace att {
typedef short s16x4 __attribute__((ext_vector_type(4)));
#ifndef B_SKIP
#define B_SKIP 1
#endif
constexpr float SKIP_T = 30.0f;
constexpr int KBUF = 64 * 256, VBUF = 64 * 256;
constexpr int OFF_K = 0, OFF_V = 2 * KBUF, OFF_TAB = 2 * KBUF + 2 * VBUF, OFF_CK = OFF_TAB + 2304, OFF_RED = OFF_CK + 512, LDS_END = OFF_RED + 64;
__device__ __forceinline__ int swz(int row) { return ((row & 3) << 2) | ((row >> 2) & 3); }
static_assert(LDS_END <= RING_BYTES, "attention LDS");

template <int MODE>
__device__ __forceinline__ void attn_unit(CArgs& a, LAS unsigned char* lds, int l, int b, int h, int qb, int tid, int wave, int lane) {
    const bf16* P = (const bf16*)(a.ws + WS_PROJ);
    const int colq = MODE == 0 ? COL_QA : COL_QB, colk = MODE == 0 ? COL_KA : COL_KB, colv = MODE == 0 ? COL_VA : COL_VB;
    const int q = lane & 31, hi = lane >> 5;
    const int qpos = qb * 256 + wave * 32 + q;
    const size_t rowbase = (size_t)b * SEQ;
    const float* cum = (const float*)(a.ws + WS_CUM) + (size_t)(b * NH + h) * SEQ;
    LAS float* tab = (LAS float*)(lds + OFF_TAB);
    LAS float* ckl = (LAS float*)(lds + OFF_CK);

    int kt_first, ntiles, kt_step;
    if (MODE == 0) { kt_first = 4 * qb - 8 < 0 ? 0 : 4 * qb - 8; ntiles = 4 * qb + 3 - kt_first + 1; kt_step = 1; }
    else { kt_first = 4 * qb + 3; ntiles = 4 * qb + 4; kt_step = -1; }
    const int cq = 4 * qb + (wave >> 1);

    if (MODE == 0) { const float* rb = a.in[6] + (size_t)(l * NH + h) * 513; for (int i = tid; i < 513; i += NWAVES * 64) tab[i] = rb[i] * LOG2E; }

    bf16x8 qf[8];
    { const bf16* qp = P + (rowbase + qpos) * NPROJ + colq + h * HD + 8 * hi;
#pragma unroll
        for (int s = 0; s < 8; ++s) qf[s] = *(const bf16x8*)(qp + 16 * s); }
    float cqv = 0.f; if (MODE == 1) cqv = cum[qpos] * LOG2E;
    if (MODE == 1 && B_SKIP) {
        float ss = 0.f;
#pragma unroll
        for (int s = 0; s < 8; ++s) { const bf16x8 qv = qf[s]; const v4u w = __builtin_bit_cast(v4u, qv);
#pragma unroll
            for (int e = 0; e < 4; ++e) { const unsigned ww = w[e]; const float lo = bf_lo(ww), hi2 = bf_hi(ww); ss += lo * lo + hi2 * hi2; } }
        ss += __shfl_xor(ss, 32);
#pragma unroll
        for (int o = 1; o < 32; o <<= 1) ss = fmaxf(ss, __shfl_xor(ss, o));
        LAS float* red = (LAS float*)(lds + OFF_RED);
        if (lane == 0) red[wave] = ss;
        __syncthreads();
        float qn2 = red[0];
#pragma unroll
        for (int w = 1; w < NWAVES; ++w) qn2 = fmaxf(qn2, red[w]);
        const float* knt = (const float*)(a.ws + WS_KNT) + (size_t)(b * NH + h) * (SEQ / 64);
        float kn = fmaxf(knt[lane], knt[lane + 64]);
#pragma unroll
        for (int o = 1; o < 64; o <<= 1) kn = fmaxf(kn, __shfl_xor(kn, o));
        const float kd = fmaxf(fmaxf(knt[4 * qb], knt[4 * qb + 1]), fmaxf(knt[4 * qb + 2], knt[4 * qb + 3]));
        const float qn = sqrtf(qn2), theta = SKIP_T + qn * (kn + kd) * QK_SCALE;
        const float c0 = cum[qb * 256];
        int jskip = -1; bool found = false;
        for (int base = 4 * qb - 1; base >= 0 && !found; base -= 64) {
            const int Jl = base - lane; const bool skip = Jl < 0 ? true : (c0 - cum[64 * Jl + 63] < -theta);
            const unsigned long long bal = __ballot(skip);
            if (bal) { jskip = base - (__ffsll((long long)bal) - 1); found = true; }
        }
        jskip = __builtin_amdgcn_readfirstlane(jskip);
        ntiles = 4 * qb + 3 - jskip;
    }

    f32x16 O[4];
#pragma unroll
    for (int d = 0; d < 4; ++d)
#pragma unroll
        for (int r = 0; r < 16; ++r) O[d][r] = 0.f;
    float mrun = -1e30f, lsum = 0.f;

    float ckreg = 0.f;
    const bf16* kbase = P + rowbase * NPROJ + colk + h * HD;
    const bf16* vbase = P + rowbase * NPROJ + colv + h * HD;
    unsigned goff[2];
#pragma unroll
    for (int j = 0; j < 2; ++j) { const int row = 8 * wave + 4 * j + (lane >> 4); goff[j] = (unsigned)(row * NPROJ + 8 * ((lane & 15) ^ swz(row))); }
#define ATT_LOAD(kt, buf) do { const size_t r0_ = (size_t)(kt) * 64 * NPROJ; \
        _Pragma("unroll") for (int j_ = 0; j_ < 2; ++j_) { \
            __builtin_amdgcn_global_load_lds((const unsigned*)(kbase + r0_ + goff[j_]), (LAS unsigned*)(lds + OFF_K + (buf) * KBUF + 1024 * (2 * wave + j_)), 16, 0, 0); \
            __builtin_amdgcn_global_load_lds((const unsigned*)(vbase + r0_ + goff[j_]), (LAS unsigned*)(lds + OFF_V + (buf) * VBUF + 1024 * (2 * wave + j_)), 16, 0, 0); } \
        if (MODE == 1 && tid < 64) ckreg = cum[(size_t)(kt) * 64 + tid] * LOG2E; } while (0)
#define ATT_STORE(buf) do { if (MODE == 1 && tid < 64) ckl[(buf) * 64 + tid] = ckreg; } while (0)
    unsigned kx[8], vx[4][2];
    { const int sk = swz(q);
#pragma unroll
        for (int s = 0; s < 8; ++s) kx[s] = (unsigned)(256 * q + 16 * ((2 * s + hi) ^ sk));
        const int qq = (lane & 15) >> 2, pp = lane & 3, g1 = (lane >> 4) & 1;
#pragma unroll
        for (int d = 0; d < 4; ++d)
#pragma unroll
            for (int hf = 0; hf < 2; ++hf) { const int row = 8 * hf + 4 * hi + qq; vx[d][hf] = (unsigned)(256 * row + 16 * ((4 * d + 2 * g1 + (pp >> 1)) ^ swz(row)) + 8 * (pp & 1)); } }

    ATT_LOAD(kt_first, 0); ATT_STORE(0);
    __syncthreads();
    for (int it = 0; it < ntiles; ++it) {
        const int kt = kt_first + it * kt_step, buf = it & 1;
        if (it + 1 < ntiles) ATT_LOAD(kt + kt_step, buf ^ 1);
        const bool active = MODE == 0 ? (kt <= cq && kt >= cq - 8) : (kt <= cq);
        if (active) {
            f32x16 p0, p1;
#pragma unroll
            for (int r = 0; r < 16; ++r) { p0[r] = 0.f; p1[r] = 0.f; }
            const LAS unsigned char* kb = lds + OFF_K + buf * KBUF;
#pragma unroll
            for (int s = 0; s < 8; ++s) {
                const bf16x8 k0 = *(const LAS bf16x8*)(kb + kx[s]), k1 = *(const LAS bf16x8*)(kb + kx[s] + 8192);
                p0 = MFMA32(k0, qf[s], p0); p1 = MFMA32(k1, qf[s], p1);
            }
            constexpr float C2 = QK_SCALE * LOG2E;
            const int key0 = kt * 64 + 4 * hi;
            if (MODE == 0) {
                if (cq - kt >= 5) { const float bc = tab[512];
#pragma unroll
                    for (int r = 0; r < 16; ++r) { p0[r] = p0[r] * C2 + bc; p1[r] = p1[r] * C2 + bc; } }
                else { const int d0 = qpos - key0 + 256;
#pragma unroll
                    for (int r = 0; r < 16; ++r) { const int c = (r & 3) + 8 * (r >> 2);
                        int i0 = d0 - c, i1 = d0 - c - 32; i0 = i0 < 0 ? 0 : (i0 > 512 ? 512 : i0); i1 = i1 < 0 ? 0 : (i1 > 512 ? 512 : i1);
                        p0[r] = p0[r] * C2 + tab[i0]; p1[r] = p1[r] * C2 + tab[i1]; } }
            } else {
                const LAS float* ck = ckl + buf * 64 + 4 * hi;
#pragma unroll
                for (int g = 0; g < 4; ++g) { const f32x4 c0 = *(const LAS f32x4*)(ck + 8 * g), c1 = *(const LAS f32x4*)(ck + 32 + 8 * g);
#pragma unroll
                    for (int e = 0; e < 4; ++e) { p0[4 * g + e] = p0[4 * g + e] * C2 + (cqv - c0[e]); p1[4 * g + e] = p1[4 * g + e] * C2 + (cqv - c1[e]); } }
                if (kt == cq) { const float NEG = -__builtin_inff();
#pragma unroll
                    for (int r = 0; r < 16; ++r) { const int key = key0 + (r & 3) + 8 * (r >> 2); if (key > qpos) p0[r] = NEG; if (key + 32 > qpos) p1[r] = NEG; } }
            }
            float mt = p0[0];
#pragma unroll
            for (int r = 1; r < 16; ++r) mt = fmaxf(mt, p0[r]);
#pragma unroll
            for (int r = 0; r < 16; ++r) mt = fmaxf(mt, p1[r]);
            mt = fmaxf(mt, __shfl_xor(mt, 32));
            const float mn = fmaxf(mrun, mt), alpha = __builtin_amdgcn_exp2f(mrun - mn);
            mrun = mn;
            float ps = 0.f;
#pragma unroll
            for (int r = 0; r < 16; ++r) { p0[r] = __builtin_amdgcn_exp2f(p0[r] - mn); p1[r] = __builtin_amdgcn_exp2f(p1[r] - mn); ps += p0[r] + p1[r]; }
            lsum = lsum * alpha + ps;
            if (!__all(alpha == 1.0f)) {
#pragma unroll
                for (int d = 0; d < 4; ++d)
#pragma unroll
                    for (int r = 0; r < 16; ++r) O[d][r] *= alpha;
            }
            bf16x8 pf[4];
            pf[0] = cvt8((f32x8){p0[0], p0[1], p0[2], p0[3], p0[4], p0[5], p0[6], p0[7]});
            pf[1] = cvt8((f32x8){p0[8], p0[9], p0[10], p0[11], p0[12], p0[13], p0[14], p0[15]});
            pf[2] = cvt8((f32x8){p1[0], p1[1], p1[2], p1[3], p1[4], p1[5], p1[6], p1[7]});
            pf[3] = cvt8((f32x8){p1[8], p1[9], p1[10], p1[11], p1[12], p1[13], p1[14], p1[15]});
            const LAS unsigned char* vb = lds + OFF_V + buf * VBUF;
#pragma unroll
            for (int d = 0; d < 4; ++d)
#pragma unroll
                for (int ks = 0; ks < 4; ++ks) {
                    const s16x4 lo = __builtin_amdgcn_ds_read_tr16_b64_v4i16((LAS s16x4*)(vb + vx[d][0] + 4096 * ks)), hh = __builtin_amdgcn_ds_read_tr16_b64_v4i16((LAS s16x4*)(vb + vx[d][1] + 4096 * ks));
                    const bf16x8 vv = {lo[0], lo[1], lo[2], lo[3], hh[0], hh[1], hh[2], hh[3]};
                    O[d] = MFMA32(vv, pf[ks], O[d]);
                }
        }
        if (it + 1 < ntiles) ATT_STORE(buf ^ 1);
        __syncthreads();
    }
#undef ATT_LOAD
#undef ATT_STORE
    const float ltot = lsum + __shfl_xor(lsum, 32), inv = 1.0f / ltot;
    bf16* op = (bf16*)(a.ws + WS_O) + (rowbase + qpos) * D + MODE * 1024 + h * HD + 4 * hi;
#pragma unroll
    for (int d = 0; d < 4; ++d)
#pragma unroll
        for (int g = 0; g < 4; ++g) { const f32x4 v = {O[d][4 * g] * inv, O[d][4 * g + 1] * inv, O[d][4 * g + 2] * inv, O[d][4 * g + 3] * inv};
            *(v2u*)(op + 32 * d + 8 * g) = cvt4(v); }
}
}

namespace s5 {
#ifndef S5_PF
#define S5_PF 8
#endif
constexpr int XROW = 272, XIMG = 32 * XROW, OFF_X = 0, OFF_E = 8 * XIMG, LDS_END = OFF_E + 8 * 64 * 8;
static_assert(LDS_END <= RING_BYTES, "s5 LDS");
struct LamC { float lr, li, cr, ci; };
__device__ __forceinline__ LamC lam_coef(const float* are, const float* aim, float dt, int n) {
    const float ar = fminf(are[n], -1e-4f), ai = aim[n];
    const float zr = ar * dt, zi = ai * dt;
    float sn, cs; sincosf(zi, &sn, &cs);
    const float er = expf(zr);
    LamC o; o.lr = er * cs; o.li = er * sn;
    const float sh = sinf(0.5f * zi);
    const float nr = expm1f(zr) * cs - 2.0f * sh * sh, ni = o.li;
    const float den = 1.0f / (ar * ar + ai * ai);
    o.cr = (nr * ar + ni * ai) * den; o.ci = (ni * ar - nr * ai) * den;
    return o;
}
__device__ __forceinline__ float gelu_tanh(float y) {
    const float z = 0.7978845608028654f * (y + 0.044715f * y * y * y);
    return y * __builtin_amdgcn_rcpf(1.0f + __builtin_amdgcn_exp2f(-2.0f * LOG2E * z));
}
__device__ __forceinline__ void s5_unit(CArgs& a, LAS unsigned char* lds, int l, int b, int g, int wave, int lane) {
    const int c32 = lane & 31, hi = lane >> 5;
    const float* are = a.in[8] + (size_t)(l * NG + g) * NS; const float* aim = a.in[9] + (size_t)(l * NG + g) * NS;
    const float dt = expf(a.in[10][l * NG + g]);
    const LamC me = lam_coef(are, aim, dt, lane);
    bf16x8 bb[4];
#pragma unroll
    for (int st = 0; st < 2; ++st) { const int ns = 32 * st + c32; const LamC cc = lam_coef(are, aim, dt, ns);
        const float* br = a.in[11] + ((size_t)(l * NG + g) * NS + ns) * 16 + 8 * hi; const float* bi = a.in[12] + ((size_t)(l * NG + g) * NS + ns) * 16 + 8 * hi;
        f32x8 vr, vi;
#pragma unroll
        for (int j = 0; j < 8; ++j) { const float xr = br[j], xi = bi[j]; vr[j] = cc.cr * xr - cc.ci * xi; vi[j] = cc.cr * xi + cc.ci * xr; }
        bb[st] = cvt8(vr); bb[2 + st] = cvt8(vi); }
    bf16x8 cf[8];
    { const float msk = c32 < 16 ? 1.f : 0.f; const int ii = c32 & 15;
        const float* cr = a.in[13] + ((size_t)(l * NG + g) * 16 + ii) * NS + 4 * hi; const float* ci = a.in[14] + ((size_t)(l * NG + g) * 16 + ii) * NS + 4 * hi;
#pragma unroll
        for (int s = 0; s < 8; ++s) { const f32x4 r4 = *(const f32x4*)(cr + 8 * s), i4 = *(const f32x4*)(ci + 8 * s);
            cf[s] = cvt8((f32x8){r4.x * msk, -i4.x * msk, r4.y * msk, -i4.y * msk, r4.z * msk, -i4.z * msk, r4.w * msk, -i4.w * msk}); } }
    bf16x8 df;
    { const float dv = c32 < 16 ? a.in[15][(size_t)l * SSMW + g * 16 + (c32 & 15)] : 0.f; f32x8 v;
#pragma unroll
        for (int j = 0; j < 8; ++j) v[j] = (8 * hi + j == c32) ? dv : 0.f;
        df = cvt8(v); }

    const bf16* up = (const bf16*)(a.ws + WS_PROJ) + ((size_t)b * SEQ + wave * 1024 + c32) * NPROJ + COL_U + g * 16 + 8 * hi;
    bf16* yg = (bf16*)(a.ws + WS_YG) + ((size_t)b * SEQ + wave * 1024 + c32) * SSMW + g * 16 + 4 * hi;
    LAS unsigned char* ximg = lds + OFF_X + wave * XIMG;
    LAS float* ebuf = (LAS float*)(lds + OFF_E);

    float xr = 0.f, xi = 0.f;
    for (int pass = 0; pass < 2; ++pass) {
        bf16x8 ub[S5_PF];
#pragma unroll
        for (int i = 0; i < S5_PF; ++i) ub[i] = *(const bf16x8*)(up + (size_t)i * 32 * NPROJ);
        for (int sg = 0; sg < 32 / S5_PF; ++sg)
#pragma unroll
        for (int si = 0; si < S5_PF; ++si) {
            const int sc = sg * S5_PF + si;
            const bf16x8 uf = ub[si];
            if (sg < 32 / S5_PF - 1) ub[si] = *(const bf16x8*)(up + (size_t)(sc + S5_PF) * 32 * NPROJ);
            f32x16 z;
#pragma unroll
            for (int r = 0; r < 16; ++r) z[r] = 0.f;
            f32x16 c0 = MFMA32(uf, bb[0], z), c1 = MFMA32(uf, bb[1], z), c2 = MFMA32(uf, bb[2], z), c3 = MFMA32(uf, bb[3], z);
            f32x16 re0, re1, im0, im1;
#pragma unroll
            for (int r = 0; r < 16; ++r) {
                const float f0 = c0[r], f1 = c1[r], f2 = c2[r], f3 = c3[r];
                const auto s0 = __builtin_amdgcn_permlane32_swap(__float_as_uint(f0), __float_as_uint(f1), false, false);
                const auto s1 = __builtin_amdgcn_permlane32_swap(__float_as_uint(f2), __float_as_uint(f3), false, false);
                const unsigned u00 = s0[0], u01 = s0[1], u10 = s1[0], u11 = s1[1];
                re0[r] = __uint_as_float(u00); re1[r] = __uint_as_float(u01); im0[r] = __uint_as_float(u10); im1[r] = __uint_as_float(u11);
            }
#pragma unroll
            for (int q4 = 0; q4 < 4; ++q4) {
#pragma unroll
                for (int i = 0; i < 4; ++i) { const int r = 4 * q4 + i; const float nr = me.lr * xr - me.li * xi + re0[r], ni = me.lr * xi + me.li * xr + im0[r]; xr = nr; xi = ni; re0[r] = nr; im0[r] = ni; }
#pragma unroll
                for (int i = 0; i < 4; ++i) { const int r = 4 * q4 + i; const float nr = me.lr * xr - me.li * xi + re1[r], ni = me.lr * xi + me.li * xr + im1[r]; xr = nr; xi = ni; re1[r] = nr; im1[r] = ni; }
            }
            if (pass == 1) {
#pragma unroll
                for (int r = 0; r < 16; ++r) {
                    *(LAS unsigned*)(ximg + crow(r, 0) * XROW + 4 * lane) = cvt2(re0[r], im0[r]);
                    *(LAS unsigned*)(ximg + crow(r, 1) * XROW + 4 * lane) = cvt2(re1[r], im1[r]);
                }
                f32x16 y;
#pragma unroll
                for (int r = 0; r < 16; ++r) y[r] = 0.f;
#pragma unroll
                for (int s = 0; s < 8; ++s) { const bf16x8 xf = *(const LAS bf16x8*)(ximg + c32 * XROW + 32 * s + 16 * hi); y = MFMA32(cf[s], xf, y); }
                y = MFMA32(df, uf, y);
                bf16* yo = yg + (size_t)sc * 32 * SSMW;
                *(v2u*)yo = cvt4((f32x4){gelu_tanh(y[0]), gelu_tanh(y[1]), gelu_tanh(y[2]), gelu_tanh(y[3])});
                *(v2u*)(yo + 8) = cvt4((f32x4){gelu_tanh(y[4]), gelu_tanh(y[5]), gelu_tanh(y[6]), gelu_tanh(y[7])});
            }
        }
        if (pass == 0) {
            ebuf[(wave * 64 + lane) * 2] = xr; ebuf[(wave * 64 + lane) * 2 + 1] = xi;
            __syncthreads();
            float pr = me.lr, pi = me.li;
#pragma unroll
            for (int i = 0; i < 10; ++i) { const float nr = pr * pr - pi * pi, ni = 2.f * pr * pi; pr = nr; pi = ni; }
            xr = 0.f; xi = 0.f;
            for (int w2 = 0; w2 < wave; ++w2) { const float er = ebuf[(w2 * 64 + lane) * 2], ei = ebuf[(w2 * 64 + lane) * 2 + 1];
                const float nr = pr * xr - pi * xi + er, ni = pr * xi + pi * xr + ei; xr = nr; xi = ni; }
        }
    }
    __syncthreads();
}
}
#define argp() (*({ CArgs* p_ = (CArgs*)__builtin_amdgcn_kernarg_segment_ptr(); asm volatile("" : "+s"(p_)); p_; }))
#define tidp() ({ int t_ = (wave << 6) + (int)__builtin_amdgcn_mbcnt_hi(~0u, __builtin_amdgcn_mbcnt_lo(~0u, 0u)); asm volatile("" : "+v"(t_)); t_; })
#define GRID_BAR() do { XcdBarrier b_ = bar; asm volatile("" : "+s"(b_.bar), "+s"(b_.x)); xcd_barrier(b_, tidp()); } while (0)
#define GEMM_PHASE(EPI, g, S, E) pg8::gemm_phase<EPI, pg8::StaticOrder, PG8_ALIGN, PG8_SP2>(lds + RING_OFF, g, S, E, tidp())

__global__ void __launch_bounds__(NWAVES * 64, 2) hybrid_fwd(Args args) {
    extern __shared__ __attribute__((aligned(16))) unsigned char lds_raw[];
    LAS unsigned char* lds = (LAS unsigned char*)lds_raw;
    const int wave = __builtin_amdgcn_readfirstlane((int)threadIdx.x >> 6);
    const int G = gridDim.x, bx = blockIdx.x;
    const int vcu = (G % 8 == 0) ? (bx % 8) * (G / 8) + bx / 8 : bx;
    const int gw = vcu * NWAVES + wave, NGW = G * NWAVES;
    for (int u = threadIdx.x; u < (LDS_BYTES - LDSCTL_OFF) / 4; u += NWAVES * 64) ((LAS unsigned*)(lds + LDSCTL_OFF))[u] = 0u;
    __syncthreads();
    volatile LAS unsigned* MISC = (volatile LAS unsigned*)(lds + MISC_OFF);
    XcdBarrier bar = xcd_barrier_post((unsigned*)(argp().ws + WS_CTL) + CW_BAR, MISC + 8);

    p0_weights(argp(), lds, gw, NGW, wave, tidp() & 63);
    __syncthreads();
    { const int t = tidp(); phase_norm0(argp(), lds, gw, NGW, t, t & 63); }
    GRID_BAR();

    for (int l = 0; l < LAYERS; ++l) {
        { unsigned char* ws = argp().ws; unsigned char* wl = ws + WS_W + (size_t)l * W_LAYER;
          pg8::Gemm g{(const pg8::bf16_t*)(ws + WS_X16), (const pg8::bf16_t*)(wl + W_IN), M, NPROJ, D}; pg8::StaticOrder S; S.init(M, NPROJ, G, bx);
          pg8::EpiStoreBf16 E{(pg8::bf16_t*)(ws + WS_PROJ), NPROJ, (const float*)(ws + WS_RS)};
          GEMM_PHASE(pg8::EpiStoreBf16, g, S, E); }
        GRID_BAR();
        phase_cum_knorm(argp(), gw, NGW, tidp() & 63);
        for (int u = vcu; u < BATCH * NG; u += G) s5::s5_unit(argp(), lds, l, u >> 7, u & 127, wave, tidp() & 63);
        for (int u = vcu; u < 256; u += G) { const int bh = u >> 4, x = u & 15;
            for (int k = 0; k < 2; ++k) { const int t = tidp(); att::attn_unit<0>(argp(), lds, l, bh >> 3, bh & 7, k ? x + 16 : x, t, wave, t & 63); } }
        GRID_BAR();
        for (int u = vcu; u < 256; u += G) { const int bh = u >> 4, x = u & 15;
            for (int k = 0; k < 2; ++k) { const int t = tidp(); att::attn_unit<1>(argp(), lds, l, bh >> 3, bh & 7, k ? 31 - x : x, t, wave, t & 63); } }
        GRID_BAR();
        { CArgs& A_ = argp(); unsigned char* ws = A_.ws; unsigned char* wl = ws + WS_W + (size_t)l * W_LAYER;
          pg8::Gemm g{(const pg8::bf16_t*)(ws + WS_YG), (const pg8::bf16_t*)(wl + W_GLU), M, SSMW, SSMW}; pg8::StaticOrder S; S.init(M, SSMW, G, bx);
          pg8::EpiGlu E{(const pg8::bf16_t*)(ws + WS_YG), SSMW, (pg8::bf16_t*)(ws + WS_O) + 2048, D, A_.in[17] + (size_t)l * SSMW};
          GEMM_PHASE(pg8::EpiGlu, g, S, E); }
        GRID_BAR();
        phase_mixnorm(argp(), gw, NGW, tidp() & 63);
        GRID_BAR();
        { unsigned char* ws = argp().ws; unsigned char* wl = ws + WS_W + (size_t)l * W_LAYER;
          pg8::Gemm g{(const pg8::bf16_t*)(ws + WS_O), (const pg8::bf16_t*)(wl + W_OUT), M, D, D}; pg8::StaticOrder S; S.init(M, D, G, bx);
          pg8::EpiStoreBf16 E{(pg8::bf16_t*)(ws + WS_Y16), D, nullptr};
          GEMM_PHASE(pg8::EpiStoreBf16, g, S, E); }
        GRID_BAR();
        { CArgs& A_ = argp(); phase_post<false, false, false>(A_, lds, A_.in[4] + (size_t)l * D, 0, gw, NGW, tidp(), tidp() & 63); }
        GRID_BAR();
        { unsigned char* ws = argp().ws; unsigned char* wl = ws + WS_W + (size_t)l * W_LAYER;
          pg8::Gemm g{(const pg8::bf16_t*)(ws + WS_X16), (const pg8::bf16_t*)(wl + W_GU), M, NGU, D}; pg8::StaticOrder S; S.init(M, NGU, G, bx);
          pg8::EpiSwiGlu E{(pg8::bf16_t*)(ws + WS_ACT), DFF, (const float*)(ws + WS_RS)};
          GEMM_PHASE(pg8::EpiSwiGlu, g, S, E); }
        GRID_BAR();
        { unsigned char* ws = argp().ws; unsigned char* wl = ws + WS_W + (size_t)l * W_LAYER;
          pg8::Gemm g{(const pg8::bf16_t*)(ws + WS_ACT), (const pg8::bf16_t*)(wl + W_D), M, D, DFF}; pg8::StaticOrder S; S.init(M, D, G, bx);
          pg8::EpiStoreBf16 E{(pg8::bf16_t*)(ws + WS_Y16), D, nullptr};
          GEMM_PHASE(pg8::EpiStoreBf16, g, S, E); }
        GRID_BAR();
        if (l + 1 < LAYERS) { CArgs& A_ = argp(); phase_post<false, false, true>(A_, lds, A_.in[19] + (size_t)l * D, l + 1, gw, NGW, tidp(), tidp() & 63); GRID_BAR(); }
        else { CArgs& A_ = argp(); phase_post<false, true, false>(A_, lds, A_.in[19] + (size_t)l * D, 0, gw, NGW, tidp(), tidp() & 63); }
    }
}

extern "C" void kernel_launch(void* const* d_in, const int* in_sizes, int n_in, void* d_out, int out_size, void* d_ws, size_t ws_size, hipStream_t stream) {
    static int grid = 0;
    if (grid == 0) {
        if (n_in != 23 || in_sizes[0] != M * D || out_size != M * D || ws_size < WS_END) {
            fprintf(stderr, "kernel_launch: unexpected shapes: n_in %d in0 %d out %d ws %zu (need %zu)\n", n_in, n_in > 0 ? in_sizes[0] : -1, out_size, ws_size, (size_t)WS_END); grid = -1; return; }
        int dev = 0, cus = 0, per_cu = 0;
        if (hipGetDevice(&dev) != hipSuccess || hipDeviceGetAttribute(&cus, hipDeviceAttributeMultiprocessorCount, dev) != hipSuccess) { grid = -1; return; }
        if (hipFuncSetAttribute((const void*)hybrid_fwd, hipFuncAttributeMaxDynamicSharedMemorySize, LDS_BYTES) != hipSuccess) { fprintf(stderr, "kernel_launch: hipFuncSetAttribute failed\n"); grid = -1; return; }
        if (hipOccupancyMaxActiveBlocksPerMultiprocessor(&per_cu, (const void*)hybrid_fwd, NWAVES * 64, LDS_BYTES) != hipSuccess || per_cu < 1)
            fprintf(stderr, "kernel_launch: occupancy query reports %d workgroups per CU\n", per_cu);
        (void)hipGetLastError();
        grid = cus;
    }
    if (grid < 0) return;
    if (hipMemsetAsync((char*)d_ws + WS_CTL, 0, CTL_ZERO_BYTES, stream) != hipSuccess) return;
    Args a{};
    for (int i = 0; i < 23; ++i) a.in[i] = (const float*)d_in[i];
    a.out = (float*)d_out; a.ws = (unsigned char*)d_ws;
    hipLaunchKernelGGL(hybrid_fwd, dim3(grid), dim3(NWAVES * 64), LDS_BYTES, stream, a);
    const hipError_t le = hipPeekAtLastError();
    if (le != hipSuccess) fprintf(stderr, "kernel_launch: launch failed: %s\n", hipGetErrorName(le));
}
```

```cpp
#include <hip/hip_runtime.h>
#include <cstdio>
#include <cstdint>
#ifndef PS_C
#define PS_C 1
#endif
#ifndef PS_AB
#define PS_AB 1
#endif
namespace pg8 {
#define PG8_LAS __attribute__((address_space(3)))
typedef unsigned short bf16_t;
typedef short bf16x8 __attribute__((ext_vector_type(8)));
typedef float f32x4 __attribute__((ext_vector_type(4)));
typedef unsigned u32x4 __attribute__((ext_vector_type(4)));
constexpr int BM = 256, BK = 64, HALF = 128, HTB = HALF * BK * 2  , STAGE_BYTES = 8 * HTB, NXCD = 8, WGM = 8;

__host__ __device__ __forceinline__ int lds_byte(int r, int c) { const int st = (r >> 4) * 2 + (c >> 5), rr = r & 15, cc = c & 31, ob = rr * 64 + cc * 2; return st * 1024 + (ob ^ (((ob >> 9) & 1) << 5)); }
__host__ __device__ __forceinline__ void stage_rc(int b, int& R, int& C) { const int st = b / 1024, sb = b % 1024, swz = sb ^ (((sb >> 9) & 1) << 5); R = (st >> 1) * 16 + swz / 64; C = (st & 1) * 32 + (swz % 64) / 2; }
__host__ __device__ __forceinline__ int perm32(int rho) { const int n = rho >> 4, i = rho & 15; return 8 * (i >> 2) + 4 * n + (i & 3); }

struct Unit { int pm, pn; };
struct Gemm { const bf16_t* A; const bf16_t* Bt; int M, N, K; };

struct StaticOrder {
    int nM, nN, nwg, G, c;
    __host__ __device__ void init(int M, int N, int G_, int c_) { nM = M / BM; nN = N / BM; nwg = nM * nN; G = G_; c = c_; }
    __host__ __device__ bool next(int i, Unit& u) const {
        const long L = (long)i * G + c; if (L >= nwg) return false;
        int wgid = (int)L; { const int q = nwg / NXCD, r = nwg % NXCD, xcd = wgid % NXCD, off = wgid / NXCD; wgid = (xcd < r ? xcd * (q + 1) : r * (q + 1) + (xcd - r) * q) + off; }
        const int nig = WGM * nN, gid = wgid / nig, fm = gid * WGM, gsz = (nM - fm) < WGM ? (nM - fm) : WGM;
        u.pm = fm + ((wgid % nig) % gsz); u.pn = (wgid % nig) / gsz; return true;
    }
    __device__ __forceinline__ void a_ready(const Unit&) const {}
    __device__ __forceinline__ void done(const Unit&) const {}
};

__device__ __forceinline__ unsigned cvt_pk_bf16(float lo, float hi) { unsigned r; asm volatile("v_cvt_pk_bf16_f32 %0, %1, %2" : "=v"(r) : "v"(lo), "v"(hi)); return r; }
typedef unsigned u32x2 __attribute__((ext_vector_type(2)));
__device__ __forceinline__ float sigm(float z) { return __builtin_amdgcn_rcpf(1.0f + __builtin_amdgcn_exp2f(-1.4426950408889634f * z)); }
__device__ __forceinline__ float bflo(unsigned w) { return __builtin_bit_cast(float, w << 16); }
__device__ __forceinline__ float bfhi(unsigned w) { return __builtin_bit_cast(float, w & 0xffff0000u); }
struct EpiStoreBf16 {
    static constexpr bool PERM = true, AFTER_DRAIN = false;
    bf16_t* O; int ldc; const float* rs;
    const PG8_LAS float* rsl = nullptr;
    __device__ __forceinline__ void operator()(const f32x4 (&acc)[2][2][4][2], const Unit& u, int wr, int wc, int fr, int fq) const {
        const int row0 = u.pm * BM + wr * 64 + fr, col0 = u.pn * BM + wc * 32 + 8 * fq;
#pragma unroll
        for (int ai = 0; ai < 2; ++ai)
#pragma unroll
            for (int m = 0; m < 4; ++m) { bf16_t* rowp = O + (size_t)(row0 + ai * HALF + m * 16) * ldc + col0; const float sc = rsl ? rsl[(wr * 64 + fr + ai * HALF + m * 16) * 3 + 2] : (rs ? rs[row0 + ai * HALF + m * 16] : 1.0f);
#pragma unroll
                for (int bj = 0; bj < 2; ++bj) { const f32x4 v0 = acc[ai][bj][m][0] * sc, v1 = acc[ai][bj][m][1] * sc;
                    u32x4 w; w.x = cvt_pk_bf16(v0[0], v0[1]); w.y = cvt_pk_bf16(v0[2], v0[3]); w.z = cvt_pk_bf16(v1[0], v1[1]); w.w = cvt_pk_bf16(v1[2], v1[3]);
                    *(u32x4*)(rowp + bj * HALF) = w; } }
    }
};
struct EpiStoreF32 {
    static constexpr bool PERM = false, AFTER_DRAIN = false;
    float* C; int ldc;
    __device__ __forceinline__ void operator()(const f32x4 (&acc)[2][2][4][2], const Unit& u, int wr, int wc, int fr, int fq) const {
        const int row0 = u.pm * BM + wr * 64 + fr, col0 = u.pn * BM + wc * 32 + 4 * fq;
#pragma unroll
        for (int ai = 0; ai < 2; ++ai)
#pragma unroll
            for (int m = 0; m < 4; ++m) { float* rowp = C + (size_t)(row0 + ai * HALF + m * 16) * ldc + col0;
#pragma unroll
                for (int bj = 0; bj < 2; ++bj)
#pragma unroll
                    for (int n = 0; n < 2; ++n) *(f32x4*)(rowp + bj * HALF + n * 16) = acc[ai][bj][m][n]; }
    }
};
struct EpiGlu {
    static constexpr bool PERM = true, AFTER_DRAIN = false;
    const bf16_t* Y; int ldy; bf16_t* O; int ldo; const float* bias; float* ps; int g_M;
    __device__ __forceinline__ void operator()(const f32x4 (&acc)[2][2][4][2], const Unit& u, int wr, int wc, int fr, int fq) const {
        const int row0 = u.pm * BM + wr * 64 + fr, col0 = u.pn * BM + wc * 32 + 8 * fq;
        f32x4 bv[2][2];
#pragma unroll
        for (int bj = 0; bj < 2; ++bj)
#pragma unroll
            for (int n = 0; n < 2; ++n) bv[bj][n] = *(const f32x4*)(bias + col0 + bj * HALF + 4 * n);
#pragma unroll
        for (int ai = 0; ai < 2; ++ai)
#pragma unroll
            for (int m = 0; m < 4; ++m) { const size_t r = (size_t)(row0 + ai * HALF + m * 16); float ss = 0.f;
#pragma unroll
                for (int bj = 0; bj < 2; ++bj) { const u32x4 yv = *(const u32x4*)(Y + r * ldy + col0 + bj * HALF);
                    const f32x4 z0 = acc[ai][bj][m][0] + bv[bj][0], z1 = acc[ai][bj][m][1] + bv[bj][1];
                    const float o0 = bflo(yv.x) * sigm(z0[0]), o1 = bfhi(yv.x) * sigm(z0[1]), o2 = bflo(yv.y) * sigm(z0[2]), o3 = bfhi(yv.y) * sigm(z0[3]);
                    const float o4 = bflo(yv.z) * sigm(z1[0]), o5 = bfhi(yv.z) * sigm(z1[1]), o6 = bflo(yv.w) * sigm(z1[2]), o7 = bfhi(yv.w) * sigm(z1[3]);
                    ss += ((o0 * o0 + o1 * o1) + (o2 * o2 + o3 * o3)) + ((o4 * o4 + o5 * o5) + (o6 * o6 + o7 * o7));
                    u32x4 w; w.x = cvt_pk_bf16(o0, o1); w.y = cvt_pk_bf16(o2, o3); w.z = cvt_pk_bf16(o4, o5); w.w = cvt_pk_bf16(o6, o7);
                    *(u32x4*)(O + r * ldo + col0 + bj * HALF) = w; }
                ps[((size_t)u.pn * g_M + r) * 16 + wc * 4 + fq] = ss; }
    }
};
struct EpiSwiGlu {
    static constexpr bool PERM = true, AFTER_DRAIN = false;
    bf16_t* O; int ldc; const float* rs;
    __device__ __forceinline__ void operator()(const f32x4 (&acc)[2][2][4][2], const Unit& u, int wr, int wc, int fr, int fq) const {
        const int row0 = u.pm * BM + wr * 64 + fr, col0 = u.pn * HALF + wc * 32 + 8 * fq;
#pragma unroll
        for (int ai = 0; ai < 2; ++ai)
#pragma unroll
            for (int m = 0; m < 4; ++m) { bf16_t* rowp = O + (size_t)(row0 + ai * HALF + m * 16) * ldc + col0; const float sc = rs[row0 + ai * HALF + m * 16];
                const f32x4 g0 = acc[ai][0][m][0] * sc, g1 = acc[ai][0][m][1] * sc, u0 = acc[ai][1][m][0] * sc, u1 = acc[ai][1][m][1] * sc;
                u32x4 w;
                w.x = cvt_pk_bf16(g0[0] * sigm(g0[0]) * u0[0], g0[1] * sigm(g0[1]) * u0[1]); w.y = cvt_pk_bf16(g0[2] * sigm(g0[2]) * u0[2], g0[3] * sigm(g0[3]) * u0[3]);
                w.z = cvt_pk_bf16(g1[0] * sigm(g1[0]) * u1[0], g1[1] * sigm(g1[1]) * u1[1]); w.w = cvt_pk_bf16(g1[2] * sigm(g1[2]) * u1[2], g1[3] * sigm(g1[3]) * u1[3]);
                *(u32x4*)rowp = w; }
    }
};
template <class Epi, class Sched, bool ALIGN_EPI = false, bool SP2 = false, bool SEG = false>
__device__ __forceinline__ void gemm_phase(PG8_LAS unsigned char* lds, const Gemm g, const Sched& S, const Epi& E, const int tid, const PG8_LAS float* seg = nullptr) {
    const int wid = __builtin_amdgcn_readfirstlane(tid >> 6), lane = tid & 63, wr = wid >> 2, wc = wid & 3, fr = lane & 15, fq = lane >> 4;
    const int K = g.K, nt = K / BK;
    unsigned voffA[2], voffB[2];
#pragma unroll
    for (int i = 0; i < 2; ++i) { int R, C; stage_rc(tid * 16 + i * 8192, R, C); const int Rb = Epi::PERM ? ((R & ~31) + perm32(R & 31)) : R;
        voffA[i] = (unsigned)(R * K + C) * 2u; voffB[i] = (unsigned)(Rb * K + C) * 2u; }
    const size_t kstep = (size_t)(BK * 2);
    const size_t hstep = (size_t)HALF * K * 2;
    const size_t tstep = 2 * hstep;
    const unsigned ldsw = (unsigned)wid * 1024u;
    const int aoff = lds_byte(wr * 64 + fr, fq * 8), boff = lds_byte(wc * 32 + fr, fq * 8);
#define PG8_SA(b, h) (((b) * 2 + (h)) * HTB)
#define PG8_SB(b, h) ((4 + (b) * 2 + (h)) * HTB)
#define PG8_STAGE(bufoff, gbase, voff) do { _Pragma("unroll") for (int _i = 0; _i < 2; ++_i) \
        __builtin_amdgcn_global_load_lds((const unsigned*)((const char*)(gbase) + (voff)[_i]), (PG8_LAS unsigned*)(lds + (bufoff) + ldsw + _i * 8192), 16, 0, 0); } while (0)
#define PG8_LDA(dst, b, h) do { _Pragma("unroll") for (int m = 0; m < 4; ++m) _Pragma("unroll") for (int k = 0; k < 2; ++k) dst[m][k] = *(const PG8_LAS bf16x8*)(lds + PG8_SA(b, h) + aoff + m * 2048 + k * 1024); } while (0)
#define PG8_LDB(dst, b, h) do { _Pragma("unroll") for (int n = 0; n < 2; ++n) _Pragma("unroll") for (int k = 0; k < 2; ++k) dst[n][k] = *(const PG8_LAS bf16x8*)(lds + PG8_SB(b, h) + boff + n * 2048 + k * 1024); } while (0)
#define PG8_MMA(ai, bj, At, Bt) do { __builtin_amdgcn_s_setprio(1); _Pragma("unroll") for (int m = 0; m < 4; ++m) _Pragma("unroll") for (int n = 0; n < 2; ++n) _Pragma("unroll") for (int k = 0; k < 2; ++k) \
        acc[ai][bj][m][n] = __builtin_amdgcn_mfma_f32_16x16x32_bf16(Bt[n][k], At[m][k], acc[ai][bj][m][n], 0, 0, 0); __builtin_amdgcn_s_setprio(0); } while (0)
#define PG8_WAIT_V(n) asm volatile("s_waitcnt vmcnt(" #n ")" ::: "memory")
#define PG8_WAIT_L(n) asm volatile("s_waitcnt lgkmcnt(" #n ")" ::: "memory")
#define PG8_BAR __builtin_amdgcn_s_barrier()
#define PG8_SCHED __builtin_amdgcn_sched_barrier(0)
    Unit cur, nxt; int ui = 0;
    if (!S.next(0, cur)) return;
    f32x4 acc[2][2][4][2];
#pragma unroll
    for (int a = 0; a < 2; ++a)
#pragma unroll
        for (int b = 0; b < 2; ++b)
#pragma unroll
            for (int m = 0; m < 4; ++m)
#pragma unroll
                for (int n = 0; n < 2; ++n) acc[a][b][m][n] = (f32x4){0.f, 0.f, 0.f, 0.f};
    bf16x8 At[4][2], B0[2][2], B1[2][2];
    const char* cA = (const char*)g.A + (size_t)cur.pm * tstep; const char* cB = (const char*)g.Bt + (size_t)cur.pn * tstep;
    S.a_ready(cur);
    if constexpr (SP2) {
        PG8_STAGE(PG8_SB(0, 0), cB, voffB); PG8_STAGE(PG8_SB(0, 1), cB + hstep, voffB); PG8_STAGE(PG8_SA(0, 0), cA, voffA); PG8_STAGE(PG8_SA(0, 1), cA + hstep, voffA);
        if (wr == 1) PG8_BAR;
        PG8_WAIT_V(2); PG8_BAR;
        PG8_STAGE(PG8_SB(1, 0), cB + kstep, voffB); PG8_STAGE(PG8_SA(1, 0), cA + kstep, voffA); PG8_STAGE(PG8_SB(1, 1), cB + hstep + kstep, voffB);
        PG8_WAIT_V(6); PG8_BAR;
    } else {
        PG8_STAGE(PG8_SB(0, 0), cB, voffB); PG8_STAGE(PG8_SA(0, 0), cA, voffA); PG8_STAGE(PG8_SB(0, 1), cB + hstep, voffB); PG8_STAGE(PG8_SA(0, 1), cA + hstep, voffA);
        if (wr == 1) PG8_BAR;
        PG8_WAIT_V(4); PG8_BAR;
        PG8_STAGE(PG8_SB(1, 0), cB + kstep, voffB); PG8_STAGE(PG8_SA(1, 0), cA + kstep, voffA); PG8_STAGE(PG8_SB(1, 1), cB + hstep + kstep, voffB);
        PG8_WAIT_V(6); PG8_BAR;
    }
    for (;;) {
        const bool has_next = S.next(ui + 1, nxt);
        const char* nA = has_next ? (const char*)g.A + (size_t)nxt.pm * tstep : cA; const char* nB = has_next ? (const char*)g.Bt + (size_t)nxt.pn * tstep : cB;
        for (int t = 0; t < nt; t += 2) {
            if (SEG && (t == 16 || t == 32)) {
                const int which = t == 16 ? 0 : 1;
#pragma unroll
                for (int ai = 0; ai < 2; ++ai)
#pragma unroll
                    for (int m = 0; m < 4; ++m) { const float f = seg[(ai * HALF + wr * 64 + m * 16 + fr) * 3 + which];
#pragma unroll
                        for (int bj = 0; bj < 2; ++bj)
#pragma unroll
                            for (int n = 0; n < 2; ++n) acc[ai][bj][m][n] *= f; }
            }
            const bool last = (t == nt - 2);
            const char* a1 = cA + (size_t)(t + 1) * kstep;
            const char* a2 = last ? nA : cA + (size_t)(t + 2) * kstep; const char* b2 = last ? nB : cB + (size_t)(t + 2) * kstep;
            const char* a3 = a2 + kstep; const char* b3 = b2 + kstep;
            if (last && has_next) S.a_ready(nxt);
            if constexpr (SP2) {
            PG8_LDB(B0, 0, 0); PG8_LDB(B1, 0, 1); PG8_SCHED; PG8_LDA(At, 0, 0); PG8_STAGE(PG8_SA(1, 1), a1 + hstep, voffA);
            PG8_WAIT_V(8); PG8_WAIT_L(0); PG8_BAR; PG8_MMA(0, 0, At, B0); PG8_MMA(0, 1, At, B1); PG8_BAR; PG8_SCHED;
            PG8_LDA(At, 0, 1); PG8_STAGE(PG8_SB(0, 0), b2, voffB); PG8_STAGE(PG8_SB(0, 1), b2 + hstep, voffB); PG8_STAGE(PG8_SA(0, 0), a2, voffA);
            PG8_WAIT_V(8); PG8_WAIT_L(0); PG8_BAR; PG8_MMA(1, 0, At, B0); PG8_MMA(1, 1, At, B1); PG8_BAR; PG8_SCHED;
            PG8_LDB(B0, 1, 0); PG8_LDB(B1, 1, 1); PG8_SCHED; PG8_LDA(At, 1, 0); PG8_STAGE(PG8_SA(0, 1), a2 + hstep, voffA);
            PG8_WAIT_V(8); PG8_WAIT_L(0); PG8_BAR; PG8_MMA(0, 0, At, B0); PG8_MMA(0, 1, At, B1); PG8_BAR; PG8_SCHED;
            PG8_LDA(At, 1, 1); PG8_STAGE(PG8_SB(1, 0), b3, voffB); PG8_STAGE(PG8_SB(1, 1), b3 + hstep, voffB); PG8_STAGE(PG8_SA(1, 0), a3, voffA);
            PG8_WAIT_V(8); PG8_WAIT_L(0); PG8_BAR; PG8_MMA(1, 0, At, B0); PG8_MMA(1, 1, At, B1); PG8_BAR; PG8_SCHED;
            } else {
            PG8_LDB(B0, 0, 0); PG8_SCHED; PG8_LDA(At, 0, 0); PG8_STAGE(PG8_SA(1, 1), a1 + hstep, voffA);
            PG8_WAIT_L(8); PG8_BAR; PG8_WAIT_L(0); PG8_MMA(0, 0, At, B0); PG8_BAR; PG8_SCHED;
            PG8_LDB(B1, 0, 1); PG8_STAGE(PG8_SB(0, 0), b2, voffB);
            PG8_BAR; PG8_WAIT_L(0); PG8_MMA(0, 1, At, B1); PG8_BAR;
            PG8_LDA(At, 0, 1); PG8_STAGE(PG8_SA(0, 0), a2, voffA);
            PG8_BAR; PG8_WAIT_L(0); PG8_MMA(1, 0, At, B0); PG8_BAR; PG8_SCHED;
            PG8_STAGE(PG8_SB(0, 1), b2 + hstep, voffB);
            PG8_WAIT_V(6); PG8_BAR; PG8_MMA(1, 1, At, B1); PG8_BAR;
            PG8_LDB(B0, 1, 0); PG8_SCHED; PG8_LDA(At, 1, 0); PG8_STAGE(PG8_SA(0, 1), a2 + hstep, voffA);
            PG8_WAIT_L(8); PG8_BAR; PG8_WAIT_L(0); PG8_MMA(0, 0, At, B0); PG8_BAR; PG8_SCHED;
            PG8_LDB(B1, 1, 1); PG8_STAGE(PG8_SB(1, 0), b3, voffB);
            PG8_BAR; PG8_WAIT_L(0); PG8_MMA(0, 1, At, B1); PG8_BAR;
            PG8_LDA(At, 1, 1); PG8_STAGE(PG8_SA(1, 0), a3, voffA);
            PG8_BAR; PG8_WAIT_L(0); PG8_MMA(1, 0, At, B0); PG8_BAR; PG8_SCHED;
            PG8_STAGE(PG8_SB(1, 1), b3 + hstep, voffB);
            PG8_WAIT_V(6); PG8_BAR; PG8_MMA(1, 1, At, B1); PG8_BAR;
            }
        }
        if constexpr (ALIGN_EPI) { if (wr == 0) PG8_BAR; }
        if constexpr (!Epi::AFTER_DRAIN) { E(acc, cur, wr, wc, fr, fq); S.done(cur); }
        if (!has_next) break;
#pragma unroll
        for (int a = 0; a < 2; ++a)
#pragma unroll
            for (int b = 0; b < 2; ++b)
#pragma unroll
                for (int m = 0; m < 4; ++m)
#pragma unroll
                    for (int n = 0; n < 2; ++n) acc[a][b][m][n] = (f32x4){0.f, 0.f, 0.f, 0.f};
        cur = nxt; cA = nA; cB = nB; ++ui;
        if constexpr (ALIGN_EPI) { if (wr == 1) PG8_BAR; }
    }
    PG8_WAIT_V(0);
    if constexpr (!ALIGN_EPI) { if (wr == 0) PG8_BAR; }
    PG8_BAR;
    if constexpr (Epi::AFTER_DRAIN) { E.fused(acc, cur, wr, wc, fr, fq, lds, wid, lane); S.done(cur); }
#undef PG8_SA
#undef PG8_SB
#undef PG8_STAGE
#undef PG8_LDA
#undef PG8_LDB
#undef PG8_MMA
#undef PG8_WAIT_V
#undef PG8_WAIT_L
#undef PG8_BAR
#undef PG8_SCHED
}
}
#ifndef PG8_SP2
#define PG8_SP2 true
#endif
#ifndef PG8_ALIGN
#define PG8_ALIGN true
#endif

constexpr int NWAVES = 8;
constexpr int BATCH = 2, SEQ = 8192, M = BATCH * SEQ, D = 4096, INCOLS = 8200, NPROJ = 8192, DFF = 11008, NGU = 2 * DFF;
constexpr int HD = 128, NH = 8, SSMW = 2048, NG = 128, NS = 64, LAYERS = 2;
constexpr int COL_QA = 0, COL_KA = 1024, COL_VA = 2048, COL_QB = 3072, COL_KB = 4096, COL_VB = 5120, COL_U = 6144;
constexpr float RMS_EPS = 1e-6f;
constexpr float LOG2E = 1.4426950408889634f;
constexpr float QK_SCALE = 0.08838834764831845f;

constexpr size_t MiB = 1u << 20;
constexpr size_t WS_CTL = 0, CTL_ZERO_BYTES = 1 * MiB;
constexpr size_t WS_LS = 3 * MiB;
constexpr size_t WS_CUM = 4 * MiB;
constexpr size_t WS_RS = 6 * MiB;
constexpr size_t WS_PSA = 7 * MiB, WS_PSB = 7 * MiB + 512 * 1024, WS_PSC = 8 * MiB;
constexpr size_t WS_KNT = 5 * MiB;
constexpr size_t WS_W = 16 * MiB;
constexpr size_t W_IN = 0, W_GLU = 64 * MiB, W_OUT = 72 * MiB, W_GU = 104 * MiB, W_D = 276 * MiB, W_LAYER = 362 * MiB;
constexpr size_t WS_X16 = WS_W + 2 * W_LAYER;
constexpr size_t WS_PROJ = WS_X16 + 128 * MiB;
constexpr size_t WS_YG = WS_PROJ + 256 * MiB;
constexpr size_t WS_O = WS_YG + 64 * MiB;
constexpr size_t WS_Y16 = WS_O + 128 * MiB;
constexpr size_t WS_ACT = WS_PROJ;
constexpr size_t WS_END = WS_Y16 + 256 * MiB;
static_assert(WS_ACT + (size_t)M * DFF * 2 <= WS_Y16, "ACT overlay");
constexpr int CW_TMO = 0, CW_BAR = 4096;

constexpr int RING_OFF = 0, RING_BYTES = 131072;
constexpr int LDSCTL_OFF = RING_BYTES, MISC_OFF = LDSCTL_OFF + 320;
constexpr int LDS_BYTES = 147456;

#define GAS __attribute__((address_space(1)))
#define LAS __attribute__((address_space(3)))
typedef unsigned short bf16;
typedef unsigned v4u __attribute__((ext_vector_type(4)));
typedef unsigned v2u __attribute__((ext_vector_type(2)));
typedef float f32x4 __attribute__((ext_vector_type(4)));
typedef float f32x8 __attribute__((ext_vector_type(8)));
typedef float f32x16 __attribute__((ext_vector_type(16)));
typedef short bf16x8 __attribute__((ext_vector_type(8)));
typedef __bf16 bfv8 __attribute__((ext_vector_type(8)));
typedef __bf16 bfv4 __attribute__((ext_vector_type(4)));
typedef __bf16 bfv2 __attribute__((ext_vector_type(2)));
typedef GAS unsigned gu32;
#define RLX_AGENT __ATOMIC_RELAXED, __HIP_MEMORY_SCOPE_AGENT
#define MFMA32(a, b, c) __builtin_amdgcn_mfma_f32_32x32x16_bf16((a), (b), (c), 0, 0, 0)

__device__ __forceinline__ bf16x8 cvt8(f32x8 v) { return __builtin_bit_cast(bf16x8, __builtin_convertvector(v, bfv8)); }
__device__ __forceinline__ v2u cvt4(f32x4 v) { return __builtin_bit_cast(v2u, __builtin_convertvector(v, bfv4)); }
__device__ __forceinline__ unsigned cvt2(float a, float b) { typedef float f2 __attribute__((ext_vector_type(2))); f2 v = {a, b}; return __builtin_bit_cast(unsigned, __builtin_convertvector(v, bfv2)); }
__device__ __forceinline__ float bf_lo(unsigned w) { return __builtin_bit_cast(float, w << 16); }
__device__ __forceinline__ float bf_hi(unsigned w) { return __builtin_bit_cast(float, w & 0xffff0000u); }
__device__ __forceinline__ float wave_sum(float v) {
#pragma unroll
    for (int o = 1; o < 64; o <<= 1) v += __shfl_xor(v, o);
    return v;
}
__device__ __forceinline__ int crow(int r, int hi) { return (r & 3) + 8 * (r >> 2) + 4 * hi; }

#define XB_TMO      128
#define XB_XCNT(j)  (256  + 64 * (j))
#define XB_XSUB(j)  (1280 + 64 * (j))
#define XB_XGEN(j)  (2304 + 64 * (j))
#define XB_TOP      3328
#define XB_TOPGEN   3392
#define XCD_BAR_WORDS 3456
#define XB_SPIN_CAP (1u << 18)

__device__ __forceinline__ unsigned xb_ld(unsigned* p)              { return __hip_atomic_load(p, __ATOMIC_RELAXED, __HIP_MEMORY_SCOPE_AGENT); }
__device__ __forceinline__ unsigned xb_add(unsigned* p, unsigned v) { return __hip_atomic_fetch_add(p, v, __ATOMIC_RELAXED, __HIP_MEMORY_SCOPE_AGENT); }
__device__ __forceinline__ unsigned xb_xcc_id() { return (unsigned)__builtin_amdgcn_s_getreg((3 << 11) | 20) & 0xFu; }
#define XB_SPIN(cond, bar) do { unsigned _sp = 0; while (cond) { __builtin_amdgcn_s_sleep(1); \
    if ((++_sp & 255u) == 0u) { if (xb_ld(&(bar)[XB_TMO])) break; if (_sp > XB_SPIN_CAP) { atomicAdd(&(bar)[XB_TMO], 1u); break; } } } } while (0)

struct XcdBarrier {
    unsigned* bar; unsigned x;
    volatile LAS unsigned* st;
};

__device__ __forceinline__ XcdBarrier xcd_barrier_post(unsigned* bar, volatile LAS unsigned* st) {
    XcdBarrier b; b.bar = bar; b.x = xb_xcc_id(); b.st = st;
    if (threadIdx.x == 0) (void)xb_add(&bar[XB_XCNT(b.x)], 1u);
    return b;
}
__device__ __forceinline__ void xcd_barrier_complete(unsigned* bar, unsigned x, unsigned& nloc, unsigned& nx) {
    const unsigned G = gridDim.x * gridDim.y * gridDim.z;
    unsigned sum, cnt, mine, sp = 0u;
    for (;;) {
        sum = 0u; cnt = 0u; mine = 0u;
#pragma unroll
        for (unsigned j = 0; j < 16; ++j) { const unsigned c = xb_ld(&bar[XB_XCNT(j)]); sum += c; cnt += (c > 0u) ? 1u : 0u; mine = (j == x) ? c : mine; }
        if (sum == G) break;
        __builtin_amdgcn_s_sleep(1);
        if ((++sp & 255u) == 0u) { if (xb_ld(&bar[XB_TMO])) break; if (sp > XB_SPIN_CAP) { atomicAdd(&bar[XB_TMO], 1u); break; } }
    }
    nloc = mine > 0u ? mine : 1u; nx = cnt > 0u ? cnt : 1u;
}

__device__ __forceinline__ void xcd_barrier(const XcdBarrier& b, const int tid_) {
    asm volatile("s_waitcnt vmcnt(0)" ::: "memory");
    __syncthreads();
    if (tid_ == 0) {
        unsigned* bar = b.bar;
        __builtin_amdgcn_s_waitcnt(0);
        unsigned nloc = b.st[0], nx = b.st[1];
        if (nloc == 0u) { xcd_barrier_complete(bar, b.x, nloc, nx); b.st[0] = nloc; b.st[1] = nx; }
        const unsigned old = xb_add(&bar[XB_XSUB(b.x)], 1u);
        const unsigned gen = old / nloc;
        if (old + 1u == (gen + 1u) * nloc) {
            __builtin_amdgcn_fence(__ATOMIC_RELEASE, "agent");
            asm volatile("s_waitcnt vmcnt(0)" ::: "memory");
            const unsigned og = xb_add(&bar[XB_TOP], 1u);
            const unsigned tg = og / nx;
            if (og + 1u == (tg + 1u) * nx) xb_add(&bar[XB_TOPGEN], 1u);
            else XB_SPIN(xb_ld(&bar[XB_TOPGEN]) == tg, bar);
            __builtin_amdgcn_fence(__ATOMIC_ACQUIRE, "agent");
            xb_add(&bar[XB_XGEN(b.x)], 1u);
            asm volatile("s_waitcnt vmcnt(0)" ::: "memory");
        } else {
            XB_SPIN(xb_ld(&bar[XB_XGEN(b.x)]) == gen, bar);
            __builtin_amdgcn_fence(__ATOMIC_ACQUIRE, "agent");
            asm volatile("s_waitcnt vmcnt(0)" ::: "memory");
        }
    }
    __syncthreads();
}


__device__ __forceinline__ void p0_item(const float* W, int ld, int col0, int k0, const float* gain, bf16* dst, int dstK, LAS float* scr, int lane) {
    const int kr = lane >> 3, nq = lane & 7;
    f32x4 w[8]; float gn[8];
#pragma unroll
    for (int i = 0; i < 8; ++i) { w[i] = *(const f32x4*)(W + (size_t)(k0 + 8 * i + kr) * ld + col0 + 4 * nq); gn[i] = gain ? gain[k0 + 8 * i + kr] : 1.0f; }
#pragma unroll
    for (int i = 0; i < 8; ++i) { LAS float* d = scr + (8 * i + kr) * 33 + 4 * nq; const f32x4 v = w[i] * gn[i]; d[0] = v.x; d[1] = v.y; d[2] = v.z; d[3] = v.w; }
    asm volatile("s_waitcnt lgkmcnt(0)" ::: "memory");
    const int c = lane & 7;
#pragma unroll
    for (int j = 0; j < 4; ++j) { const int n = (lane >> 3) + 8 * j; const LAS float* s = scr + (8 * c) * 33 + n;
        f32x8 v = {s[0 * 33], s[1 * 33], s[2 * 33], s[3 * 33], s[4 * 33], s[5 * 33], s[6 * 33], s[7 * 33]};
        *(bf16x8*)(dst + (size_t)n * dstK + 8 * c) = cvt8(v); }
    asm volatile("s_waitcnt lgkmcnt(0)" ::: "memory");
}
constexpr int I_IN = (D / 64) * (NPROJ / 32), I_GLU = (SSMW / 64) * (SSMW / 32), I_OUT = (D / 64) * (D / 32), I_GU = (D / 64) * (NGU / 32), I_D = (DFF / 64) * (D / 32);
constexpr int I_LAYER = I_IN + I_GLU + I_OUT + I_GU + I_D;

struct Args { const float* in[23]; float* out; unsigned char* ws; };
typedef const __attribute__((address_space(4))) Args CArgs;

__device__ __forceinline__ void p0_weights(CArgs& a, LAS unsigned char* lds, int gw, int NGW, int wave, int lane) {
    LAS float* scr = (LAS float*)(lds + RING_OFF + wave * 16384);
    for (int it = gw; it < LAYERS * I_LAYER; it += NGW) {
        const int l = it / I_LAYER; int r = it - l * I_LAYER;
        unsigned char* wl = a.ws + WS_W + (size_t)l * W_LAYER;
        if (r < I_IN) { const int kb = r / (NPROJ / 32), nb = r % (NPROJ / 32); const int n0 = 32 * nb;
            p0_item(a.in[1] + (size_t)l * D * INCOLS, INCOLS, n0 + (n0 >= COL_U ? 8 : 0), 64 * kb, a.in[3] + l * D, (bf16*)(wl + W_IN) + (size_t)n0 * D + 64 * kb, D, scr, lane); continue; }
        r -= I_IN;
        if (r < I_GLU) { const int kb = r / (SSMW / 32), nb = r % (SSMW / 32);
            p0_item(a.in[16] + (size_t)l * SSMW * SSMW, SSMW, 32 * nb, 64 * kb, nullptr, (bf16*)(wl + W_GLU) + (size_t)(32 * nb) * SSMW + 64 * kb, SSMW, scr, lane); continue; }
        r -= I_GLU;
        if (r < I_OUT) { const int kb = r / (D / 32), nb = r % (D / 32);
            p0_item(a.in[2] + (size_t)l * D * D, D, 32 * nb, 64 * kb, a.in[5] + l * D, (bf16*)(wl + W_OUT) + (size_t)(32 * nb) * D + 64 * kb, D, scr, lane); continue; }
        r -= I_OUT;
        if (r < I_GU) { const int kb = r / (NGU / 32), nb = r % (NGU / 32); const int n0 = 32 * nb, tile = n0 >> 8, within = n0 & 255;
            const float* src = (within < 128 ? a.in[20] : a.in[21]) + (size_t)l * D * DFF;
            p0_item(src, DFF, 128 * tile + (within & 127), 64 * kb, a.in[18] + l * D, (bf16*)(wl + W_GU) + (size_t)n0 * D + 64 * kb, D, scr, lane); continue; }
        r -= I_GU;
        { const int kb = r / (D / 32), nb = r % (D / 32);
            p0_item(a.in[22] + (size_t)l * DFF * D, D, 32 * nb, 64 * kb, nullptr, (bf16*)(wl + W_D) + (size_t)(32 * nb) * DFF + 64 * kb, DFF, scr, lane); }
    }
}

__device__ __forceinline__ void load_row(const float* p, int lane, f32x4 (&v)[16]) {
    const f32x4* q = (const f32x4*)p + lane;
#pragma unroll
    for (int j = 0; j < 16; ++j) v[j] = q[64 * j];
}
__device__ __forceinline__ float row_sumsq(const f32x4 (&v)[16]) {
    float s = 0.f;
#pragma unroll
    for (int j = 0; j < 16; ++j) s += (v[j].x * v[j].x + v[j].y * v[j].y) + (v[j].z * v[j].z + v[j].w * v[j].w);
    return wave_sum(s);
}
__device__ __forceinline__ void store_h(bf16* hrow, int lane, const f32x4 (&v)[16], float rstd) {
    v2u* o = (v2u*)hrow + lane;
#pragma unroll
    for (int j = 0; j < 16; ++j) o[64 * j] = cvt4(v[j] * rstd);
}
__device__ __forceinline__ void build_wfb(LAS float* wfb, const float* w_in_l, const float* g, int tid) {
#pragma unroll 1
    for (int base = tid; base < 8 * D; base += 16 * NWAVES * 64) {
        float w[16], gg[16];
#pragma unroll
        for (int i = 0; i < 16; ++i) { const int idx = base + i * NWAVES * 64, k = idx >> 3, hh = idx & 7; w[i] = w_in_l[(size_t)k * INCOLS + COL_U + hh]; gg[i] = g[k]; }
#pragma unroll
        for (int i = 0; i < 16; ++i) { const int idx = base + i * NWAVES * 64, k = idx >> 3, hh = idx & 7; wfb[hh * D + k] = gg[i] * w[i]; }
    }
}
__device__ __forceinline__ void fb_accum(const f32x4 vj, int j, const LAS float* wfb, int lane, float (&acc)[8]) {
#pragma unroll
    for (int hh = 0; hh < 8; ++hh) { const LAS float* base = wfb + 4 * lane + (hh < 4 ? 0 : 4 * D);
        const f32x4 w = *(const LAS f32x4*)(base + (hh & 3) * D + 256 * j); acc[hh] += (vj.x * w.x + vj.y * w.y) + (vj.z * w.z + vj.w * w.w); }
}
__device__ __forceinline__ void fb_finish(const float (&acc)[8], float rstd, const float* bfg, float* LS, int m, int lane) {
    float mine = 0.f;
#pragma unroll
    for (int hh = 0; hh < 8; ++hh) { const float s = wave_sum(acc[hh]); mine = (lane == hh) ? s : mine; }
    if (lane < 8) { const float z = mine * rstd + bfg[lane];
        const float ls = fminf(z, 0.f) - 0.6931471805599453f * __builtin_amdgcn_logf(1.0f + __builtin_amdgcn_exp2f(-fabsf(z) * LOG2E));
        const int b = m / SEQ, s = m - b * SEQ; LS[(size_t)(b * NH + lane) * SEQ + s] = ls; }
}
__device__ __forceinline__ void fb_emit(const f32x4 (&v)[16], float rstd, const LAS float* wfb, const float* bfg, float* LS, int m, int lane) {
    float acc[8];
#pragma unroll
    for (int hh = 0; hh < 8; ++hh) acc[hh] = 0.f;
#pragma unroll
    for (int j = 0; j < 16; ++j) { fb_accum(v[j], j, wfb, lane, acc);
        asm volatile("" ::: "memory"); }
    fb_finish(acc, rstd, bfg, LS, m, lane);
}
__device__ __forceinline__ void phase_norm0(CArgs& a, LAS unsigned char* lds, int gw, int NGW, int tid, int lane) {
    LAS float* wfb = (LAS float*)(lds + RING_OFF);
    build_wfb(wfb, a.in[1], a.in[3], tid);
    __syncthreads();
    bf16* X = (bf16*)(a.ws + WS_X16); float* LS = (float*)(a.ws + WS_LS); float* RS = (float*)(a.ws + WS_RS);
    f32x4 v[16], vn[16];
    int m = gw;
    if (m < M) load_row(a.in[0] + (size_t)m * D, lane, v);
    while (m < M) {
        const int mn = m + NGW;
        if (mn < M) load_row(a.in[0] + (size_t)mn * D, lane, vn);
        const float rstd = 1.0f / sqrtf(row_sumsq(v) * (1.0f / D) + RMS_EPS);
        store_h(X + (size_t)m * D, lane, v, 1.0f);
        if (lane == 0) RS[m] = rstd;
        fb_emit(v, rstd, wfb, a.in[7], LS, m, lane);
#pragma unroll
        for (int j = 0; j < 16; ++j) v[j] = vn[j];
        m = mn;
    }
    __syncthreads();
}
__device__ __forceinline__ void load_row_bf16(const bf16* p, int lane, f32x4 (&y)[16]) {
    const v2u* yq = (const v2u*)p + lane; v2u yw[16];
#pragma unroll
    for (int j = 0; j < 16; ++j) yw[j] = yq[64 * j];
#pragma unroll
    for (int j = 0; j < 16; ++j) { const unsigned w0 = yw[j].x, w1 = yw[j].y; y[j] = (f32x4){bf_lo(w0), bf_hi(w0), bf_lo(w1), bf_hi(w1)}; }
}
template <bool XF32> struct XRow;
template <> struct XRow<true> { typedef f32x4 T;
    static __device__ __forceinline__ void load(const float* xin, const bf16*, int m, int lane, f32x4 (&w)[16]) { const f32x4* q = (const f32x4*)(xin + (size_t)m * D) + lane;
#pragma unroll
        for (int j = 0; j < 16; ++j) w[j] = q[64 * j]; }
    static __device__ __forceinline__ f32x4 get(const f32x4& w) { return w; } };
template <> struct XRow<false> { typedef v2u T;
    static __device__ __forceinline__ void load(const float*, const bf16* X, int m, int lane, v2u (&w)[16]) { const v2u* q = (const v2u*)(X + (size_t)m * D) + lane;
#pragma unroll
        for (int j = 0; j < 16; ++j) w[j] = q[64 * j]; }
    static __device__ __forceinline__ f32x4 get(const v2u& w) { const unsigned w0 = w.x, w1 = w.y; return (f32x4){bf_lo(w0), bf_hi(w0), bf_lo(w1), bf_hi(w1)}; } };
template <bool XF32, bool LAST, bool DO_FB>
__device__ __forceinline__ void phase_post(CArgs& a, LAS unsigned char* lds, const float* gpost, int lnext, int gw, int NGW, int tid, int lane) {
    LAS float* wfb = (LAS float*)(lds + RING_OFF);
    if (DO_FB) { build_wfb(wfb, a.in[1] + (size_t)lnext * D * INCOLS, a.in[3] + lnext * D, tid); __syncthreads(); }
    const bf16* Y = (const bf16*)(a.ws + WS_Y16); bf16* X = (bf16*)(a.ws + WS_X16); float* LS = (float*)(a.ws + WS_LS); float* RS = (float*)(a.ws + WS_RS);
    const f32x4* gq = (const f32x4*)gpost + lane;
    typedef typename XRow<XF32>::T XT;
    v2u yw[16], ywn[16]; XT xw[16], xwn[16];
    int m = gw;
    if (m < M) { const v2u* yq = (const v2u*)(Y + (size_t)m * D) + lane;
#pragma unroll
        for (int j = 0; j < 16; ++j) yw[j] = yq[64 * j];
        XRow<XF32>::load(a.in[0], X, m, lane, xw); }
#pragma clang loop unroll(disable)
    while (m < M) {
        const int mn = m + NGW;
        if (!XF32 && mn < M) { const v2u* yq = (const v2u*)(Y + (size_t)mn * D) + lane;
#pragma unroll
            for (int j = 0; j < 16; ++j) ywn[j] = yq[64 * j];
            XRow<XF32>::load(a.in[0], X, mn, lane, xwn); }
        float ssy = 0.f;
#pragma unroll
        for (int j = 0; j < 16; ++j) { const unsigned w0 = yw[j].x, w1 = yw[j].y; const float a0 = bf_lo(w0), a1 = bf_hi(w0), a2 = bf_lo(w1), a3 = bf_hi(w1); ssy += (a0 * a0 + a1 * a1) + (a2 * a2 + a3 * a3); }
        const float ry = 1.0f / sqrtf(wave_sum(ssy) * (1.0f / D) + RMS_EPS);
        float ssv = 0.f; float acc[8];
#pragma unroll
        for (int hh = 0; hh < 8; ++hh) acc[hh] = 0.f;
        f32x4* o = (f32x4*)(a.out + (size_t)m * D) + lane; v2u* xo = (v2u*)(X + (size_t)m * D) + lane;
#pragma unroll
        for (int j = 0; j < 16; ++j) { const unsigned w0 = yw[j].x, w1 = yw[j].y; const f32x4 yv = {bf_lo(w0), bf_hi(w0), bf_lo(w1), bf_hi(w1)};
            const f32x4 vj = XRow<XF32>::get(xw[j]) + (yv * ry) * gq[64 * j];
            if (LAST) o[64 * j] = vj;
            else { xo[64 * j] = cvt4(vj); ssv += (vj.x * vj.x + vj.y * vj.y) + (vj.z * vj.z + vj.w * vj.w); if (DO_FB) fb_accum(vj, j, wfb, lane, acc); }
            if (DO_FB) asm volatile("" : "+v"(acc[0]), "+v"(acc[1]), "+v"(acc[2]), "+v"(acc[3]), "+v"(acc[4]), "+v"(acc[5]), "+v"(acc[6]), "+v"(acc[7]) :: "memory");
            else if ((j & 3) == 3) asm volatile("" ::: "memory"); }
        if (!LAST) { const float rstd = 1.0f / sqrtf(wave_sum(ssv) * (1.0f / D) + RMS_EPS);
            if (lane == 0) RS[m] = rstd;
            if (DO_FB) fb_finish(acc, rstd, a.in[7] + lnext * NH, LS, m, lane); }
        if (XF32) { if (mn < M) { const v2u* yq = (const v2u*)(Y + (size_t)mn * D) + lane;
#pragma unroll
                for (int j = 0; j < 16; ++j) yw[j] = yq[64 * j];
                XRow<XF32>::load(a.in[0], X, mn, lane, xw); } }
        else {
#pragma unroll
            for (int j = 0; j < 16; ++j) { yw[j] = ywn[j]; xw[j] = xwn[j]; } }
        m = mn;
    }
    if (DO_FB) __syncthreads();
}
constexpr int SEG_OFF = LDSCTL_OFF + 1024;
__device__ __forceinline__ void build_seg(CArgs& a, LAS unsigned char* lds, int pm, int tid) {
    { const int r = tid >> 1, hf = tid & 1; const size_t row = (size_t)pm * 256 + r;
        const int b = (int)(row / SEQ), sq = (int)(row % SEQ);
        const float* pp = (const float*)(a.ws + (hf ? WS_PSB : WS_PSA)) + (size_t)b * NH * SEQ + sq; const f32x4* pc = (const f32x4*)((const float*)(a.ws + WS_PSC) + ((size_t)(4 * hf) * M + row) * 16);
        float hs[8];
#pragma unroll
        for (int hh = 0; hh < 8; ++hh) hs[hh] = pp[(size_t)hh * SEQ];
        const float sx = ((hs[0] + hs[1]) + (hs[2] + hs[3])) + ((hs[4] + hs[5]) + (hs[6] + hs[7])), so = __shfl_xor(sx, 1), sa = hf ? so : sx, sb = hf ? sx : so; float sc = 0.f;
#pragma unroll
        for (int i = 0; i < 16; ++i) { const f32x4 c = pc[(size_t)(i >> 2) * (M * 4) + (i & 3)]; sc += (c.x + c.y) + (c.z + c.w); }
        sc += __shfl_xor(sc, 1);
        const float ra = 1.0f / sqrtf(sa * (1.0f / 1024.f) + RMS_EPS), rb = 1.0f / sqrtf(sb * (1.0f / 1024.f) + RMS_EPS), rc = 1.0f / sqrtf(sc * (1.0f / 2048.f) + RMS_EPS);
        LAS float* seg = (LAS float*)(lds + SEG_OFF) + r * 3; if (hf == 0) { seg[0] = ra / rb; seg[1] = rb / rc; seg[2] = rc; } }
    __syncthreads();
}
__device__ __forceinline__ void phase_mixnorm(CArgs& a, int gw, int NGW, int lane) {
    bf16* O = (bf16*)(a.ws + WS_O);
    for (int m = gw; m < M; m += NGW) {
        v4u* p = (v4u*)(O + (size_t)m * D) + lane; v4u w[8]; float ss[8];
#pragma unroll
        for (int j = 0; j < 8; ++j) w[j] = p[64 * j];
#pragma unroll
        for (int j = 0; j < 8; ++j) { float s = 0.f;
#pragma unroll
            for (int e = 0; e < 4; ++e) { const float lo = bf_lo(w[j][e]), hi = bf_hi(w[j][e]); s += lo * lo + hi * hi; }
            ss[j] = s; }
        const float sa = wave_sum(ss[0] + ss[1]), sb = wave_sum(ss[2] + ss[3]), sc = wave_sum((ss[4] + ss[5]) + (ss[6] + ss[7]));
        const float ra = 1.0f / sqrtf(sa * (1.0f / 1024.f) + RMS_EPS), rb = 1.0f / sqrtf(sb * (1.0f / 1024.f) + RMS_EPS), rc = 1.0f / sqrtf(sc * (1.0f / 2048.f) + RMS_EPS);
#pragma unroll
        for (int j = 0; j < 8; ++j) { const float r = j < 2 ? ra : (j < 4 ? rb : rc); v4u o;
#pragma unroll
            for (int e = 0; e < 4; ++e) o[e] = cvt2(bf_lo(w[j][e]) * r, bf_hi(w[j][e]) * r);
            p[64 * j] = o; }
    }
}
__device__ __forceinline__ void phase_cum_knorm(CArgs& a, int gw, int NGW, int lane) {
    if (gw < BATCH * NH) {
        const float* ls = (const float*)(a.ws + WS_LS) + (size_t)gw * SEQ; float* cum = (float*)(a.ws + WS_CUM) + (size_t)gw * SEQ; float carry = 0.f;
        f32x4 qa[SEQ / 1024][4];
#pragma unroll
        for (int c = 0; c < SEQ / 1024; ++c)
#pragma unroll
            for (int i = 0; i < 4; ++i) qa[c][i] = *(const f32x4*)(ls + c * 1024 + lane * 16 + 4 * i);
#pragma unroll
        for (int c = 0; c < SEQ / 1024; ++c) {
            f32x4 q[4];
#pragma unroll
            for (int i = 0; i < 4; ++i) q[i] = qa[c][i];
            float run = 0.f;
#pragma unroll
            for (int i = 0; i < 4; ++i) { q[i].x += run; q[i].y += q[i].x; q[i].z += q[i].y; q[i].w += q[i].z; run = q[i].w; }
            float inc = run;
#pragma unroll
            for (int o = 1; o < 64; o <<= 1) { const float t = __builtin_bit_cast(float, __builtin_amdgcn_ds_bpermute(((lane - o) & 63) << 2, __builtin_bit_cast(int, inc))); if (lane >= o) inc += t; }
            const float excl = (inc - run) + carry;
#pragma unroll
            for (int i = 0; i < 4; ++i) *(f32x4*)(cum + c * 1024 + lane * 16 + 4 * i) = q[i] + excl;
            carry += __builtin_bit_cast(float, __builtin_amdgcn_readlane(__builtin_bit_cast(int, inc), 63));
        }
    }
    const bf16* P = (const bf16*)(a.ws + WS_PROJ); float* knt = (float*)(a.ws + WS_KNT);
    for (int t = gw; t < BATCH * NH * (SEQ / 64); t += NGW) {
        const int bh = t / (SEQ / 64), kt = t % (SEQ / 64), b = bh / NH, h = bh % NH; float mx = 0.f;
        const bf16* base = P + (size_t)(b * SEQ + kt * 64) * NPROJ + COL_KB + h * HD + 8 * (lane & 15);
#pragma unroll 4
        for (int it = 0; it < 16; ++it) { const v4u w = *(const v4u*)(base + (size_t)(it * 4 + (lane >> 4)) * NPROJ); float s = 0.f;
#pragma unroll
            for (int e = 0; e < 4; ++e) { const float lo = bf_lo(w[e]), hi = bf_hi(w[e]); s += lo * lo + hi * hi; }
            s += __shfl_xor(s, 1); s += __shfl_xor(s, 2); s += __shfl_xor(s, 4); s += __shfl_xor(s, 8); mx = fmaxf(mx, s); }
        mx = fmaxf(mx, __shfl_xor(mx, 16)); mx = fmaxf(mx, __shfl_xor(mx, 32));
        if (lane == 0) knt[t] = sqrtf(mx);
    }
}
namespace att {
typedef short s16x4 __attribute__((ext_vector_type(4)));
#ifndef B_SKIP
#define B_SKIP 1
#endif
constexpr float SKIP_T = 30.0f;
constexpr int KBUF = 64 * 256, VBUF = 64 * 256;
constexpr int NBUF = 3;
constexpr int OFF_K = 0, OFF_V = NBUF * KBUF, OFF_TAB = NBUF * (KBUF + VBUF), OFF_CK = OFF_TAB + 2560, OFF_RED = OFF_CK + NBUF * 256, LDS_END = OFF_RED + 64;
__device__ __forceinline__ int swz(int row) { return ((row & 3) << 2) | ((row >> 2) & 3); }
static_assert(LDS_END <= RING_BYTES, "attention LDS");

template <int MODE>
__device__ __forceinline__ void attn_unit(CArgs& a, LAS unsigned char* lds, int l, int b, int h, int qb, int tid, int wave, int lane) {
    const bf16* P = (const bf16*)(a.ws + WS_PROJ);
    const int colq = MODE == 0 ? COL_QA : COL_QB, colk = MODE == 0 ? COL_KA : COL_KB, colv = MODE == 0 ? COL_VA : COL_VB;
    const int q = lane & 31, hi = lane >> 5;
    const int qpos = qb * 256 + wave * 32 + q;
    const size_t rowbase = (size_t)b * SEQ;
    const float* cum = (const float*)(a.ws + WS_CUM) + (size_t)(b * NH + h) * SEQ;
    LAS float* tab = (LAS float*)(lds + OFF_TAB);
    LAS float* ckl = (LAS float*)(lds + OFF_CK);

    int kt_first, ntiles, kt_step;
    if (MODE == 0) { kt_first = 4 * qb - 8 < 0 ? 0 : 4 * qb - 8; ntiles = 4 * qb + 3 - kt_first + 1; kt_step = 1; }
    else { kt_first = 4 * qb + 3; ntiles = 4 * qb + 4; kt_step = -1; }
    const int cq = 4 * qb + (wave >> 1);

    if (MODE == 0) { const float* rb = a.in[6] + (size_t)(l * NH + h) * 513; for (int i = tid; i < 640; i += NWAVES * 64) tab[i] = rb[i < 512 ? i : 512] * LOG2E; }

    bf16x8 qf[8];
    { const bf16* qp = P + (rowbase + qpos) * NPROJ + colq + h * HD + 8 * hi;
#pragma unroll
        for (int s = 0; s < 8; ++s) qf[s] = *(const bf16x8*)(qp + 16 * s); }
    if (MODE == 1 && B_SKIP) {
        float ss = 0.f;
#pragma unroll
        for (int s = 0; s < 8; ++s) { const bf16x8 qv = qf[s]; const v4u w = __builtin_bit_cast(v4u, qv);
#pragma unroll
            for (int e = 0; e < 4; ++e) { const unsigned ww = w[e]; const float lo = bf_lo(ww), hi2 = bf_hi(ww); ss += lo * lo + hi2 * hi2; } }
        ss += __shfl_xor(ss, 32);
#pragma unroll
        for (int o = 1; o < 32; o <<= 1) ss = fmaxf(ss, __shfl_xor(ss, o));
        LAS float* red = (LAS float*)(lds + OFF_RED);
        if (lane == 0) red[wave] = ss;
        __syncthreads();
        float qn2 = red[0];
#pragma unroll
        for (int w = 1; w < NWAVES; ++w) qn2 = fmaxf(qn2, red[w]);
        const float* knt = (const float*)(a.ws + WS_KNT) + (size_t)(b * NH + h) * (SEQ / 64);
        float kn = fmaxf(knt[lane], knt[lane + 64]);
#pragma unroll
        for (int o = 1; o < 64; o <<= 1) kn = fmaxf(kn, __shfl_xor(kn, o));
        const float kd = fmaxf(fmaxf(knt[4 * qb], knt[4 * qb + 1]), fmaxf(knt[4 * qb + 2], knt[4 * qb + 3]));
        const float qn = sqrtf(qn2), theta = SKIP_T + qn * (kn + kd) * QK_SCALE;
        const float c0 = cum[qb * 256];
        int jskip = -1; bool found = false;
        for (int base = 4 * qb - 1; base >= 0 && !found; base -= 64) {
            const int Jl = base - lane; const bool skip = Jl < 0 ? true : (c0 - cum[64 * Jl + 63] < -theta);
            const unsigned long long bal = __ballot(skip);
            if (bal) { jskip = base - (__ffsll((long long)bal) - 1); found = true; }
        }
        jskip = __builtin_amdgcn_readfirstlane(jskip);
        ntiles = 4 * qb + 3 - jskip;
    }

    f32x16 O[4];
#pragma unroll
    for (int d = 0; d < 4; ++d)
#pragma unroll
        for (int r = 0; r < 16; ++r) O[d][r] = 0.f;
    float mrun = -1e30f, lsum = 0.f;

    float ckreg = 0.f;
    const bf16* kbase = P + rowbase * NPROJ + colk + h * HD;
    const bf16* vbase = P + rowbase * NPROJ + colv + h * HD;
    unsigned goff[2];
#pragma unroll
    for (int j = 0; j < 2; ++j) { const int row = 8 * wave + 4 * j + (lane >> 4); goff[j] = (unsigned)(row * NPROJ + 8 * ((lane & 15) ^ swz(row))); }
#define ATT_LOAD(kt, buf) do { const size_t r0_ = (size_t)(kt) * 64 * NPROJ; \
        _Pragma("unroll") for (int j_ = 0; j_ < 2; ++j_) { \
            __builtin_amdgcn_global_load_lds((const unsigned*)(kbase + r0_ + goff[j_]), (LAS unsigned*)(lds + OFF_K + (buf) * KBUF + 1024 * (2 * wave + j_)), 16, 0, 0); \
            __builtin_amdgcn_global_load_lds((const unsigned*)(vbase + r0_ + goff[j_]), (LAS unsigned*)(lds + OFF_V + (buf) * VBUF + 1024 * (2 * wave + j_)), 16, 0, 0); } \
        if (MODE == 1 && tid < 64) ckreg = -cum[(size_t)(kt) * 64 + tid] * LOG2E; } while (0)
#define ATT_STORE(buf) do { if (MODE == 1 && tid < 64) ckl[(buf) * 64 + tid] = ckreg; } while (0)
    unsigned kx[8], vx[4][2];
    { const int sk = swz(q);
#pragma unroll
        for (int s = 0; s < 8; ++s) kx[s] = (unsigned)(256 * q + 16 * ((2 * s + hi) ^ sk));
        const int qq = (lane & 15) >> 2, pp = lane & 3, g1 = (lane >> 4) & 1;
#pragma unroll
        for (int d = 0; d < 4; ++d)
#pragma unroll
            for (int hf = 0; hf < 2; ++hf) { const int row = 8 * hf + 4 * hi + qq; vx[d][hf] = (unsigned)(256 * row + 16 * ((4 * d + 2 * g1 + (pp >> 1)) ^ swz(row)) + 8 * (pp & 1)); } }

#define ATT_QK(P0, P1, buf) do { const LAS unsigned char* kb_ = lds + OFF_K + (buf) * KBUF; \
        _Pragma("unroll") for (int r_ = 0; r_ < 16; ++r_) { P0[r_] = 0.f; P1[r_] = 0.f; } \
        _Pragma("unroll") for (int s_ = 0; s_ < 8; ++s_) { const bf16x8 k0_ = *(const LAS bf16x8*)(kb_ + kx[s_]), k1_ = *(const LAS bf16x8*)(kb_ + kx[s_] + 8192); \
            P0 = MFMA32(k0_, qf[s_], P0); P1 = MFMA32(k1_, qf[s_], P1); } } while (0)
#define ATT_ACTIVE(kt) (MODE == 0 ? ((kt) <= cq && (kt) >= cq - 8) : ((kt) <= cq))
    ATT_LOAD(kt_first, 0); ATT_STORE(0);
    if (ntiles > 1) { ATT_LOAD(kt_first + kt_step, 1); ATT_STORE(1); }
    __syncthreads();
    f32x16 pn0, pn1;
#pragma unroll
    for (int r = 0; r < 16; ++r) { pn0[r] = 0.f; pn1[r] = 0.f; }
    if (ATT_ACTIVE(kt_first)) ATT_QK(pn0, pn1, 0);
    int buf = 0, bnx = 1, bnn = 2;
    for (int it = 0; it < ntiles; ++it) {
        const int kt = kt_first + it * kt_step;
        if (it + 2 < ntiles) ATT_LOAD(kt + 2 * kt_step, bnn);
        f32x16 p0 = pn0, p1 = pn1;
        if (it + 1 < ntiles && ATT_ACTIVE(kt + kt_step)) ATT_QK(pn0, pn1, bnx);
        const bool active = ATT_ACTIVE(kt);
        if (active) {
            constexpr float C2 = QK_SCALE * LOG2E;
            const int key0 = kt * 64 + 4 * hi;
            if (MODE == 0) {
                if (cq - kt >= 5) { const float bc = tab[512];
#pragma unroll
                    for (int r = 0; r < 16; ++r) { p0[r] = p0[r] * C2 + bc; p1[r] = p1[r] * C2 + bc; } }
                else { const LAS float* tb = tab + (qpos - key0 + 256 - 59);
#pragma unroll
                    for (int r = 0; r < 16; ++r) { const int c = (r & 3) + 8 * (r >> 2); p0[r] = p0[r] * C2 + tb[59 - c]; p1[r] = p1[r] * C2 + tb[27 - c]; } }
            } else {
                const LAS float* ck = ckl + buf * 64 + 4 * hi;
#pragma unroll
                for (int g = 0; g < 4; ++g) { const f32x4 c0 = *(const LAS f32x4*)(ck + 8 * g), c1 = *(const LAS f32x4*)(ck + 32 + 8 * g);
#pragma unroll
                    for (int e = 0; e < 4; ++e) { p0[4 * g + e] = p0[4 * g + e] * C2 + c0[e]; p1[4 * g + e] = p1[4 * g + e] * C2 + c1[e]; } }
                if (kt == cq) { const float NEG = -__builtin_inff();
#pragma unroll
                    for (int r = 0; r < 16; ++r) { const int key = key0 + (r & 3) + 8 * (r >> 2); if (key > qpos) p0[r] = NEG; if (key + 32 > qpos) p1[r] = NEG; } }
            }
            float mt = p0[0];
#pragma unroll
            for (int r = 1; r < 16; ++r) mt = fmaxf(mt, p0[r]);
#pragma unroll
            for (int r = 0; r < 16; ++r) mt = fmaxf(mt, p1[r]);
            mt = fmaxf(mt, __shfl_xor(mt, 32));
            const float mn = fmaxf(mrun, mt), alpha = __builtin_amdgcn_exp2f(mrun - mn);
            mrun = mn;
            float ps = 0.f;
#pragma unroll
            for (int r = 0; r < 16; ++r) { p0[r] = __builtin_amdgcn_exp2f(p0[r] - mn); p1[r] = __builtin_amdgcn_exp2f(p1[r] - mn); ps += p0[r] + p1[r]; }
            lsum = lsum * alpha + ps;
            if (!__all(alpha == 1.0f)) {
#pragma unroll
                for (int d = 0; d < 4; ++d)
#pragma unroll
                    for (int r = 0; r < 16; ++r) O[d][r] *= alpha;
            }
            bf16x8 pf[4];
            pf[0] = cvt8((f32x8){p0[0], p0[1], p0[2], p0[3], p0[4], p0[5], p0[6], p0[7]});
            pf[1] = cvt8((f32x8){p0[8], p0[9], p0[10], p0[11], p0[12], p0[13], p0[14], p0[15]});
            pf[2] = cvt8((f32x8){p1[0], p1[1], p1[2], p1[3], p1[4], p1[5], p1[6], p1[7]});
            pf[3] = cvt8((f32x8){p1[8], p1[9], p1[10], p1[11], p1[12], p1[13], p1[14], p1[15]});
            const LAS unsigned char* vb = lds + OFF_V + buf * VBUF;
#pragma unroll
            for (int d = 0; d < 4; ++d)
#pragma unroll
                for (int ks = 0; ks < 4; ++ks) {
                    const s16x4 lo = __builtin_amdgcn_ds_read_tr16_b64_v4i16((LAS s16x4*)(vb + vx[d][0] + 4096 * ks)), hh = __builtin_amdgcn_ds_read_tr16_b64_v4i16((LAS s16x4*)(vb + vx[d][1] + 4096 * ks));
                    const bf16x8 vv = {lo[0], lo[1], lo[2], lo[3], hh[0], hh[1], hh[2], hh[3]};
                    O[d] = MFMA32(vv, pf[ks], O[d]);
                }
        }
        if (it + 2 < ntiles) ATT_STORE(bnn);
        __syncthreads();
        { const int t_ = buf; buf = bnx; bnx = bnn; bnn = t_; }
    }
#undef ATT_QK
#undef ATT_ACTIVE
#undef ATT_LOAD
#undef ATT_STORE
    const float ltot = lsum + __shfl_xor(lsum, 32), inv = 1.0f / ltot; float ssq = 0.f;
    bf16* op = (bf16*)(a.ws + WS_O) + (rowbase + qpos) * D + MODE * 1024 + h * HD + 4 * hi;
#pragma unroll
    for (int d = 0; d < 4; ++d)
#pragma unroll
        for (int g = 0; g < 4; ++g) { const f32x4 v = {O[d][4 * g] * inv, O[d][4 * g + 1] * inv, O[d][4 * g + 2] * inv, O[d][4 * g + 3] * inv};
            ssq += (v.x * v.x + v.y * v.y) + (v.z * v.z + v.w * v.w);
            *(v2u*)(op + 32 * d + 8 * g) = cvt4(v); }
    ssq += __shfl_xor(ssq, 32);
    if (hi == 0) ((float*)(a.ws + (MODE == 0 ? WS_PSA : WS_PSB)))[(size_t)(b * NH + h) * SEQ + qpos] = ssq;
}
}

namespace s5 {
#ifndef S5_PF
#define S5_PF 8
#endif
constexpr int XROW = 272, XIMG = 32 * XROW, OFF_X = 0, OFF_E = 8 * XIMG, LDS_END = OFF_E + 8 * 64 * 8;
static_assert(LDS_END <= RING_BYTES, "s5 LDS");
struct LamC { float lr, li, cr, ci; };
__device__ __forceinline__ LamC lam_coef(const float* are, const float* aim, float dt, int n) {
    const float ar = fminf(are[n], -1e-4f), ai = aim[n];
    const float zr = ar * dt, zi = ai * dt;
    float sn, cs; sincosf(zi, &sn, &cs);
    const float er = expf(zr);
    LamC o; o.lr = er * cs; o.li = er * sn;
    const float sh = sinf(0.5f * zi);
    const float nr = expm1f(zr) * cs - 2.0f * sh * sh, ni = o.li;
    const float den = 1.0f / (ar * ar + ai * ai);
    o.cr = (nr * ar + ni * ai) * den; o.ci = (ni * ar - nr * ai) * den;
    return o;
}
__device__ __forceinline__ float gelu_tanh(float y) {
    const float z = 0.7978845608028654f * (y + 0.044715f * y * y * y);
    return y * __builtin_amdgcn_rcpf(1.0f + __builtin_amdgcn_exp2f(-2.0f * LOG2E * z));
}
__device__ __forceinline__ void s5_unit(CArgs& a, LAS unsigned char* lds, int l, int b, int g, int wave, int lane) {
    const int c32 = lane & 31, hi = lane >> 5;
    const float* are = a.in[8] + (size_t)(l * NG + g) * NS; const float* aim = a.in[9] + (size_t)(l * NG + g) * NS;
    const float dt = expf(a.in[10][l * NG + g]);
    const LamC me = lam_coef(are, aim, dt, lane);
    bf16x8 bb[4];
#pragma unroll
    for (int st = 0; st < 2; ++st) { const int ns = 32 * st + c32; const LamC cc = lam_coef(are, aim, dt, ns);
        const float* br = a.in[11] + ((size_t)(l * NG + g) * NS + ns) * 16 + 8 * hi; const float* bi = a.in[12] + ((size_t)(l * NG + g) * NS + ns) * 16 + 8 * hi;
        f32x8 vr, vi;
#pragma unroll
        for (int j = 0; j < 8; ++j) { const float xr = br[j], xi = bi[j]; vr[j] = cc.cr * xr - cc.ci * xi; vi[j] = cc.cr * xi + cc.ci * xr; }
        bb[st] = cvt8(vr); bb[2 + st] = cvt8(vi); }
    bf16x8 cf[8];
    { const float msk = c32 < 16 ? 1.f : 0.f; const int ii = c32 & 15;
        const float* cr = a.in[13] + ((size_t)(l * NG + g) * 16 + ii) * NS + 4 * hi; const float* ci = a.in[14] + ((size_t)(l * NG + g) * 16 + ii) * NS + 4 * hi;
#pragma unroll
        for (int s = 0; s < 8; ++s) { const f32x4 r4 = *(const f32x4*)(cr + 8 * s), i4 = *(const f32x4*)(ci + 8 * s);
            cf[s] = cvt8((f32x8){r4.x * msk, -i4.x * msk, r4.y * msk, -i4.y * msk, r4.z * msk, -i4.z * msk, r4.w * msk, -i4.w * msk}); } }
    bf16x8 df;
    { const float dv = c32 < 16 ? a.in[15][(size_t)l * SSMW + g * 16 + (c32 & 15)] : 0.f; f32x8 v;
#pragma unroll
        for (int j = 0; j < 8; ++j) v[j] = (8 * hi + j == c32) ? dv : 0.f;
        df = cvt8(v); }

    const bf16* up = (const bf16*)(a.ws + WS_PROJ) + ((size_t)b * SEQ + wave * 1024 + c32) * NPROJ + COL_U + g * 16 + 8 * hi;
    bf16* yg = (bf16*)(a.ws + WS_YG) + ((size_t)b * SEQ + wave * 1024 + c32) * SSMW + g * 16 + 4 * hi;
    LAS unsigned char* ximg = lds + OFF_X + wave * XIMG;
    LAS float* ebuf = (LAS float*)(lds + OFF_E);

    float xr = 0.f, xi = 0.f; const float nli = -me.li;
    for (int pass = 0; pass < 2; ++pass) {
        bf16x8 ub[S5_PF];
#pragma unroll
        for (int i = 0; i < S5_PF; ++i) ub[i] = *(const bf16x8*)(up + (size_t)i * 32 * NPROJ);
        for (int sg = 0; sg < 32 / S5_PF; ++sg)
#pragma unroll
        for (int si = 0; si < S5_PF; ++si) {
            const int sc = sg * S5_PF + si;
            const bf16x8 uf = ub[si];
            if (sg < 32 / S5_PF - 1) ub[si] = *(const bf16x8*)(up + (size_t)(sc + S5_PF) * 32 * NPROJ);
            f32x16 z;
#pragma unroll
            for (int r = 0; r < 16; ++r) z[r] = 0.f;
            f32x16 c0 = MFMA32(uf, bb[0], z), c1 = MFMA32(uf, bb[1], z), c2 = MFMA32(uf, bb[2], z), c3 = MFMA32(uf, bb[3], z);
            f32x16 re0, re1, im0, im1;
#pragma unroll
            for (int r = 0; r < 16; ++r) {
                const float f0 = c0[r], f1 = c1[r], f2 = c2[r], f3 = c3[r];
                const auto s0 = __builtin_amdgcn_permlane32_swap(__float_as_uint(f0), __float_as_uint(f1), false, false);
                const auto s1 = __builtin_amdgcn_permlane32_swap(__float_as_uint(f2), __float_as_uint(f3), false, false);
                const unsigned u00 = s0[0], u01 = s0[1], u10 = s1[0], u11 = s1[1];
                re0[r] = __uint_as_float(u00); re1[r] = __uint_as_float(u01); im0[r] = __uint_as_float(u10); im1[r] = __uint_as_float(u11);
            }
#pragma unroll
            for (int q4 = 0; q4 < 4; ++q4) {
#pragma unroll
                for (int i = 0; i < 4; ++i) { const int r = 4 * q4 + i; const float nr = __builtin_fmaf(me.lr, xr, __builtin_fmaf(nli, xi, re0[r])), ni = __builtin_fmaf(me.lr, xi, __builtin_fmaf(me.li, xr, im0[r])); xr = nr; xi = ni; re0[r] = nr; im0[r] = ni; }
#pragma unroll
                for (int i = 0; i < 4; ++i) { const int r = 4 * q4 + i; const float nr = __builtin_fmaf(me.lr, xr, __builtin_fmaf(nli, xi, re1[r])), ni = __builtin_fmaf(me.lr, xi, __builtin_fmaf(me.li, xr, im1[r])); xr = nr; xi = ni; re1[r] = nr; im1[r] = ni; }
            }
            if (pass == 1) {
#pragma unroll
                for (int r = 0; r < 16; ++r) {
                    *(LAS unsigned*)(ximg + crow(r, 0) * XROW + 4 * lane) = cvt2(re0[r], im0[r]);
                    *(LAS unsigned*)(ximg + crow(r, 1) * XROW + 4 * lane) = cvt2(re1[r], im1[r]);
                }
                f32x16 y, y2;
#pragma unroll
                for (int r = 0; r < 16; ++r) { y[r] = 0.f; y2[r] = 0.f; }
#pragma unroll
                for (int s = 0; s < 4; ++s) { const bf16x8 xf = *(const LAS bf16x8*)(ximg + c32 * XROW + 32 * s + 16 * hi), xg = *(const LAS bf16x8*)(ximg + c32 * XROW + 32 * (s + 4) + 16 * hi);
                    y = MFMA32(cf[s], xf, y); y2 = MFMA32(cf[s + 4], xg, y2); }
                y = MFMA32(df, uf, y);
#pragma unroll
                for (int r = 0; r < 8; ++r) y[r] += y2[r];
                bf16* yo = yg + (size_t)sc * 32 * SSMW;
                *(v2u*)yo = cvt4((f32x4){gelu_tanh(y[0]), gelu_tanh(y[1]), gelu_tanh(y[2]), gelu_tanh(y[3])});
                *(v2u*)(yo + 8) = cvt4((f32x4){gelu_tanh(y[4]), gelu_tanh(y[5]), gelu_tanh(y[6]), gelu_tanh(y[7])});
            }
        }
        if (pass == 0) {
            ebuf[(wave * 64 + lane) * 2] = xr; ebuf[(wave * 64 + lane) * 2 + 1] = xi;
            __syncthreads();
            float pr = me.lr, pi = me.li;
#pragma unroll
            for (int i = 0; i < 10; ++i) { const float nr = pr * pr - pi * pi, ni = 2.f * pr * pi; pr = nr; pi = ni; }
            xr = 0.f; xi = 0.f;
            for (int w2 = 0; w2 < wave; ++w2) { const float er = ebuf[(w2 * 64 + lane) * 2], ei = ebuf[(w2 * 64 + lane) * 2 + 1];
                const float nr = pr * xr - pi * xi + er, ni = pr * xi + pi * xr + ei; xr = nr; xi = ni; }
        }
    }
    __syncthreads();
}
}
#define argp() (*({ CArgs* p_ = (CArgs*)__builtin_amdgcn_kernarg_segment_ptr(); asm volatile("" : "+s"(p_)); p_; }))
#define tidp() ({ int t_ = (wave << 6) + (int)__builtin_amdgcn_mbcnt_hi(~0u, __builtin_amdgcn_mbcnt_lo(~0u, 0u)); asm volatile("" : "+v"(t_)); t_; })
#define GRID_BAR() do { XcdBarrier b_ = bar; asm volatile("" : "+s"(b_.bar), "+s"(b_.x)); xcd_barrier(b_, tidp()); } while (0)
#ifndef S5_REP
#define S5_REP 1
#endif
#ifndef ATT_REP
#define ATT_REP 1
#endif
#ifndef SEG_ON
#define SEG_ON 1
#endif
#define GEMM_PHASE(EPI, g, S, E) pg8::gemm_phase<EPI, pg8::StaticOrder, PG8_ALIGN, PG8_SP2>(lds + RING_OFF, g, S, E, tidp())

__global__ void __launch_bounds__(NWAVES * 64, 2) hybrid_fwd(Args args) {
    extern __shared__ __attribute__((aligned(16))) unsigned char lds_raw[];
    LAS unsigned char* lds = (LAS unsigned char*)lds_raw;
    const int wave = __builtin_amdgcn_readfirstlane((int)threadIdx.x >> 6);
    const int G = gridDim.x, bx = blockIdx.x;
    const int vcu = (G % 8 == 0) ? (bx % 8) * (G / 8) + bx / 8 : bx;
    const int gw = vcu * NWAVES + wave, NGW = G * NWAVES;
    for (int u = threadIdx.x; u < (LDS_BYTES - LDSCTL_OFF) / 4; u += NWAVES * 64) ((LAS unsigned*)(lds + LDSCTL_OFF))[u] = 0u;
    __syncthreads();
    volatile LAS unsigned* MISC = (volatile LAS unsigned*)(lds + MISC_OFF);
    XcdBarrier bar = xcd_barrier_post((unsigned*)(argp().ws + WS_CTL) + CW_BAR, MISC + 8);

    p0_weights(argp(), lds, gw, NGW, wave, tidp() & 63);
    __syncthreads();
    { const int t = tidp(); phase_norm0(argp(), lds, gw, NGW, t, t & 63); }
    GRID_BAR();

    for (int l = 0; l < LAYERS; ++l) {
        { unsigned char* ws = argp().ws; unsigned char* wl = ws + WS_W + (size_t)l * W_LAYER;
          pg8::Gemm g{(const pg8::bf16_t*)(ws + WS_X16), (const pg8::bf16_t*)(wl + W_IN), M, NPROJ, D}; pg8::StaticOrder S; S.init(M, NPROJ, G, bx);
          pg8::EpiStoreBf16 E{(pg8::bf16_t*)(ws + WS_PROJ), NPROJ, (const float*)(ws + WS_RS)};
          GEMM_PHASE(pg8::EpiStoreBf16, g, S, E); }
        GRID_BAR();
        phase_cum_knorm(argp(), gw, NGW, tidp() & 63);
        for (int rep_ = 0; rep_ < S5_REP; ++rep_)
        for (int u = vcu; u < BATCH * NG; u += G) s5::s5_unit(argp(), lds, l, u >> 7, u & 127, wave, tidp() & 63);
#ifdef S5_TRIPLE
        for (int u = vcu; u < BATCH * NG; u += G) s5::s5_unit(argp(), lds, l, u >> 7, u & 127, wave, tidp() & 63);
        for (int u = vcu; u < BATCH * NG; u += G) s5::s5_unit(argp(), lds, l, u >> 7, u & 127, wave, tidp() & 63);
#endif
        for (int rep_ = 0; rep_ < ATT_REP; ++rep_)
        for (int u = vcu; u < 256; u += G) { const int bh = u >> 4, x = u & 15;
            for (int k = 0; k < 2; ++k) { const int t = tidp(); att::attn_unit<0>(argp(), lds, l, bh >> 3, bh & 7, k ? x + 16 : x, t, wave, t & 63); } }
        GRID_BAR();
        for (int rep_ = 0; rep_ < ATT_REP; ++rep_)
        for (int u = vcu; u < 256; u += G) { const int bh = u >> 4, x = u & 15;
            for (int k = 0; k < 2; ++k) { const int t = tidp(); att::attn_unit<1>(argp(), lds, l, bh >> 3, bh & 7, k ? 31 - x : x, t, wave, t & 63); } }
        { CArgs& A_ = argp(); unsigned char* ws = A_.ws; unsigned char* wl = ws + WS_W + (size_t)l * W_LAYER;
          pg8::Gemm g{(const pg8::bf16_t*)(ws + WS_YG), (const pg8::bf16_t*)(wl + W_GLU), M, SSMW, SSMW}; pg8::StaticOrder S; S.init(M, SSMW, G, bx);
          pg8::EpiGlu E{(const pg8::bf16_t*)(ws + WS_YG), SSMW, (pg8::bf16_t*)(ws + WS_O) + 2048, D, A_.in[17] + (size_t)l * SSMW, (float*)(ws + WS_PSC), M};
          GEMM_PHASE(pg8::EpiGlu, g, S, E); }
        GRID_BAR();
        if (G == 256 && SEG_ON) {
            const int pm_own = 8 * (bx % 8) + (bx / 8) % 8;
            build_seg(argp(), lds, pm_own, tidp());
            unsigned char* ws = argp().ws; unsigned char* wl = ws + WS_W + (size_t)l * W_LAYER;
            pg8::Gemm g{(const pg8::bf16_t*)(ws + WS_O), (const pg8::bf16_t*)(wl + W_OUT), M, D, D}; pg8::StaticOrder S; S.init(M, D, G, bx);
            pg8::EpiStoreBf16 E{(pg8::bf16_t*)(ws + WS_Y16), D, nullptr, (const LAS float*)(lds + SEG_OFF)};
            pg8::gemm_phase<pg8::EpiStoreBf16, pg8::StaticOrder, PG8_ALIGN, PG8_SP2, true>(lds + RING_OFF, g, S, E, tidp(), (const LAS float*)(lds + SEG_OFF));
        } else {
            phase_mixnorm(argp(), gw, NGW, tidp() & 63);
            GRID_BAR();
            unsigned char* ws = argp().ws; unsigned char* wl = ws + WS_W + (size_t)l * W_LAYER;
            pg8::Gemm g{(const pg8::bf16_t*)(ws + WS_O), (const pg8::bf16_t*)(wl + W_OUT), M, D, D}; pg8::StaticOrder S; S.init(M, D, G, bx);
            pg8::EpiStoreBf16 E{(pg8::bf16_t*)(ws + WS_Y16), D, nullptr};
            GEMM_PHASE(pg8::EpiStoreBf16, g, S, E);
        }
        GRID_BAR();
        { CArgs& A_ = argp(); phase_post<false, false, false>(A_, lds, A_.in[4] + (size_t)l * D, 0, gw, NGW, tidp(), tidp() & 63); }
        GRID_BAR();
        { unsigned char* ws = argp().ws; unsigned char* wl = ws + WS_W + (size_t)l * W_LAYER;
          pg8::Gemm g{(const pg8::bf16_t*)(ws + WS_X16), (const pg8::bf16_t*)(wl + W_GU), M, NGU, D}; pg8::StaticOrder S; S.init(M, NGU, G, bx);
          pg8::EpiSwiGlu E{(pg8::bf16_t*)(ws + WS_ACT), DFF, (const float*)(ws + WS_RS)};
          GEMM_PHASE(pg8::EpiSwiGlu, g, S, E); }
        GRID_BAR();
        { unsigned char* ws = argp().ws; unsigned char* wl = ws + WS_W + (size_t)l * W_LAYER;
          pg8::Gemm g{(const pg8::bf16_t*)(ws + WS_ACT), (const pg8::bf16_t*)(wl + W_D), M, D, DFF}; pg8::StaticOrder S; S.init(M, D, G, bx);
          pg8::EpiStoreBf16 E{(pg8::bf16_t*)(ws + WS_Y16), D, nullptr};
          GEMM_PHASE(pg8::EpiStoreBf16, g, S, E); }
        GRID_BAR();
        if (l + 1 < LAYERS) { CArgs& A_ = argp(); phase_post<false, false, true>(A_, lds, A_.in[19] + (size_t)l * D, l + 1, gw, NGW, tidp(), tidp() & 63); GRID_BAR(); }
        else { CArgs& A_ = argp(); phase_post<false, true, false>(A_, lds, A_.in[19] + (size_t)l * D, 0, gw, NGW, tidp(), tidp() & 63); }
    }
}

extern "C" void kernel_launch(void* const* d_in, const int* in_sizes, int n_in, void* d_out, int out_size, void* d_ws, size_t ws_size, hipStream_t stream) {
    static int grid = 0;
    if (grid == 0) {
        if (n_in != 23 || in_sizes[0] != M * D || out_size != M * D || ws_size < WS_END) {
            fprintf(stderr, "kernel_launch: unexpected shapes: n_in %d in0 %d out %d ws %zu (need %zu)\n", n_in, n_in > 0 ? in_sizes[0] : -1, out_size, ws_size, (size_t)WS_END); grid = -1; return; }
        int dev = 0, cus = 0, per_cu = 0;
        if (hipGetDevice(&dev) != hipSuccess || hipDeviceGetAttribute(&cus, hipDeviceAttributeMultiprocessorCount, dev) != hipSuccess) { grid = -1; return; }
        if (hipFuncSetAttribute((const void*)hybrid_fwd, hipFuncAttributeMaxDynamicSharedMemorySize, LDS_BYTES) != hipSuccess) { fprintf(stderr, "kernel_launch: hipFuncSetAttribute failed\n"); grid = -1; return; }
        if (hipOccupancyMaxActiveBlocksPerMultiprocessor(&per_cu, (const void*)hybrid_fwd, NWAVES * 64, LDS_BYTES) != hipSuccess || per_cu < 1)
            fprintf(stderr, "kernel_launch: occupancy query reports %d workgroups per CU\n", per_cu);
        (void)hipGetLastError();
        grid = cus;
    }
    if (grid < 0) return;
    if (hipMemsetAsync((char*)d_ws + WS_CTL, 0, CTL_ZERO_BYTES, stream) != hipSuccess) return;
    Args a{};
    for (int i = 0; i < 23; ++i) a.in[i] = (const float*)d_in[i];
    a.out = (float*)d_out; a.ws = (unsigned char*)d_ws;
    hipLaunchKernelGGL(hybrid_fwd, dim3(grid), dim3(NWAVES * 64), LDS_BYTES, stream, a);
    const hipError_t le = hipPeekAtLastError();
    if (le != hipSuccess) fprintf(stderr, "kernel_launch: launch failed: %s\n", hipGetErrorName(le));
}
```

```cpp
#include <hip/hip_runtime.h>
#include <cstdio>
#include <cstdint>
#ifndef PS_C
#define PS_C 1
#endif
#ifndef PS_AB
#define PS_AB 1
#endif
namespace pg8 {
#define PG8_LAS __attribute__((address_space(3)))
typedef unsigned short bf16_t;
typedef short bf16x8 __attribute__((ext_vector_type(8)));
typedef float f32x4 __attribute__((ext_vector_type(4)));
typedef unsigned u32x4 __attribute__((ext_vector_type(4)));
constexpr int BM = 256, BK = 64, HALF = 128, HTB = HALF * BK * 2  , STAGE_BYTES = 8 * HTB, NXCD = 8, WGM = 8;

__host__ __device__ __forceinline__ int lds_byte(int r, int c) { const int st = (r >> 4) * 2 + (c >> 5), rr = r & 15, cc = c & 31, ob = rr * 64 + cc * 2; return st * 1024 + (ob ^ (((ob >> 9) & 1) << 5)); }
__host__ __device__ __forceinline__ void stage_rc(int b, int& R, int& C) { const int st = b / 1024, sb = b % 1024, swz = sb ^ (((sb >> 9) & 1) << 5); R = (st >> 1) * 16 + swz / 64; C = (st & 1) * 32 + (swz % 64) / 2; }
__host__ __device__ __forceinline__ int perm32(int rho) { const int n = rho >> 4, i = rho & 15; return 8 * (i >> 2) + 4 * n + (i & 3); }

struct Unit { int pm, pn; };
struct Gemm { const bf16_t* A; const bf16_t* Bt; int M, N, K; };

struct StaticOrder {
    int nM, nN, nwg, G, c;
    __host__ __device__ void init(int M, int N, int G_, int c_) { nM = M / BM; nN = N / BM; nwg = nM * nN; G = G_; c = c_; }
    __host__ __device__ bool next(int i, Unit& u) const {
        const long L = (long)i * G + c; if (L >= nwg) return false;
        int wgid = (int)L; { const int q = nwg / NXCD, r = nwg % NXCD, xcd = wgid % NXCD, off = wgid / NXCD; wgid = (xcd < r ? xcd * (q + 1) : r * (q + 1) + (xcd - r) * q) + off; }
        const int nig = WGM * nN, gid = wgid / nig, fm = gid * WGM, gsz = (nM - fm) < WGM ? (nM - fm) : WGM;
        u.pm = fm + ((wgid % nig) % gsz); u.pn = (wgid % nig) / gsz; return true;
    }
    __device__ __forceinline__ void a_ready(const Unit&) const {}
    __device__ __forceinline__ void done(const Unit&) const {}
};

__device__ __forceinline__ unsigned cvt_pk_bf16(float lo, float hi) { unsigned r; asm volatile("v_cvt_pk_bf16_f32 %0, %1, %2" : "=v"(r) : "v"(lo), "v"(hi)); return r; }
typedef unsigned u32x2 __attribute__((ext_vector_type(2)));
__device__ __forceinline__ float sigm(float z) { return __builtin_amdgcn_rcpf(1.0f + __builtin_amdgcn_exp2f(-1.4426950408889634f * z)); }
__device__ __forceinline__ float bflo(unsigned w) { return __builtin_bit_cast(float, w << 16); }
__device__ __forceinline__ float bfhi(unsigned w) { return __builtin_bit_cast(float, w & 0xffff0000u); }
struct EpiStoreBf16 {
    static constexpr bool PERM = true, AFTER_DRAIN = false;
    bf16_t* O; int ldc; const float* rs;
    const PG8_LAS float* rsl = nullptr;
    __device__ __forceinline__ void operator()(const f32x4 (&acc)[2][2][4][2], const Unit& u, int wr, int wc, int fr, int fq) const {
        const int row0 = u.pm * BM + wr * 64 + fr, col0 = u.pn * BM + wc * 32 + 8 * fq;
#pragma unroll
        for (int ai = 0; ai < 2; ++ai)
#pragma unroll
            for (int m = 0; m < 4; ++m) { bf16_t* rowp = O + (size_t)(row0 + ai * HALF + m * 16) * ldc + col0; const float sc = rsl ? rsl[(wr * 64 + fr + ai * HALF + m * 16) * 3 + 2] : (rs ? rs[row0 + ai * HALF + m * 16] : 1.0f);
#pragma unroll
                for (int bj = 0; bj < 2; ++bj) { const f32x4 v0 = acc[ai][bj][m][0] * sc, v1 = acc[ai][bj][m][1] * sc;
                    u32x4 w; w.x = cvt_pk_bf16(v0[0], v0[1]); w.y = cvt_pk_bf16(v0[2], v0[3]); w.z = cvt_pk_bf16(v1[0], v1[1]); w.w = cvt_pk_bf16(v1[2], v1[3]);
                    *(u32x4*)(rowp + bj * HALF) = w; } }
    }
};
struct EpiStoreF32 {
    static constexpr bool PERM = false, AFTER_DRAIN = false;
    float* C; int ldc;
    __device__ __forceinline__ void operator()(const f32x4 (&acc)[2][2][4][2], const Unit& u, int wr, int wc, int fr, int fq) const {
        const int row0 = u.pm * BM + wr * 64 + fr, col0 = u.pn * BM + wc * 32 + 4 * fq;
#pragma unroll
        for (int ai = 0; ai < 2; ++ai)
#pragma unroll
            for (int m = 0; m < 4; ++m) { float* rowp = C + (size_t)(row0 + ai * HALF + m * 16) * ldc + col0;
#pragma unroll
                for (int bj = 0; bj < 2; ++bj)
#pragma unroll
                    for (int n = 0; n < 2; ++n) *(f32x4*)(rowp + bj * HALF + n * 16) = acc[ai][bj][m][n]; }
    }
};
struct EpiGlu {
    static constexpr bool PERM = true, AFTER_DRAIN = false;
    const bf16_t* Y; int ldy; bf16_t* O; int ldo; const float* bias; float* ps; int g_M;
    __device__ __forceinline__ void operator()(const f32x4 (&acc)[2][2][4][2], const Unit& u, int wr, int wc, int fr, int fq) const {
        const int row0 = u.pm * BM + wr * 64 + fr, col0 = u.pn * BM + wc * 32 + 8 * fq;
        f32x4 bv[2][2];
#pragma unroll
        for (int bj = 0; bj < 2; ++bj)
#pragma unroll
            for (int n = 0; n < 2; ++n) bv[bj][n] = *(const f32x4*)(bias + col0 + bj * HALF + 4 * n);
#pragma unroll
        for (int ai = 0; ai < 2; ++ai)
#pragma unroll
            for (int m = 0; m < 4; ++m) { const size_t r = (size_t)(row0 + ai * HALF + m * 16); float ss = 0.f;
#pragma unroll
                for (int bj = 0; bj < 2; ++bj) { const u32x4 yv = *(const u32x4*)(Y + r * ldy + col0 + bj * HALF);
                    const f32x4 z0 = acc[ai][bj][m][0] + bv[bj][0], z1 = acc[ai][bj][m][1] + bv[bj][1];
                    const float o0 = bflo(yv.x) * sigm(z0[0]), o1 = bfhi(yv.x) * sigm(z0[1]), o2 = bflo(yv.y) * sigm(z0[2]), o3 = bfhi(yv.y) * sigm(z0[3]);
                    const float o4 = bflo(yv.z) * sigm(z1[0]), o5 = bfhi(yv.z) * sigm(z1[1]), o6 = bflo(yv.w) * sigm(z1[2]), o7 = bfhi(yv.w) * sigm(z1[3]);
                    ss += ((o0 * o0 + o1 * o1) + (o2 * o2 + o3 * o3)) + ((o4 * o4 + o5 * o5) + (o6 * o6 + o7 * o7));
                    u32x4 w; w.x = cvt_pk_bf16(o0, o1); w.y = cvt_pk_bf16(o2, o3); w.z = cvt_pk_bf16(o4, o5); w.w = cvt_pk_bf16(o6, o7);
                    *(u32x4*)(O + r * ldo + col0 + bj * HALF) = w; }
                ps[((size_t)u.pn * g_M + r) * 16 + wc * 4 + fq] = ss; }
    }
};
struct EpiSwiGlu {
    static constexpr bool PERM = true, AFTER_DRAIN = false;
    bf16_t* O; int ldc; const float* rs;
    __device__ __forceinline__ void operator()(const f32x4 (&acc)[2][2][4][2], const Unit& u, int wr, int wc, int fr, int fq) const {
        const int row0 = u.pm * BM + wr * 64 + fr, col0 = u.pn * HALF + wc * 32 + 8 * fq;
#pragma unroll
        for (int ai = 0; ai < 2; ++ai)
#pragma unroll
            for (int m = 0; m < 4; ++m) { bf16_t* rowp = O + (size_t)(row0 + ai * HALF + m * 16) * ldc + col0; const float sc = rs[row0 + ai * HALF + m * 16];
                const f32x4 g0 = acc[ai][0][m][0] * sc, g1 = acc[ai][0][m][1] * sc, u0 = acc[ai][1][m][0] * sc, u1 = acc[ai][1][m][1] * sc;
                u32x4 w;
                w.x = cvt_pk_bf16(g0[0] * sigm(g0[0]) * u0[0], g0[1] * sigm(g0[1]) * u0[1]); w.y = cvt_pk_bf16(g0[2] * sigm(g0[2]) * u0[2], g0[3] * sigm(g0[3]) * u0[3]);
                w.z = cvt_pk_bf16(g1[0] * sigm(g1[0]) * u1[0], g1[1] * sigm(g1[1]) * u1[1]); w.w = cvt_pk_bf16(g1[2] * sigm(g1[2]) * u1[2], g1[3] * sigm(g1[3]) * u1[3]);
                *(u32x4*)rowp = w; }
    }
};
template <class Epi, class Sched, bool ALIGN_EPI = false, bool SP2 = false, bool SEG = false>
__device__ __forceinline__ void gemm_phase(PG8_LAS unsigned char* lds, const Gemm g, const Sched& S, const Epi& E, const int tid, const PG8_LAS float* seg = nullptr) {
    const int wid = __builtin_amdgcn_readfirstlane(tid >> 6), lane = tid & 63, wr = wid >> 2, wc = wid & 3, fr = lane & 15, fq = lane >> 4;
    const int K = g.K, nt = K / BK;
    unsigned voffA[2], voffB[2];
#pragma unroll
    for (int i = 0; i < 2; ++i) { int R, C; stage_rc(tid * 16 + i * 8192, R, C); const int Rb = Epi::PERM ? ((R & ~31) + perm32(R & 31)) : R;
        voffA[i] = (unsigned)(R * K + C) * 2u; voffB[i] = (unsigned)(Rb * K + C) * 2u; }
    const size_t kstep = (size_t)(BK * 2);
    const size_t hstep = (size_t)HALF * K * 2;
    const size_t tstep = 2 * hstep;
    const unsigned ldsw = (unsigned)wid * 1024u;
    const int aoff = lds_byte(wr * 64 + fr, fq * 8), boff = lds_byte(wc * 32 + fr, fq * 8);
#define PG8_SA(b, h) (((b) * 2 + (h)) * HTB)
#define PG8_SB(b, h) ((4 + (b) * 2 + (h)) * HTB)
#define PG8_STAGE(bufoff, gbase, voff) do { _Pragma("unroll") for (int _i = 0; _i < 2; ++_i) \
        __builtin_amdgcn_global_load_lds((const unsigned*)((const char*)(gbase) + (voff)[_i]), (PG8_LAS unsigned*)(lds + (bufoff) + ldsw + _i * 8192), 16, 0, 0); } while (0)
#define PG8_LDA(dst, b, h) do { _Pragma("unroll") for (int m = 0; m < 4; ++m) _Pragma("unroll") for (int k = 0; k < 2; ++k) dst[m][k] = *(const PG8_LAS bf16x8*)(lds + PG8_SA(b, h) + aoff + m * 2048 + k * 1024); } while (0)
#define PG8_LDB(dst, b, h) do { _Pragma("unroll") for (int n = 0; n < 2; ++n) _Pragma("unroll") for (int k = 0; k < 2; ++k) dst[n][k] = *(const PG8_LAS bf16x8*)(lds + PG8_SB(b, h) + boff + n * 2048 + k * 1024); } while (0)
#define PG8_MMA(ai, bj, At, Bt) do { __builtin_amdgcn_s_setprio(1); _Pragma("unroll") for (int m = 0; m < 4; ++m) _Pragma("unroll") for (int n = 0; n < 2; ++n) _Pragma("unroll") for (int k = 0; k < 2; ++k) \
        acc[ai][bj][m][n] = __builtin_amdgcn_mfma_f32_16x16x32_bf16(Bt[n][k], At[m][k], acc[ai][bj][m][n], 0, 0, 0); __builtin_amdgcn_s_setprio(0); } while (0)
#define PG8_WAIT_V(n) asm volatile("s_waitcnt vmcnt(" #n ")" ::: "memory")
#define PG8_WAIT_L(n) asm volatile("s_waitcnt lgkmcnt(" #n ")" ::: "memory")
#define PG8_BAR __builtin_amdgcn_s_barrier()
#define PG8_SCHED __builtin_amdgcn_sched_barrier(0)
    Unit cur, nxt; int ui = 0;
    if (!S.next(0, cur)) return;
    f32x4 acc[2][2][4][2];
#pragma unroll
    for (int a = 0; a < 2; ++a)
#pragma unroll
        for (int b = 0; b < 2; ++b)
#pragma unroll
            for (int m = 0; m < 4; ++m)
#pragma unroll
                for (int n = 0; n < 2; ++n) acc[a][b][m][n] = (f32x4){0.f, 0.f, 0.f, 0.f};
    bf16x8 At[4][2], B0[2][2], B1[2][2];
    const char* cA = (const char*)g.A + (size_t)cur.pm * tstep; const char* cB = (const char*)g.Bt + (size_t)cur.pn * tstep;
    S.a_ready(cur);
    if constexpr (SP2) {
        PG8_STAGE(PG8_SB(0, 0), cB, voffB); PG8_STAGE(PG8_SB(0, 1), cB + hstep, voffB); PG8_STAGE(PG8_SA(0, 0), cA, voffA); PG8_STAGE(PG8_SA(0, 1), cA + hstep, voffA);
        if (wr == 1) PG8_BAR;
        PG8_WAIT_V(2); PG8_BAR;
        PG8_STAGE(PG8_SB(1, 0), cB + kstep, voffB); PG8_STAGE(PG8_SA(1, 0), cA + kstep, voffA); PG8_STAGE(PG8_SB(1, 1), cB + hstep + kstep, voffB);
        PG8_WAIT_V(6); PG8_BAR;
    } else {
        PG8_STAGE(PG8_SB(0, 0), cB, voffB); PG8_STAGE(PG8_SA(0, 0), cA, voffA); PG8_STAGE(PG8_SB(0, 1), cB + hstep, voffB); PG8_STAGE(PG8_SA(0, 1), cA + hstep, voffA);
        if (wr == 1) PG8_BAR;
        PG8_WAIT_V(4); PG8_BAR;
        PG8_STAGE(PG8_SB(1, 0), cB + kstep, voffB); PG8_STAGE(PG8_SA(1, 0), cA + kstep, voffA); PG8_STAGE(PG8_SB(1, 1), cB + hstep + kstep, voffB);
        PG8_WAIT_V(6); PG8_BAR;
    }
    for (;;) {
        const bool has_next = S.next(ui + 1, nxt);
        const char* nA = has_next ? (const char*)g.A + (size_t)nxt.pm * tstep : cA; const char* nB = has_next ? (const char*)g.Bt + (size_t)nxt.pn * tstep : cB;
        for (int t = 0; t < nt; t += 2) {
            if (SEG && (t == 16 || t == 32)) {
                const int which = t == 16 ? 0 : 1;
#pragma unroll
                for (int ai = 0; ai < 2; ++ai)
#pragma unroll
                    for (int m = 0; m < 4; ++m) { const float f = seg[(ai * HALF + wr * 64 + m * 16 + fr) * 3 + which];
#pragma unroll
                        for (int bj = 0; bj < 2; ++bj)
#pragma unroll
                            for (int n = 0; n < 2; ++n) acc[ai][bj][m][n] *= f; }
            }
            const bool last = (t == nt - 2);
            const char* a1 = cA + (size_t)(t + 1) * kstep;
            const char* a2 = last ? nA : cA + (size_t)(t + 2) * kstep; const char* b2 = last ? nB : cB + (size_t)(t + 2) * kstep;
            const char* a3 = a2 + kstep; const char* b3 = b2 + kstep;
            if (last && has_next) S.a_ready(nxt);
            if constexpr (SP2) {
            PG8_LDB(B0, 0, 0); PG8_LDB(B1, 0, 1); PG8_SCHED; PG8_LDA(At, 0, 0); PG8_STAGE(PG8_SA(1, 1), a1 + hstep, voffA);
            PG8_WAIT_V(8); PG8_WAIT_L(0); PG8_BAR; PG8_MMA(0, 0, At, B0); PG8_MMA(0, 1, At, B1); PG8_BAR; PG8_SCHED;
            PG8_LDA(At, 0, 1); PG8_STAGE(PG8_SB(0, 0), b2, voffB); PG8_STAGE(PG8_SB(0, 1), b2 + hstep, voffB); PG8_STAGE(PG8_SA(0, 0), a2, voffA);
            PG8_WAIT_V(8); PG8_WAIT_L(0); PG8_BAR; PG8_MMA(1, 0, At, B0); PG8_MMA(1, 1, At, B1); PG8_BAR; PG8_SCHED;
            PG8_LDB(B0, 1, 0); PG8_LDB(B1, 1, 1); PG8_SCHED; PG8_LDA(At, 1, 0); PG8_STAGE(PG8_SA(0, 1), a2 + hstep, voffA);
            PG8_WAIT_V(8); PG8_WAIT_L(0); PG8_BAR; PG8_MMA(0, 0, At, B0); PG8_MMA(0, 1, At, B1); PG8_BAR; PG8_SCHED;
            PG8_LDA(At, 1, 1); PG8_STAGE(PG8_SB(1, 0), b3, voffB); PG8_STAGE(PG8_SB(1, 1), b3 + hstep, voffB); PG8_STAGE(PG8_SA(1, 0), a3, voffA);
            PG8_WAIT_V(8); PG8_WAIT_L(0); PG8_BAR; PG8_MMA(1, 0, At, B0); PG8_MMA(1, 1, At, B1); PG8_BAR; PG8_SCHED;
            } else {
            PG8_LDB(B0, 0, 0); PG8_SCHED; PG8_LDA(At, 0, 0); PG8_STAGE(PG8_SA(1, 1), a1 + hstep, voffA);
            PG8_WAIT_L(8); PG8_BAR; PG8_WAIT_L(0); PG8_MMA(0, 0, At, B0); PG8_BAR; PG8_SCHED;
            PG8_LDB(B1, 0, 1); PG8_STAGE(PG8_SB(0, 0), b2, voffB);
            PG8_BAR; PG8_WAIT_L(0); PG8_MMA(0, 1, At, B1); PG8_BAR;
            PG8_LDA(At, 0, 1); PG8_STAGE(PG8_SA(0, 0), a2, voffA);
            PG8_BAR; PG8_WAIT_L(0); PG8_MMA(1, 0, At, B0); PG8_BAR; PG8_SCHED;
            PG8_STAGE(PG8_SB(0, 1), b2 + hstep, voffB);
            PG8_WAIT_V(6); PG8_BAR; PG8_MMA(1, 1, At, B1); PG8_BAR;
            PG8_LDB(B0, 1, 0); PG8_SCHED; PG8_LDA(At, 1, 0); PG8_STAGE(PG8_SA(0, 1), a2 + hstep, voffA);
            PG8_WAIT_L(8); PG8_BAR; PG8_WAIT_L(0); PG8_MMA(0, 0, At, B0); PG8_BAR; PG8_SCHED;
            PG8_LDB(B1, 1, 1); PG8_STAGE(PG8_SB(1, 0), b3, voffB);
            PG8_BAR; PG8_WAIT_L(0); PG8_MMA(0, 1, At, B1); PG8_BAR;
            PG8_LDA(At, 1, 1); PG8_STAGE(PG8_SA(1, 0), a3, voffA);
            PG8_BAR; PG8_WAIT_L(0); PG8_MMA(1, 0, At, B0); PG8_BAR; PG8_SCHED;
            PG8_STAGE(PG8_SB(1, 1), b3 + hstep, voffB);
            PG8_WAIT_V(6); PG8_BAR; PG8_MMA(1, 1, At, B1); PG8_BAR;
            }
        }
        if constexpr (ALIGN_EPI) { if (wr == 0) PG8_BAR; }
        if constexpr (!Epi::AFTER_DRAIN) { E(acc, cur, wr, wc, fr, fq); S.done(cur); }
        if (!has_next) break;
#pragma unroll
        for (int a = 0; a < 2; ++a)
#pragma unroll
            for (int b = 0; b < 2; ++b)
#pragma unroll
                for (int m = 0; m < 4; ++m)
#pragma unroll
                    for (int n = 0; n < 2; ++n) acc[a][b][m][n] = (f32x4){0.f, 0.f, 0.f, 0.f};
        cur = nxt; cA = nA; cB = nB; ++ui;
        if constexpr (ALIGN_EPI) { if (wr == 1) PG8_BAR; }
    }
    PG8_WAIT_V(0);
    if constexpr (!ALIGN_EPI) { if (wr == 0) PG8_BAR; }
    PG8_BAR;
    if constexpr (Epi::AFTER_DRAIN) { E.fused(acc, cur, wr, wc, fr, fq, lds, wid, lane); S.done(cur); }
#undef PG8_SA
#undef PG8_SB
#undef PG8_STAGE
#undef PG8_LDA
#undef PG8_LDB
#undef PG8_MMA
#undef PG8_WAIT_V
#undef PG8_WAIT_L
#undef PG8_BAR
#undef PG8_SCHED
}
}
#ifndef PG8_SP2
#define PG8_SP2 true
#endif
#ifndef PG8_ALIGN
#define PG8_ALIGN true
#endif

constexpr int NWAVES = 8;
constexpr int BATCH = 2, SEQ = 8192, M = BATCH * SEQ, D = 4096, INCOLS = 8200, NPROJ = 8192, DFF = 11008, NGU = 2 * DFF;
constexpr int HD = 128, NH = 8, SSMW = 2048, NG = 128, NS = 64, LAYERS = 2;
constexpr int COL_QA = 0, COL_KA = 1024, COL_VA = 2048, COL_QB = 3072, COL_KB = 4096, COL_VB = 5120, COL_U = 6144;
constexpr float RMS_EPS = 1e-6f;
constexpr float LOG2E = 1.4426950408889634f;
constexpr float QK_SCALE = 0.08838834764831845f;

constexpr size_t MiB = 1u << 20;
constexpr size_t WS_CTL = 0, CTL_ZERO_BYTES = 1 * MiB;
constexpr size_t WS_LS = 3 * MiB;
constexpr size_t WS_CUM = 4 * MiB;
constexpr size_t WS_RS = 6 * MiB;
constexpr size_t WS_PSA = 7 * MiB, WS_PSB = 7 * MiB + 512 * 1024, WS_PSC = 8 * MiB;
constexpr size_t WS_KNT = 5 * MiB;
constexpr size_t WS_W = 16 * MiB;
constexpr size_t W_IN = 0, W_GLU = 64 * MiB, W_OUT = 72 * MiB, W_GU = 104 * MiB, W_D = 276 * MiB, W_LAYER = 362 * MiB;
constexpr size_t WS_X16 = WS_W + 2 * W_LAYER;
constexpr size_t WS_PROJ = WS_X16 + 128 * MiB;
constexpr size_t WS_YG = WS_PROJ + 256 * MiB;
constexpr size_t WS_O = WS_YG + 64 * MiB;
constexpr size_t WS_Y16 = WS_O + 128 * MiB;
constexpr size_t WS_ACT = WS_PROJ;
constexpr size_t WS_END = WS_Y16 + 256 * MiB;
static_assert(WS_ACT + (size_t)M * DFF * 2 <= WS_Y16, "ACT overlay");
constexpr int CW_TMO = 0, CW_BAR = 4096;

constexpr int RING_OFF = 0, RING_BYTES = 131072;
constexpr int LDSCTL_OFF = RING_BYTES, MISC_OFF = LDSCTL_OFF + 320;
constexpr int LDS_BYTES = 147456;

#define GAS __attribute__((address_space(1)))
#define LAS __attribute__((address_space(3)))
typedef unsigned short bf16;
typedef unsigned v4u __attribute__((ext_vector_type(4)));
typedef unsigned v2u __attribute__((ext_vector_type(2)));
typedef float f32x4 __attribute__((ext_vector_type(4)));
typedef float f32x8 __attribute__((ext_vector_type(8)));
typedef float f32x16 __attribute__((ext_vector_type(16)));
typedef short bf16x8 __attribute__((ext_vector_type(8)));
typedef __bf16 bfv8 __attribute__((ext_vector_type(8)));
typedef __bf16 bfv4 __attribute__((ext_vector_type(4)));
typedef __bf16 bfv2 __attribute__((ext_vector_type(2)));
typedef GAS unsigned gu32;
#define RLX_AGENT __ATOMIC_RELAXED, __HIP_MEMORY_SCOPE_AGENT
#define MFMA32(a, b, c) __builtin_amdgcn_mfma_f32_32x32x16_bf16((a), (b), (c), 0, 0, 0)

__device__ __forceinline__ bf16x8 cvt8(f32x8 v) { return __builtin_bit_cast(bf16x8, __builtin_convertvector(v, bfv8)); }
__device__ __forceinline__ v2u cvt4(f32x4 v) { return __builtin_bit_cast(v2u, __builtin_convertvector(v, bfv4)); }
__device__ __forceinline__ unsigned cvt2(float a, float b) { typedef float f2 __attribute__((ext_vector_type(2))); f2 v = {a, b}; return __builtin_bit_cast(unsigned, __builtin_convertvector(v, bfv2)); }
__device__ __forceinline__ float bf_lo(unsigned w) { return __builtin_bit_cast(float, w << 16); }
__device__ __forceinline__ float bf_hi(unsigned w) { return __builtin_bit_cast(float, w & 0xffff0000u); }
__device__ __forceinline__ float wave_sum(float v) {
#pragma unroll
    for (int o = 1; o < 64; o <<= 1) v += __shfl_xor(v, o);
    return v;
}
__device__ __forceinline__ int crow(int r, int hi) { return (r & 3) + 8 * (r >> 2) + 4 * hi; }

#define XB_TMO      128
#define XB_XCNT(j)  (256  + 64 * (j))
#define XB_XSUB(j)  (1280 + 64 * (j))
#define XB_XGEN(j)  (2304 + 64 * (j))
#define XB_TOP      3328
#define XB_TOPGEN   3392
#define XCD_BAR_WORDS 3456
#define XB_SPIN_CAP (1u << 18)

__device__ __forceinline__ unsigned xb_ld(unsigned* p)              { return __hip_atomic_load(p, __ATOMIC_RELAXED, __HIP_MEMORY_SCOPE_AGENT); }
__device__ __forceinline__ unsigned xb_add(unsigned* p, unsigned v) { return __hip_atomic_fetch_add(p, v, __ATOMIC_RELAXED, __HIP_MEMORY_SCOPE_AGENT); }
__device__ __forceinline__ unsigned xb_xcc_id() { return (unsigned)__builtin_amdgcn_s_getreg((3 << 11) | 20) & 0xFu; }
#define XB_SPIN(cond, bar) do { unsigned _sp = 0; while (cond) { __builtin_amdgcn_s_sleep(1); \
    if ((++_sp & 255u) == 0u) { if (xb_ld(&(bar)[XB_TMO])) break; if (_sp > XB_SPIN_CAP) { atomicAdd(&(bar)[XB_TMO], 1u); break; } } } } while (0)

struct XcdBarrier {
    unsigned* bar; unsigned x;
    volatile LAS unsigned* st;
};

__device__ __forceinline__ XcdBarrier xcd_barrier_post(unsigned* bar, volatile LAS unsigned* st) {
    XcdBarrier b; b.bar = bar; b.x = xb_xcc_id(); b.st = st;
    if (threadIdx.x == 0) (void)xb_add(&bar[XB_XCNT(b.x)], 1u);
    return b;
}
__device__ __forceinline__ void xcd_barrier_complete(unsigned* bar, unsigned x, unsigned& nloc, unsigned& nx) {
    const unsigned G = gridDim.x * gridDim.y * gridDim.z;
    unsigned sum, cnt, mine, sp = 0u;
    for (;;) {
        sum = 0u; cnt = 0u; mine = 0u;
#pragma unroll
        for (unsigned j = 0; j < 16; ++j) { const unsigned c = xb_ld(&bar[XB_XCNT(j)]); sum += c; cnt += (c > 0u) ? 1u : 0u; mine = (j == x) ? c : mine; }
        if (sum == G) break;
        __builtin_amdgcn_s_sleep(1);
        if ((++sp & 255u) == 0u) { if (xb_ld(&bar[XB_TMO])) break; if (sp > XB_SPIN_CAP) { atomicAdd(&bar[XB_TMO], 1u); break; } }
    }
    nloc = mine > 0u ? mine : 1u; nx = cnt > 0u ? cnt : 1u;
}

__device__ __forceinline__ void xcd_barrier(const XcdBarrier& b, const int tid_) {
    asm volatile("s_waitcnt vmcnt(0)" ::: "memory");
    __syncthreads();
    if (tid_ == 0) {
        unsigned* bar = b.bar;
        __builtin_amdgcn_s_waitcnt(0);
        unsigned nloc = b.st[0], nx = b.st[1];
        if (nloc == 0u) { xcd_barrier_complete(bar, b.x, nloc, nx); b.st[0] = nloc; b.st[1] = nx; }
        const unsigned old = xb_add(&bar[XB_XSUB(b.x)], 1u);
        const unsigned gen = old / nloc;
        if (old + 1u == (gen + 1u) * nloc) {
            __builtin_amdgcn_fence(__ATOMIC_RELEASE, "agent");
            asm volatile("s_waitcnt vmcnt(0)" ::: "memory");
            const unsigned og = xb_add(&bar[XB_TOP], 1u);
            const unsigned tg = og / nx;
            if (og + 1u == (tg + 1u) * nx) xb_add(&bar[XB_TOPGEN], 1u);
            else XB_SPIN(xb_ld(&bar[XB_TOPGEN]) == tg, bar);
            __builtin_amdgcn_fence(__ATOMIC_ACQUIRE, "agent");
            xb_add(&bar[XB_XGEN(b.x)], 1u);
            asm volatile("s_waitcnt vmcnt(0)" ::: "memory");
        } else {
            XB_SPIN(xb_ld(&bar[XB_XGEN(b.x)]) == gen, bar);
            __builtin_amdgcn_fence(__ATOMIC_ACQUIRE, "agent");
            asm volatile("s_waitcnt vmcnt(0)" ::: "memory");
        }
    }
    __syncthreads();
}


__device__ __forceinline__ void p0_item(const float* W, int ld, int col0, int k0, const float* gain, bf16* dst, int dstK, LAS float* scr, int lane) {
    const int kr = lane >> 3, nq = lane & 7;
    f32x4 w[8]; float gn[8];
#pragma unroll
    for (int i = 0; i < 8; ++i) { w[i] = *(const f32x4*)(W + (size_t)(k0 + 8 * i + kr) * ld + col0 + 4 * nq); gn[i] = gain ? gain[k0 + 8 * i + kr] : 1.0f; }
#pragma unroll
    for (int i = 0; i < 8; ++i) { LAS float* d = scr + (8 * i + kr) * 33 + 4 * nq; const f32x4 v = w[i] * gn[i]; d[0] = v.x; d[1] = v.y; d[2] = v.z; d[3] = v.w; }
    asm volatile("s_waitcnt lgkmcnt(0)" ::: "memory");
    const int c = lane & 7;
#pragma unroll
    for (int j = 0; j < 4; ++j) { const int n = (lane >> 3) + 8 * j; const LAS float* s = scr + (8 * c) * 33 + n;
        f32x8 v = {s[0 * 33], s[1 * 33], s[2 * 33], s[3 * 33], s[4 * 33], s[5 * 33], s[6 * 33], s[7 * 33]};
        *(bf16x8*)(dst + (size_t)n * dstK + 8 * c) = cvt8(v); }
    asm volatile("s_waitcnt lgkmcnt(0)" ::: "memory");
}
constexpr int I_IN = (D / 64) * (NPROJ / 32), I_GLU = (SSMW / 64) * (SSMW / 32), I_OUT = (D / 64) * (D / 32), I_GU = (D / 64) * (NGU / 32), I_D = (DFF / 64) * (D / 32);
constexpr int I_LAYER = I_IN + I_GLU + I_OUT + I_GU + I_D;

struct Args { const float* in[23]; float* out; unsigned char* ws; };
typedef const __attribute__((address_space(4))) Args CArgs;

struct P0Tile { const float* src; const float* gain; bf16* dst; };
template <int LD>
__device__ __forceinline__ void p0_load(const P0Tile& t, int lane, f32x4 (&w)[8], float (&gn)[8]) {
    const int kr = lane >> 3, nq = lane & 7;
#pragma unroll
    for (int i = 0; i < 8; ++i) { w[i] = *(const f32x4*)(t.src + (size_t)(8 * i + kr) * LD + 4 * nq); gn[i] = t.gain ? t.gain[8 * i + kr] : 1.0f; }
}
template <int DSTK>
__device__ __forceinline__ void p0_finish(const P0Tile& t, const f32x4 (&w)[8], const float (&gn)[8], LAS float* scr, int lane) {
    const int kr = lane >> 3, nq = lane & 7;
#pragma unroll
    for (int i = 0; i < 8; ++i) { LAS float* d = scr + (8 * i + kr) * 33 + 4 * nq; const f32x4 v = w[i] * gn[i]; d[0] = v.x; d[1] = v.y; d[2] = v.z; d[3] = v.w; }
    asm volatile("s_waitcnt lgkmcnt(0)" ::: "memory");
    const int c = lane & 7;
#pragma unroll
    for (int j = 0; j < 4; ++j) { const int n = (lane >> 3) + 8 * j; const LAS float* s = scr + (8 * c) * 33 + n;
        f32x8 v = {s[0 * 33], s[1 * 33], s[2 * 33], s[3 * 33], s[4 * 33], s[5 * 33], s[6 * 33], s[7 * 33]};
        *(bf16x8*)(t.dst + (size_t)n * DSTK + 8 * c) = cvt8(v); }
    asm volatile("s_waitcnt lgkmcnt(0)" ::: "memory");
}
template <int LD, int DSTK, class Dec>
__device__ __forceinline__ void p0_segment(int first, int NGW, int count, LAS float* scr, int lane, Dec dec) {
    int r = first; if (r >= count) return;
    f32x4 w[8], wn[8]; float gn[8], gnn[8];
    P0Tile t = dec(r); p0_load<LD>(t, lane, w, gn);
    bf16* dcur = t.dst;
#pragma clang loop unroll(disable)
    for (;;) {
        const int rn = r + NGW; const bool more = rn < count; bf16* dnext = dcur;
        if (more) { const P0Tile tn = dec(rn); p0_load<LD>(tn, lane, wn, gnn); dnext = tn.dst; }
        { P0Tile tc; tc.src = nullptr; tc.gain = nullptr; tc.dst = dcur; p0_finish<DSTK>(tc, w, gn, scr, lane); }
        if (!more) break;
#pragma unroll
        for (int i = 0; i < 8; ++i) { w[i] = wn[i]; gn[i] = gnn[i]; }
        dcur = dnext; r = rn;
    }
}
__device__ __forceinline__ void p0_weights(CArgs& a, LAS unsigned char* lds, int gw, int NGW, int wave, int lane) {
    LAS float* scr = (LAS float*)(lds + RING_OFF + wave * 16384);
    for (int l = 0; l < LAYERS; ++l) {
        unsigned char* wl = a.ws + WS_W + (size_t)l * W_LAYER;
        { const float* W = a.in[1] + (size_t)l * D * INCOLS; const float* g = a.in[3] + l * D; bf16* T = (bf16*)(wl + W_IN);
          p0_segment<INCOLS, D>(gw, NGW, I_IN, scr, lane, [=](int r) { const int kb = r / (NPROJ / 32), n0 = 32 * (r % (NPROJ / 32));
              return P0Tile{W + (size_t)(64 * kb) * INCOLS + n0 + (n0 >= COL_U ? 8 : 0), g + 64 * kb, T + (size_t)n0 * D + 64 * kb}; }); }
        { const float* W = a.in[16] + (size_t)l * SSMW * SSMW; bf16* T = (bf16*)(wl + W_GLU);
          p0_segment<SSMW, SSMW>(gw, NGW, I_GLU, scr, lane, [=](int r) { const int kb = r / (SSMW / 32), n0 = 32 * (r % (SSMW / 32));
              return P0Tile{W + (size_t)(64 * kb) * SSMW + n0, nullptr, T + (size_t)n0 * SSMW + 64 * kb}; }); }
        { const float* W = a.in[2] + (size_t)l * D * D; const float* g = a.in[5] + l * D; bf16* T = (bf16*)(wl + W_OUT);
          p0_segment<D, D>(gw, NGW, I_OUT, scr, lane, [=](int r) { const int kb = r / (D / 32), n0 = 32 * (r % (D / 32));
              return P0Tile{W + (size_t)(64 * kb) * D + n0, g + 64 * kb, T + (size_t)n0 * D + 64 * kb}; }); }
        { CArgs* pa = &a; const float* g = a.in[18] + l * D; bf16* T = (bf16*)(wl + W_GU);
          p0_segment<DFF, D>(gw, NGW, I_GU, scr, lane, [=](int r) { const int kb = r / (NGU / 32), n0 = 32 * (r % (NGU / 32)), tile = n0 >> 8, within = n0 & 255;
              return P0Tile{pa->in[20 + (within >> 7)] + (size_t)l * D * DFF + (size_t)(64 * kb) * DFF + 128 * tile + (within & 127), g + 64 * kb, T + (size_t)n0 * D + 64 * kb}; }); }
        { const float* W = a.in[22] + (size_t)l * DFF * D; bf16* T = (bf16*)(wl + W_D);
          p0_segment<D, DFF>((gw + NGW / 2) % NGW, NGW, I_D, scr, lane, [=](int r) { const int kb = r / (D / 32), n0 = 32 * (r % (D / 32));
              return P0Tile{W + (size_t)(64 * kb) * D + n0, nullptr, T + (size_t)n0 * DFF + 64 * kb}; }); }
    }
}

__device__ __forceinline__ void load_row(const float* p, int lane, f32x4 (&v)[16]) {
    const f32x4* q = (const f32x4*)p + lane;
#pragma unroll
    for (int j = 0; j < 16; ++j) v[j] = q[64 * j];
}
__device__ __forceinline__ float row_sumsq(const f32x4 (&v)[16]) {
    float s = 0.f;
#pragma unroll
    for (int j = 0; j < 16; ++j) s += (v[j].x * v[j].x + v[j].y * v[j].y) + (v[j].z * v[j].z + v[j].w * v[j].w);
    return wave_sum(s);
}
__device__ __forceinline__ void store_h(bf16* hrow, int lane, const f32x4 (&v)[16], float rstd) {
    v2u* o = (v2u*)hrow + lane;
#pragma unroll
    for (int j = 0; j < 16; ++j) o[64 * j] = cvt4(v[j] * rstd);
}
__device__ __forceinline__ void build_wfb(LAS float* wfb, const float* w_in_l, const float* g, int tid) {
#pragma unroll 1
    for (int base = tid; base < 8 * D; base += 16 * NWAVES * 64) {
        float w[16], gg[16];
#pragma unroll
        for (int i = 0; i < 16; ++i) { const int idx = base + i * NWAVES * 64, k = idx >> 3, hh = idx & 7; w[i] = w_in_l[(size_t)k * INCOLS + COL_U + hh]; gg[i] = g[k]; }
#pragma unroll
        for (int i = 0; i < 16; ++i) { const int idx = base + i * NWAVES * 64, k = idx >> 3, hh = idx & 7; wfb[hh * D + k] = gg[i] * w[i]; }
    }
}
__device__ __forceinline__ void fb_accum(const f32x4 vj, int j, const LAS float* wfb, int lane, float (&acc)[8]) {
#pragma unroll
    for (int hh = 0; hh < 8; ++hh) { const LAS float* base = wfb + 4 * lane + (hh < 4 ? 0 : 4 * D);
        const f32x4 w = *(const LAS f32x4*)(base + (hh & 3) * D + 256 * j); acc[hh] += (vj.x * w.x + vj.y * w.y) + (vj.z * w.z + vj.w * w.w); }
}
__device__ __forceinline__ void fb_finish(const float (&acc)[8], float rstd, const float* bfg, float* LS, int m, int lane) {
    float mine = 0.f;
#pragma unroll
    for (int hh = 0; hh < 8; ++hh) { const float s = wave_sum(acc[hh]); mine = (lane == hh) ? s : mine; }
    if (lane < 8) { const float z = mine * rstd + bfg[lane];
        const float ls = fminf(z, 0.f) - 0.6931471805599453f * __builtin_amdgcn_logf(1.0f + __builtin_amdgcn_exp2f(-fabsf(z) * LOG2E));
        const int b = m / SEQ, s = m - b * SEQ; LS[(size_t)(b * NH + lane) * SEQ + s] = ls; }
}
__device__ __forceinline__ void fb_emit(const f32x4 (&v)[16], float rstd, const LAS float* wfb, const float* bfg, float* LS, int m, int lane) {
    float acc[8];
#pragma unroll
    for (int hh = 0; hh < 8; ++hh) acc[hh] = 0.f;
#pragma unroll
    for (int j = 0; j < 16; ++j) { fb_accum(v[j], j, wfb, lane, acc);
        asm volatile("" ::: "memory"); }
    fb_finish(acc, rstd, bfg, LS, m, lane);
}
__device__ __forceinline__ void phase_norm0(CArgs& a, LAS unsigned char* lds, int gw, int NGW, int tid, int lane) {
    LAS float* wfb = (LAS float*)(lds + RING_OFF);
    build_wfb(wfb, a.in[1], a.in[3], tid);
    __syncthreads();
    bf16* X = (bf16*)(a.ws + WS_X16); float* LS = (float*)(a.ws + WS_LS); float* RS = (float*)(a.ws + WS_RS);
    f32x4 v[16], vn[16];
    int m = gw;
    if (m < M) load_row(a.in[0] + (size_t)m * D, lane, v);
    while (m < M) {
        const int mn = m + NGW;
        if (mn < M) load_row(a.in[0] + (size_t)mn * D, lane, vn);
        const float rstd = 1.0f / sqrtf(row_sumsq(v) * (1.0f / D) + RMS_EPS);
        store_h(X + (size_t)m * D, lane, v, 1.0f);
        if (lane == 0) RS[m] = rstd;
        fb_emit(v, rstd, wfb, a.in[7], LS, m, lane);
#pragma unroll
        for (int j = 0; j < 16; ++j) v[j] = vn[j];
        m = mn;
    }
    __syncthreads();
}
__device__ __forceinline__ void load_row_bf16(const bf16* p, int lane, f32x4 (&y)[16]) {
    const v2u* yq = (const v2u*)p + lane; v2u yw[16];
#pragma unroll
    for (int j = 0; j < 16; ++j) yw[j] = yq[64 * j];
#pragma unroll
    for (int j = 0; j < 16; ++j) { const unsigned w0 = yw[j].x, w1 = yw[j].y; y[j] = (f32x4){bf_lo(w0), bf_hi(w0), bf_lo(w1), bf_hi(w1)}; }
}
template <bool XF32> struct XRow;
template <> struct XRow<true> { typedef f32x4 T;
    static __device__ __forceinline__ void load(const float* xin, const bf16*, int m, int lane, f32x4 (&w)[16]) { const f32x4* q = (const f32x4*)(xin + (size_t)m * D) + lane;
#pragma unroll
        for (int j = 0; j < 16; ++j) w[j] = q[64 * j]; }
    static __device__ __forceinline__ f32x4 get(const f32x4& w) { return w; } };
template <> struct XRow<false> { typedef v2u T;
    static __device__ __forceinline__ void load(const float*, const bf16* X, int m, int lane, v2u (&w)[16]) { const v2u* q = (const v2u*)(X + (size_t)m * D) + lane;
#pragma unroll
        for (int j = 0; j < 16; ++j) w[j] = q[64 * j]; }
    static __device__ __forceinline__ f32x4 get(const v2u& w) { const unsigned w0 = w.x, w1 = w.y; return (f32x4){bf_lo(w0), bf_hi(w0), bf_lo(w1), bf_hi(w1)}; } };
template <bool XF32, bool LAST, bool DO_FB>
__device__ __forceinline__ void phase_post(CArgs& a, LAS unsigned char* lds, const float* gpost, int lnext, int gw, int NGW, int tid, int lane) {
    LAS float* wfb = (LAS float*)(lds + RING_OFF);
    if (DO_FB) { build_wfb(wfb, a.in[1] + (size_t)lnext * D * INCOLS, a.in[3] + lnext * D, tid); __syncthreads(); }
    const bf16* Y = (const bf16*)(a.ws + WS_Y16); bf16* X = (bf16*)(a.ws + WS_X16); float* LS = (float*)(a.ws + WS_LS); float* RS = (float*)(a.ws + WS_RS);
    const f32x4* gq = (const f32x4*)gpost + lane;
    typedef typename XRow<XF32>::T XT;
    v2u yw[16], ywn[16]; XT xw[16], xwn[16];
    int m = gw;
    if (m < M) { const v2u* yq = (const v2u*)(Y + (size_t)m * D) + lane;
#pragma unroll
        for (int j = 0; j < 16; ++j) yw[j] = yq[64 * j];
        XRow<XF32>::load(a.in[0], X, m, lane, xw); }
#pragma clang loop unroll(disable)
    while (m < M) {
        const int mn = m + NGW;
        if (!XF32 && mn < M) { const v2u* yq = (const v2u*)(Y + (size_t)mn * D) + lane;
#pragma unroll
            for (int j = 0; j < 16; ++j) ywn[j] = yq[64 * j];
            XRow<XF32>::load(a.in[0], X, mn, lane, xwn); }
        float ssy = 0.f;
#pragma unroll
        for (int j = 0; j < 16; ++j) { const unsigned w0 = yw[j].x, w1 = yw[j].y; const float a0 = bf_lo(w0), a1 = bf_hi(w0), a2 = bf_lo(w1), a3 = bf_hi(w1); ssy += (a0 * a0 + a1 * a1) + (a2 * a2 + a3 * a3); }
        const float ry = 1.0f / sqrtf(wave_sum(ssy) * (1.0f / D) + RMS_EPS);
        float ssv = 0.f; float acc[8];
#pragma unroll
        for (int hh = 0; hh < 8; ++hh) acc[hh] = 0.f;
        f32x4* o = (f32x4*)(a.out + (size_t)m * D) + lane; v2u* xo = (v2u*)(X + (size_t)m * D) + lane;
#pragma unroll
        for (int j = 0; j < 16; ++j) { const unsigned w0 = yw[j].x, w1 = yw[j].y; const f32x4 yv = {bf_lo(w0), bf_hi(w0), bf_lo(w1), bf_hi(w1)};
            const f32x4 vj = XRow<XF32>::get(xw[j]) + (yv * ry) * gq[64 * j];
            if (LAST) o[64 * j] = vj;
            else { xo[64 * j] = cvt4(vj); ssv += (vj.x * vj.x + vj.y * vj.y) + (vj.z * vj.z + vj.w * vj.w); if (DO_FB) fb_accum(vj, j, wfb, lane, acc); }
            if (DO_FB) asm volatile("" : "+v"(acc[0]), "+v"(acc[1]), "+v"(acc[2]), "+v"(acc[3]), "+v"(acc[4]), "+v"(acc[5]), "+v"(acc[6]), "+v"(acc[7]) :: "memory");
            else if ((j & 3) == 3) asm volatile("" ::: "memory"); }
        if (!LAST) { const float rstd = 1.0f / sqrtf(wave_sum(ssv) * (1.0f / D) + RMS_EPS);
            if (lane == 0) RS[m] = rstd;
            if (DO_FB) fb_finish(acc, rstd, a.in[7] + lnext * NH, LS, m, lane); }
        if (XF32) { if (mn < M) { const v2u* yq = (const v2u*)(Y + (size_t)mn * D) + lane;
#pragma unroll
                for (int j = 0; j < 16; ++j) yw[j] = yq[64 * j];
                XRow<XF32>::load(a.in[0], X, mn, lane, xw); } }
        else {
#pragma unroll
            for (int j = 0; j < 16; ++j) { yw[j] = ywn[j]; xw[j] = xwn[j]; } }
        m = mn;
    }
    if (DO_FB) __syncthreads();
}
constexpr int SEG_OFF = LDSCTL_OFF + 1024;
__device__ __forceinline__ void build_seg(CArgs& a, LAS unsigned char* lds, int pm, int tid) {
    { const int r = tid >> 1, hf = tid & 1; const size_t row = (size_t)pm * 256 + r;
        const int b = (int)(row / SEQ), sq = (int)(row % SEQ);
        const float* pp = (const float*)(a.ws + (hf ? WS_PSB : WS_PSA)) + (size_t)b * NH * SEQ + sq; const f32x4* pc = (const f32x4*)((const float*)(a.ws + WS_PSC) + ((size_t)(4 * hf) * M + row) * 16);
        float hs[8];
#pragma unroll
        for (int hh = 0; hh < 8; ++hh) hs[hh] = pp[(size_t)hh * SEQ];
        const float sx = ((hs[0] + hs[1]) + (hs[2] + hs[3])) + ((hs[4] + hs[5]) + (hs[6] + hs[7])), so = __shfl_xor(sx, 1), sa = hf ? so : sx, sb = hf ? sx : so; float sc = 0.f;
#pragma unroll
        for (int i = 0; i < 16; ++i) { const f32x4 c = pc[(size_t)(i >> 2) * (M * 4) + (i & 3)]; sc += (c.x + c.y) + (c.z + c.w); }
        sc += __shfl_xor(sc, 1);
        const float ra = 1.0f / sqrtf(sa * (1.0f / 1024.f) + RMS_EPS), rb = 1.0f / sqrtf(sb * (1.0f / 1024.f) + RMS_EPS), rc = 1.0f / sqrtf(sc * (1.0f / 2048.f) + RMS_EPS);
        LAS float* seg = (LAS float*)(lds + SEG_OFF) + r * 3; if (hf == 0) { seg[0] = ra / rb; seg[1] = rb / rc; seg[2] = rc; } }
    __syncthreads();
}
__device__ __forceinline__ void phase_mixnorm(CArgs& a, int gw, int NGW, int lane) {
    bf16* O = (bf16*)(a.ws + WS_O);
    for (int m = gw; m < M; m += NGW) {
        v4u* p = (v4u*)(O + (size_t)m * D) + lane; v4u w[8]; float ss[8];
#pragma unroll
        for (int j = 0; j < 8; ++j) w[j] = p[64 * j];
#pragma unroll
        for (int j = 0; j < 8; ++j) { float s = 0.f;
#pragma unroll
            for (int e = 0; e < 4; ++e) { const float lo = bf_lo(w[j][e]), hi = bf_hi(w[j][e]); s += lo * lo + hi * hi; }
            ss[j] = s; }
        const float sa = wave_sum(ss[0] + ss[1]), sb = wave_sum(ss[2] + ss[3]), sc = wave_sum((ss[4] + ss[5]) + (ss[6] + ss[7]));
        const float ra = 1.0f / sqrtf(sa * (1.0f / 1024.f) + RMS_EPS), rb = 1.0f / sqrtf(sb * (1.0f / 1024.f) + RMS_EPS), rc = 1.0f / sqrtf(sc * (1.0f / 2048.f) + RMS_EPS);
#pragma unroll
        for (int j = 0; j < 8; ++j) { const float r = j < 2 ? ra : (j < 4 ? rb : rc); v4u o;
#pragma unroll
            for (int e = 0; e < 4; ++e) o[e] = cvt2(bf_lo(w[j][e]) * r, bf_hi(w[j][e]) * r);
            p[64 * j] = o; }
    }
}
__device__ __forceinline__ void phase_cum_knorm(CArgs& a, int gw, int NGW, int lane) {
    if (gw < BATCH * NH) {
        const float* ls = (const float*)(a.ws + WS_LS) + (size_t)gw * SEQ; float* cum = (float*)(a.ws + WS_CUM) + (size_t)gw * SEQ; float carry = 0.f;
        f32x4 qa[SEQ / 1024][4];
#pragma unroll
        for (int c = 0; c < SEQ / 1024; ++c)
#pragma unroll
            for (int i = 0; i < 4; ++i) qa[c][i] = *(const f32x4*)(ls + c * 1024 + lane * 16 + 4 * i);
#pragma unroll
        for (int c = 0; c < SEQ / 1024; ++c) {
            f32x4 q[4];
#pragma unroll
            for (int i = 0; i < 4; ++i) q[i] = qa[c][i];
            float run = 0.f;
#pragma unroll
            for (int i = 0; i < 4; ++i) { q[i].x += run; q[i].y += q[i].x; q[i].z += q[i].y; q[i].w += q[i].z; run = q[i].w; }
            float inc = run;
#pragma unroll
            for (int o = 1; o < 64; o <<= 1) { const float t = __builtin_bit_cast(float, __builtin_amdgcn_ds_bpermute(((lane - o) & 63) << 2, __builtin_bit_cast(int, inc))); if (lane >= o) inc += t; }
            const float excl = (inc - run) + carry;
#pragma unroll
            for (int i = 0; i < 4; ++i) *(f32x4*)(cum + c * 1024 + lane * 16 + 4 * i) = q[i] + excl;
            carry += __builtin_bit_cast(float, __builtin_amdgcn_readlane(__builtin_bit_cast(int, inc), 63));
        }
    }
    const bf16* P = (const bf16*)(a.ws + WS_PROJ); float* knt = (float*)(a.ws + WS_KNT);
    for (int t = gw; t < BATCH * NH * (SEQ / 64); t += NGW) {
        const int bh = t / (SEQ / 64), kt = t % (SEQ / 64), b = bh / NH, h = bh % NH; float mx = 0.f;
        const bf16* base = P + (size_t)(b * SEQ + kt * 64) * NPROJ + COL_KB + h * HD + 8 * (lane & 15);
#pragma unroll 4
        for (int it = 0; it < 16; ++it) { const v4u w = *(const v4u*)(base + (size_t)(it * 4 + (lane >> 4)) * NPROJ); float s = 0.f;
#pragma unroll
            for (int e = 0; e < 4; ++e) { const float lo = bf_lo(w[e]), hi = bf_hi(w[e]); s += lo * lo + hi * hi; }
            s += __shfl_xor(s, 1); s += __shfl_xor(s, 2); s += __shfl_xor(s, 4); s += __shfl_xor(s, 8); mx = fmaxf(mx, s); }
        mx = fmaxf(mx, __shfl_xor(mx, 16)); mx = fmaxf(mx, __shfl_xor(mx, 32));
        if (lane == 0) knt[t] = sqrtf(mx);
    }
}
namespace att {
typedef short s16x4 __attribute__((ext_vector_type(4)));
#ifndef B_SKIP
#define B_SKIP 1
#endif
constexpr float SKIP_T = 30.0f;
constexpr int KBUF = 64 * 256, VBUF = 64 * 256;
constexpr int NBUF = 3;
constexpr int OFF_K = 0, OFF_V = NBUF * KBUF, OFF_TAB = NBUF * (KBUF + VBUF), OFF_CK = OFF_TAB + 2560, OFF_RED = OFF_CK + NBUF * 256, LDS_END = OFF_RED + 64;
__device__ __forceinline__ int swz(int row) { return ((row & 3) << 2) | ((row >> 2) & 3); }
static_assert(LDS_END <= RING_BYTES, "attention LDS");

template <int MODE>
__device__ __forceinline__ void attn_unit(CArgs& a, LAS unsigned char* lds, int l, int b, int h, int qb, int tid, int wave, int lane) {
    const bf16* P = (const bf16*)(a.ws + WS_PROJ);
    const int colq = MODE == 0 ? COL_QA : COL_QB, colk = MODE == 0 ? COL_KA : COL_KB, colv = MODE == 0 ? COL_VA : COL_VB;
    const int q = lane & 31, hi = lane >> 5;
    const int qpos = qb * 256 + wave * 32 + q;
    const size_t rowbase = (size_t)b * SEQ;
    const float* cum = (const float*)(a.ws + WS_CUM) + (size_t)(b * NH + h) * SEQ;
    LAS float* tab = (LAS float*)(lds + OFF_TAB);
    LAS float* ckl = (LAS float*)(lds + OFF_CK);

    int kt_first, ntiles, kt_step;
    if (MODE == 0) { kt_first = 4 * qb - 8 < 0 ? 0 : 4 * qb - 8; ntiles = 4 * qb + 3 - kt_first + 1; kt_step = 1; }
    else { kt_first = 4 * qb + 3; ntiles = 4 * qb + 4; kt_step = -1; }
    const int cq = 4 * qb + (wave >> 1);

    if (MODE == 0) { const float* rb = a.in[6] + (size_t)(l * NH + h) * 513; for (int i = tid; i < 640; i += NWAVES * 64) tab[i] = rb[i < 512 ? i : 512] * LOG2E; }

    bf16x8 qf[8];
    { const bf16* qp = P + (rowbase + qpos) * NPROJ + colq + h * HD + 8 * hi;
#pragma unroll
        for (int s = 0; s < 8; ++s) qf[s] = *(const bf16x8*)(qp + 16 * s); }
    if (MODE == 1 && B_SKIP) {
        float ss = 0.f;
#pragma unroll
        for (int s = 0; s < 8; ++s) { const bf16x8 qv = qf[s]; const v4u w = __builtin_bit_cast(v4u, qv);
#pragma unroll
            for (int e = 0; e < 4; ++e) { const unsigned ww = w[e]; const float lo = bf_lo(ww), hi2 = bf_hi(ww); ss += lo * lo + hi2 * hi2; } }
        ss += __shfl_xor(ss, 32);
#pragma unroll
        for (int o = 1; o < 32; o <<= 1) ss = fmaxf(ss, __shfl_xor(ss, o));
        LAS float* red = (LAS float*)(lds + OFF_RED);
        if (lane == 0) red[wave] = ss;
        __syncthreads();
        float qn2 = red[0];
#pragma unroll
        for (int w = 1; w < NWAVES; ++w) qn2 = fmaxf(qn2, red[w]);
        const float* knt = (const float*)(a.ws + WS_KNT) + (size_t)(b * NH + h) * (SEQ / 64);
        float kn = fmaxf(knt[lane], knt[lane + 64]);
#pragma unroll
        for (int o = 1; o < 64; o <<= 1) kn = fmaxf(kn, __shfl_xor(kn, o));
        const float kd = fmaxf(fmaxf(knt[4 * qb], knt[4 * qb + 1]), fmaxf(knt[4 * qb + 2], knt[4 * qb + 3]));
        const float qn = sqrtf(qn2), theta = SKIP_T + qn * (kn + kd) * QK_SCALE;
        const float c0 = cum[qb * 256];
        int jskip = -1; bool found = false;
        for (int base = 4 * qb - 1; base >= 0 && !found; base -= 64) {
            const int Jl = base - lane; const bool skip = Jl < 0 ? true : (c0 - cum[64 * Jl + 63] < -theta);
            const unsigned long long bal = __ballot(skip);
            if (bal) { jskip = base - (__ffsll((long long)bal) - 1); found = true; }
        }
        jskip = __builtin_amdgcn_readfirstlane(jskip);
        ntiles = 4 * qb + 3 - jskip;
    }

    f32x16 O[4];
#pragma unroll
    for (int d = 0; d < 4; ++d)
#pragma unroll
        for (int r = 0; r < 16; ++r) O[d][r] = 0.f;
    float mrun = -1e30f, lsum = 0.f;

    float ckreg = 0.f;
    const bf16* kbase = P + rowbase * NPROJ + colk + h * HD;
    const bf16* vbase = P + rowbase * NPROJ + colv + h * HD;
    unsigned goff[2];
#pragma unroll
    for (int j = 0; j < 2; ++j) { const int row = 8 * wave + 4 * j + (lane >> 4); goff[j] = (unsigned)(row * NPROJ + 8 * ((lane & 15) ^ swz(row))); }
#define ATT_LOAD(kt, buf) do { const size_t r0_ = (size_t)(kt) * 64 * NPROJ; \
        _Pragma("unroll") for (int j_ = 0; j_ < 2; ++j_) { \
            __builtin_amdgcn_global_load_lds((const unsigned*)(kbase + r0_ + goff[j_]), (LAS unsigned*)(lds + OFF_K + (buf) * KBUF + 1024 * (2 * wave + j_)), 16, 0, 0); \
            __builtin_amdgcn_global_load_lds((const unsigned*)(vbase + r0_ + goff[j_]), (LAS unsigned*)(lds + OFF_V + (buf) * VBUF + 1024 * (2 * wave + j_)), 16, 0, 0); } \
        if (MODE == 1 && tid < 64) ckreg = -cum[(size_t)(kt) * 64 + tid] * LOG2E; } while (0)
#define ATT_STORE(buf) do { if (MODE == 1 && tid < 64) ckl[(buf) * 64 + tid] = ckreg; } while (0)
    unsigned kx[8], vx[4][2];
    { const int sk = swz(q);
#pragma unroll
        for (int s = 0; s < 8; ++s) kx[s] = (unsigned)(256 * q + 16 * ((2 * s + hi) ^ sk));
        const int qq = (lane & 15) >> 2, pp = lane & 3, g1 = (lane >> 4) & 1;
#pragma unroll
        for (int d = 0; d < 4; ++d)
#pragma unroll
            for (int hf = 0; hf < 2; ++hf) { const int row = 8 * hf + 4 * hi + qq; vx[d][hf] = (unsigned)(256 * row + 16 * ((4 * d + 2 * g1 + (pp >> 1)) ^ swz(row)) + 8 * (pp & 1)); } }

#define ATT_QK(P0, P1, buf) do { const LAS unsigned char* kb_ = lds + OFF_K + (buf) * KBUF; \
        _Pragma("unroll") for (int r_ = 0; r_ < 16; ++r_) { P0[r_] = 0.f; P1[r_] = 0.f; } \
        _Pragma("unroll") for (int s_ = 0; s_ < 8; ++s_) { const bf16x8 k0_ = *(const LAS bf16x8*)(kb_ + kx[s_]), k1_ = *(const LAS bf16x8*)(kb_ + kx[s_] + 8192); \
            P0 = MFMA32(k0_, qf[s_], P0); P1 = MFMA32(k1_, qf[s_], P1); } } while (0)
#define ATT_ACTIVE(kt) (MODE == 0 ? ((kt) <= cq && (kt) >= cq - 8) : ((kt) <= cq))
    ATT_LOAD(kt_first, 0); ATT_STORE(0);
    if (ntiles > 1) { ATT_LOAD(kt_first + kt_step, 1); ATT_STORE(1); }
    __syncthreads();
    f32x16 pn0, pn1;
#pragma unroll
    for (int r = 0; r < 16; ++r) { pn0[r] = 0.f; pn1[r] = 0.f; }
    if (ATT_ACTIVE(kt_first)) ATT_QK(pn0, pn1, 0);
    int buf = 0, bnx = 1, bnn = 2;
    for (int it = 0; it < ntiles; ++it) {
        const int kt = kt_first + it * kt_step;
        if (it + 2 < ntiles) ATT_LOAD(kt + 2 * kt_step, bnn);
        f32x16 p0 = pn0, p1 = pn1;
        if (it + 1 < ntiles && ATT_ACTIVE(kt + kt_step)) ATT_QK(pn0, pn1, bnx);
        const bool active = ATT_ACTIVE(kt);
        if (active) {
            constexpr float C2 = QK_SCALE * LOG2E;
            const int key0 = kt * 64 + 4 * hi;
            if (MODE == 0) {
                if (cq - kt >= 5) { const float bc = tab[512];
#pragma unroll
                    for (int r = 0; r < 16; ++r) { p0[r] = p0[r] * C2 + bc; p1[r] = p1[r] * C2 + bc; } }
                else { const LAS float* tb = tab + (qpos - key0 + 256 - 59);
#pragma unroll
                    for (int r = 0; r < 16; ++r) { const int c = (r & 3) + 8 * (r >> 2); p0[r] = p0[r] * C2 + tb[59 - c]; p1[r] = p1[r] * C2 + tb[27 - c]; } }
            } else {
                const LAS float* ck = ckl + buf * 64 + 4 * hi;
#pragma unroll
                for (int g = 0; g < 4; ++g) { const f32x4 c0 = *(const LAS f32x4*)(ck + 8 * g), c1 = *(const LAS f32x4*)(ck + 32 + 8 * g);
#pragma unroll
                    for (int e = 0; e < 4; ++e) { p0[4 * g + e] = p0[4 * g + e] * C2 + c0[e]; p1[4 * g + e] = p1[4 * g + e] * C2 + c1[e]; } }
                if (kt == cq) { const float NEG = -__builtin_inff();
#pragma unroll
                    for (int r = 0; r < 16; ++r) { const int key = key0 + (r & 3) + 8 * (r >> 2); if (key > qpos) p0[r] = NEG; if (key + 32 > qpos) p1[r] = NEG; } }
            }
            float mt = p0[0];
#pragma unroll
            for (int r = 1; r < 16; ++r) mt = fmaxf(mt, p0[r]);
#pragma unroll
            for (int r = 0; r < 16; ++r) mt = fmaxf(mt, p1[r]);
            mt = fmaxf(mt, __shfl_xor(mt, 32));
            const float mn = fmaxf(mrun, mt), alpha = __builtin_amdgcn_exp2f(mrun - mn);
            mrun = mn;
            float ps = 0.f;
#pragma unroll
            for (int r = 0; r < 16; ++r) { p0[r] = __builtin_amdgcn_exp2f(p0[r] - mn); p1[r] = __builtin_amdgcn_exp2f(p1[r] - mn); ps += p0[r] + p1[r]; }
            lsum = lsum * alpha + ps;
            if (!__all(alpha == 1.0f)) {
#pragma unroll
                for (int d = 0; d < 4; ++d)
#pragma unroll
                    for (int r = 0; r < 16; ++r) O[d][r] *= alpha;
            }
            bf16x8 pf[4];
            pf[0] = cvt8((f32x8){p0[0], p0[1], p0[2], p0[3], p0[4], p0[5], p0[6], p0[7]});
            pf[1] = cvt8((f32x8){p0[8], p0[9], p0[10], p0[11], p0[12], p0[13], p0[14], p0[15]});
            pf[2] = cvt8((f32x8){p1[0], p1[1], p1[2], p1[3], p1[4], p1[5], p1[6], p1[7]});
            pf[3] = cvt8((f32x8){p1[8], p1[9], p1[10], p1[11], p1[12], p1[13], p1[14], p1[15]});
            const LAS unsigned char* vb = lds + OFF_V + buf * VBUF;
#pragma unroll
            for (int d = 0; d < 4; ++d)
#pragma unroll
                for (int ks = 0; ks < 4; ++ks) {
                    const s16x4 lo = __builtin_amdgcn_ds_read_tr16_b64_v4i16((LAS s16x4*)(vb + vx[d][0] + 4096 * ks)), hh = __builtin_amdgcn_ds_read_tr16_b64_v4i16((LAS s16x4*)(vb + vx[d][1] + 4096 * ks));
                    const bf16x8 vv = {lo[0], lo[1], lo[2], lo[3], hh[0], hh[1], hh[2], hh[3]};
                    O[d] = MFMA32(vv, pf[ks], O[d]);
                }
        }
        if (it + 2 < ntiles) ATT_STORE(bnn);
        __syncthreads();
        { const int t_ = buf; buf = bnx; bnx = bnn; bnn = t_; }
    }
#undef ATT_QK
#undef ATT_ACTIVE
#undef ATT_LOAD
#undef ATT_STORE
    const float ltot = lsum + __shfl_xor(lsum, 32), inv = 1.0f / ltot; float ssq = 0.f;
    bf16* op = (bf16*)(a.ws + WS_O) + (rowbase + qpos) * D + MODE * 1024 + h * HD + 4 * hi;
#pragma unroll
    for (int d = 0; d < 4; ++d)
#pragma unroll
        for (int g = 0; g < 4; ++g) { const f32x4 v = {O[d][4 * g] * inv, O[d][4 * g + 1] * inv, O[d][4 * g + 2] * inv, O[d][4 * g + 3] * inv};
            ssq += (v.x * v.x + v.y * v.y) + (v.z * v.z + v.w * v.w);
            *(v2u*)(op + 32 * d + 8 * g) = cvt4(v); }
    ssq += __shfl_xor(ssq, 32);
    if (hi == 0) ((float*)(a.ws + (MODE == 0 ? WS_PSA : WS_PSB)))[(size_t)(b * NH + h) * SEQ + qpos] = ssq;
}
}

namespace s5 {
#ifndef S5_PF
#define S5_PF 8
#endif
constexpr int XROW = 272, XIMG = 32 * XROW, OFF_X = 0, OFF_E = 8 * XIMG, LDS_END = OFF_E + 8 * 64 * 8;
static_assert(LDS_END <= RING_BYTES, "s5 LDS");
struct LamC { float lr, li, cr, ci; };
__device__ __forceinline__ LamC lam_coef(const float* are, const float* aim, float dt, int n) {
    const float ar = fminf(are[n], -1e-4f), ai = aim[n];
    const float zr = ar * dt, zi = ai * dt;
    float sn, cs; sincosf(zi, &sn, &cs);
    const float er = expf(zr);
    LamC o; o.lr = er * cs; o.li = er * sn;
    const float sh = sinf(0.5f * zi);
    const float nr = expm1f(zr) * cs - 2.0f * sh * sh, ni = o.li;
    const float den = 1.0f / (ar * ar + ai * ai);
    o.cr = (nr * ar + ni * ai) * den; o.ci = (ni * ar - nr * ai) * den;
    return o;
}
__device__ __forceinline__ float gelu_tanh(float y) {
    const float z = 0.7978845608028654f * (y + 0.044715f * y * y * y);
    return y * __builtin_amdgcn_rcpf(1.0f + __builtin_amdgcn_exp2f(-2.0f * LOG2E * z));
}
__device__ __forceinline__ void s5_unit(CArgs& a, LAS unsigned char* lds, int l, int b, int g, int wave, int lane) {
    const int c32 = lane & 31, hi = lane >> 5;
    const float* are = a.in[8] + (size_t)(l * NG + g) * NS; const float* aim = a.in[9] + (size_t)(l * NG + g) * NS;
    const float dt = expf(a.in[10][l * NG + g]);
    const LamC me = lam_coef(are, aim, dt, lane);
    bf16x8 bb[4];
#pragma unroll
    for (int st = 0; st < 2; ++st) { const int ns = 32 * st + c32; const LamC cc = lam_coef(are, aim, dt, ns);
        const float* br = a.in[11] + ((size_t)(l * NG + g) * NS + ns) * 16 + 8 * hi; const float* bi = a.in[12] + ((size_t)(l * NG + g) * NS + ns) * 16 + 8 * hi;
        f32x8 vr, vi;
#pragma unroll
        for (int j = 0; j < 8; ++j) { const float xr = br[j], xi = bi[j]; vr[j] = cc.cr * xr - cc.ci * xi; vi[j] = cc.cr * xi + cc.ci * xr; }
        bb[st] = cvt8(vr); bb[2 + st] = cvt8(vi); }
    bf16x8 cf[8];
    { const float msk = c32 < 16 ? 1.f : 0.f; const int ii = c32 & 15;
        const float* cr = a.in[13] + ((size_t)(l * NG + g) * 16 + ii) * NS + 4 * hi; const float* ci = a.in[14] + ((size_t)(l * NG + g) * 16 + ii) * NS + 4 * hi;
#pragma unroll
        for (int s = 0; s < 8; ++s) { const f32x4 r4 = *(const f32x4*)(cr + 8 * s), i4 = *(const f32x4*)(ci + 8 * s);
            cf[s] = cvt8((f32x8){r4.x * msk, -i4.x * msk, r4.y * msk, -i4.y * msk, r4.z * msk, -i4.z * msk, r4.w * msk, -i4.w * msk}); } }
    bf16x8 df;
    { const float dv = c32 < 16 ? a.in[15][(size_t)l * SSMW + g * 16 + (c32 & 15)] : 0.f; f32x8 v;
#pragma unroll
        for (int j = 0; j < 8; ++j) v[j] = (8 * hi + j == c32) ? dv : 0.f;
        df = cvt8(v); }

    const bf16* up = (const bf16*)(a.ws + WS_PROJ) + ((size_t)b * SEQ + wave * 1024 + c32) * NPROJ + COL_U + g * 16 + 8 * hi;
    bf16* yg = (bf16*)(a.ws + WS_YG) + ((size_t)b * SEQ + wave * 1024 + c32) * SSMW + g * 16 + 4 * hi;
    LAS unsigned char* ximg = lds + OFF_X + wave * XIMG;
    LAS float* ebuf = (LAS float*)(lds + OFF_E);

    float xr = 0.f, xi = 0.f; const float nli = -me.li;
    for (int pass = 0; pass < 2; ++pass) {
        bf16x8 ub[S5_PF];
#pragma unroll
        for (int i = 0; i < S5_PF; ++i) ub[i] = *(const bf16x8*)(up + (size_t)i * 32 * NPROJ);
        for (int sg = 0; sg < 32 / S5_PF; ++sg)
#pragma unroll
        for (int si = 0; si < S5_PF; ++si) {
            const int sc = sg * S5_PF + si;
            const bf16x8 uf = ub[si];
            if (sg < 32 / S5_PF - 1) ub[si] = *(const bf16x8*)(up + (size_t)(sc + S5_PF) * 32 * NPROJ);
            f32x16 z;
#pragma unroll
            for (int r = 0; r < 16; ++r) z[r] = 0.f;
            f32x16 c0 = MFMA32(uf, bb[0], z), c1 = MFMA32(uf, bb[1], z), c2 = MFMA32(uf, bb[2], z), c3 = MFMA32(uf, bb[3], z);
            f32x16 re0, re1, im0, im1;
#pragma unroll
            for (int r = 0; r < 16; ++r) {
                const float f0 = c0[r], f1 = c1[r], f2 = c2[r], f3 = c3[r];
                const auto s0 = __builtin_amdgcn_permlane32_swap(__float_as_uint(f0), __float_as_uint(f1), false, false);
                const auto s1 = __builtin_amdgcn_permlane32_swap(__float_as_uint(f2), __float_as_uint(f3), false, false);
                const unsigned u00 = s0[0], u01 = s0[1], u10 = s1[0], u11 = s1[1];
                re0[r] = __uint_as_float(u00); re1[r] = __uint_as_float(u01); im0[r] = __uint_as_float(u10); im1[r] = __uint_as_float(u11);
            }
#pragma unroll
            for (int q4 = 0; q4 < 4; ++q4) {
#pragma unroll
                for (int i = 0; i < 4; ++i) { const int r = 4 * q4 + i; const float nr = __builtin_fmaf(me.lr, xr, __builtin_fmaf(nli, xi, re0[r])), ni = __builtin_fmaf(me.lr, xi, __builtin_fmaf(me.li, xr, im0[r])); xr = nr; xi = ni; re0[r] = nr; im0[r] = ni; }
#pragma unroll
                for (int i = 0; i < 4; ++i) { const int r = 4 * q4 + i; const float nr = __builtin_fmaf(me.lr, xr, __builtin_fmaf(nli, xi, re1[r])), ni = __builtin_fmaf(me.lr, xi, __builtin_fmaf(me.li, xr, im1[r])); xr = nr; xi = ni; re1[r] = nr; im1[r] = ni; }
            }
            if (pass == 1) {
#pragma unroll
                for (int r = 0; r < 16; ++r) {
                    *(LAS unsigned*)(ximg + crow(r, 0) * XROW + 4 * lane) = cvt2(re0[r], im0[r]);
                    *(LAS unsigned*)(ximg + crow(r, 1) * XROW + 4 * lane) = cvt2(re1[r], im1[r]);
                }
                f32x16 y, y2;
#pragma unroll
                for (int r = 0; r < 16; ++r) { y[r] = 0.f; y2[r] = 0.f; }
#pragma unroll
                for (int s = 0; s < 4; ++s) { const bf16x8 xf = *(const LAS bf16x8*)(ximg + c32 * XROW + 32 * s + 16 * hi), xg = *(const LAS bf16x8*)(ximg + c32 * XROW + 32 * (s + 4) + 16 * hi);
                    y = MFMA32(cf[s], xf, y); y2 = MFMA32(cf[s + 4], xg, y2); }
                y = MFMA32(df, uf, y);
#pragma unroll
                for (int r = 0; r < 8; ++r) y[r] += y2[r];
                bf16* yo = yg + (size_t)sc * 32 * SSMW;
                *(v2u*)yo = cvt4((f32x4){gelu_tanh(y[0]), gelu_tanh(y[1]), gelu_tanh(y[2]), gelu_tanh(y[3])});
                *(v2u*)(yo + 8) = cvt4((f32x4){gelu_tanh(y[4]), gelu_tanh(y[5]), gelu_tanh(y[6]), gelu_tanh(y[7])});
            }
        }
        if (pass == 0) {
            ebuf[(wave * 64 + lane) * 2] = xr; ebuf[(wave * 64 + lane) * 2 + 1] = xi;
            __syncthreads();
            float pr = me.lr, pi = me.li;
#pragma unroll
            for (int i = 0; i < 10; ++i) { const float nr = pr * pr - pi * pi, ni = 2.f * pr * pi; pr = nr; pi = ni; }
            xr = 0.f; xi = 0.f;
            for (int w2 = 0; w2 < wave; ++w2) { const float er = ebuf[(w2 * 64 + lane) * 2], ei = ebuf[(w2 * 64 + lane) * 2 + 1];
                const float nr = pr * xr - pi * xi + er, ni = pr * xi + pi * xr + ei; xr = nr; xi = ni; }
        }
    }
    __syncthreads();
}
}
#define argp() (*({ CArgs* p_ = (CArgs*)__builtin_amdgcn_kernarg_segment_ptr(); asm volatile("" : "+s"(p_)); p_; }))
#define tidp() ({ int t_ = (wave << 6) + (int)__builtin_amdgcn_mbcnt_hi(~0u, __builtin_amdgcn_mbcnt_lo(~0u, 0u)); asm volatile("" : "+v"(t_)); t_; })
#define GRID_BAR() do { XcdBarrier b_ = bar; asm volatile("" : "+s"(b_.bar), "+s"(b_.x)); xcd_barrier(b_, tidp()); } while (0)
#ifndef S5_REP
#define S5_REP 1
#endif
#ifndef ATT_REP
#define ATT_REP 1
#endif
#ifndef SEG_ON
#define SEG_ON 1
#endif
#define GEMM_PHASE(EPI, g, S, E) pg8::gemm_phase<EPI, pg8::StaticOrder, PG8_ALIGN, PG8_SP2>(lds + RING_OFF, g, S, E, tidp())

__global__ void __launch_bounds__(NWAVES * 64, 2) hybrid_fwd(Args args) {
    extern __shared__ __attribute__((aligned(16))) unsigned char lds_raw[];
    LAS unsigned char* lds = (LAS unsigned char*)lds_raw;
    const int wave = __builtin_amdgcn_readfirstlane((int)threadIdx.x >> 6);
    const int G = gridDim.x, bx = blockIdx.x;
    const int vcu = (G % 8 == 0) ? (bx % 8) * (G / 8) + bx / 8 : bx;
    const int gw = vcu * NWAVES + wave, NGW = G * NWAVES;
    for (int u = threadIdx.x; u < (LDS_BYTES - LDSCTL_OFF) / 4; u += NWAVES * 64) ((LAS unsigned*)(lds + LDSCTL_OFF))[u] = 0u;
    __syncthreads();
    volatile LAS unsigned* MISC = (volatile LAS unsigned*)(lds + MISC_OFF);
    XcdBarrier bar = xcd_barrier_post((unsigned*)(argp().ws + WS_CTL) + CW_BAR, MISC + 8);

    p0_weights(argp(), lds, gw, NGW, wave, tidp() & 63);
    __syncthreads();
    { const int t = tidp(); phase_norm0(argp(), lds, gw, NGW, t, t & 63); }
    GRID_BAR();

    for (int l = 0; l < LAYERS; ++l) {
        { unsigned char* ws = argp().ws; unsigned char* wl = ws + WS_W + (size_t)l * W_LAYER;
          pg8::Gemm g{(const pg8::bf16_t*)(ws + WS_X16), (const pg8::bf16_t*)(wl + W_IN), M, NPROJ, D}; pg8::StaticOrder S; S.init(M, NPROJ, G, bx);
          pg8::EpiStoreBf16 E{(pg8::bf16_t*)(ws + WS_PROJ), NPROJ, (const float*)(ws + WS_RS)};
          GEMM_PHASE(pg8::EpiStoreBf16, g, S, E); }
        GRID_BAR();
        phase_cum_knorm(argp(), gw, NGW, tidp() & 63);
        for (int rep_ = 0; rep_ < S5_REP; ++rep_)
        for (int u = vcu; u < BATCH * NG; u += G) s5::s5_unit(argp(), lds, l, u >> 7, u & 127, wave, tidp() & 63);
#ifdef S5_TRIPLE
        for (int u = vcu; u < BATCH * NG; u += G) s5::s5_unit(argp(), lds, l, u >> 7, u & 127, wave, tidp() & 63);
        for (int u = vcu; u < BATCH * NG; u += G) s5::s5_unit(argp(), lds, l, u >> 7, u & 127, wave, tidp() & 63);
#endif
        for (int rep_ = 0; rep_ < ATT_REP; ++rep_)
        for (int u = vcu; u < 256; u += G) { const int bh = u >> 4, x = u & 15;
            for (int k = 0; k < 2; ++k) { const int t = tidp(); att::attn_unit<0>(argp(), lds, l, bh >> 3, bh & 7, k ? x + 16 : x, t, wave, t & 63); } }
        GRID_BAR();
        for (int rep_ = 0; rep_ < ATT_REP; ++rep_)
        for (int u = vcu; u < 256; u += G) { const int bh = u >> 4, x = u & 15;
            for (int k = 0; k < 2; ++k) { const int t = tidp(); att::attn_unit<1>(argp(), lds, l, bh >> 3, bh & 7, k ? 31 - x : x, t, wave, t & 63); } }
        { CArgs& A_ = argp(); unsigned char* ws = A_.ws; unsigned char* wl = ws + WS_W + (size_t)l * W_LAYER;
          pg8::Gemm g{(const pg8::bf16_t*)(ws + WS_YG), (const pg8::bf16_t*)(wl + W_GLU), M, SSMW, SSMW}; pg8::StaticOrder S; S.init(M, SSMW, G, bx);
          pg8::EpiGlu E{(const pg8::bf16_t*)(ws + WS_YG), SSMW, (pg8::bf16_t*)(ws + WS_O) + 2048, D, A_.in[17] + (size_t)l * SSMW, (float*)(ws + WS_PSC), M};
          GEMM_PHASE(pg8::EpiGlu, g, S, E); }
        GRID_BAR();
        if (G == 256 && SEG_ON) {
            const int pm_own = 8 * (bx % 8) + (bx / 8) % 8;
            build_seg(argp(), lds, pm_own, tidp());
            unsigned char* ws = argp().ws; unsigned char* wl = ws + WS_W + (size_t)l * W_LAYER;
            pg8::Gemm g{(const pg8::bf16_t*)(ws + WS_O), (const pg8::bf16_t*)(wl + W_OUT), M, D, D}; pg8::StaticOrder S; S.init(M, D, G, bx);
            pg8::EpiStoreBf16 E{(pg8::bf16_t*)(ws + WS_Y16), D, nullptr, (const LAS float*)(lds + SEG_OFF)};
            pg8::gemm_phase<pg8::EpiStoreBf16, pg8::StaticOrder, PG8_ALIGN, PG8_SP2, true>(lds + RING_OFF, g, S, E, tidp(), (const LAS float*)(lds + SEG_OFF));
        } else {
            phase_mixnorm(argp(), gw, NGW, tidp() & 63);
            GRID_BAR();
            unsigned char* ws = argp().ws; unsigned char* wl = ws + WS_W + (size_t)l * W_LAYER;
            pg8::Gemm g{(const pg8::bf16_t*)(ws + WS_O), (const pg8::bf16_t*)(wl + W_OUT), M, D, D}; pg8::StaticOrder S; S.init(M, D, G, bx);
            pg8::EpiStoreBf16 E{(pg8::bf16_t*)(ws + WS_Y16), D, nullptr};
            GEMM_PHASE(pg8::EpiStoreBf16, g, S, E);
        }
        GRID_BAR();
        { CArgs& A_ = argp(); phase_post<false, false, false>(A_, lds, A_.in[4] + (size_t)l * D, 0, gw, NGW, tidp(), tidp() & 63); }
        GRID_BAR();
        { unsigned char* ws = argp().ws; unsigned char* wl = ws + WS_W + (size_t)l * W_LAYER;
          pg8::Gemm g{(const pg8::bf16_t*)(ws + WS_X16), (const pg8::bf16_t*)(wl + W_GU), M, NGU, D}; pg8::StaticOrder S; S.init(M, NGU, G, bx);
          pg8::EpiSwiGlu E{(pg8::bf16_t*)(ws + WS_ACT), DFF, (const float*)(ws + WS_RS)};
          GEMM_PHASE(pg8::EpiSwiGlu, g, S, E); }
        GRID_BAR();
        { unsigned char* ws = argp().ws; unsigned char* wl = ws + WS_W + (size_t)l * W_LAYER;
          pg8::Gemm g{(const pg8::bf16_t*)(ws + WS_ACT), (const pg8::bf16_t*)(wl + W_D), M, D, DFF}; pg8::StaticOrder S; S.init(M, D, G, bx);
          pg8::EpiStoreBf16 E{(pg8::bf16_t*)(ws + WS_Y16), D, nullptr};
          GEMM_PHASE(pg8::EpiStoreBf16, g, S, E); }
        GRID_BAR();
        if (l + 1 < LAYERS) { CArgs& A_ = argp(); phase_post<false, false, true>(A_, lds, A_.in[19] + (size_t)l * D, l + 1, gw, NGW, tidp(), tidp() & 63); GRID_BAR(); }
        else { CArgs& A_ = argp(); phase_post<false, true, false>(A_, lds, A_.in[19] + (size_t)l * D, 0, gw, NGW, tidp(), tidp() & 63); }
    }
}

extern "C" void kernel_launch(void* const* d_in, const int* in_sizes, int n_in, void* d_out, int out_size, void* d_ws, size_t ws_size, hipStream_t stream) {
    static int grid = 0;
    if (grid == 0) {
        if (n_in != 23 || in_sizes[0] != M * D || out_size != M * D || ws_size < WS_END) {
            fprintf(stderr, "kernel_launch: unexpected shapes: n_in %d in0 %d out %d ws %zu (need %zu)\n", n_in, n_in > 0 ? in_sizes[0] : -1, out_size, ws_size, (size_t)WS_END); grid = -1; return; }
        int dev = 0, cus = 0, per_cu = 0;
        if (hipGetDevice(&dev) != hipSuccess || hipDeviceGetAttribute(&cus, hipDeviceAttributeMultiprocessorCount, dev) != hipSuccess) { grid = -1; return; }
        if (hipFuncSetAttribute((const void*)hybrid_fwd, hipFuncAttributeMaxDynamicSharedMemorySize, LDS_BYTES) != hipSuccess) { fprintf(stderr, "kernel_launch: hipFuncSetAttribute failed\n"); grid = -1; return; }
        if (hipOccupancyMaxActiveBlocksPerMultiprocessor(&per_cu, (const void*)hybrid_fwd, NWAVES * 64, LDS_BYTES) != hipSuccess || per_cu < 1)
            fprintf(stderr, "kernel_launch: occupancy query reports %d workgroups per CU\n", per_cu);
        (void)hipGetLastError();
        grid = cus;
    }
    if (grid < 0) return;
    if (hipMemsetAsync((char*)d_ws + WS_CTL, 0, CTL_ZERO_BYTES, stream) != hipSuccess) return;
    Args a{};
    for (int i = 0; i < 23; ++i) a.in[i] = (const float*)d_in[i];
    a.out = (float*)d_out; a.ws = (unsigned char*)d_ws;
    hipLaunchKernelGGL(hybrid_fwd, dim3(grid), dim3(NWAVES * 64), LDS_BYTES, stream, a);
    const hipError_t le = hipPeekAtLastError();
    if (le != hipSuccess) fprintf(stderr, "kernel_launch: launch failed: %s\n", hipGetErrorName(le));
}
```
